# Optimizing an MI355X kernel written in HIP

```python
import math
import jax, jax.numpy as jnp
from jax import lax
import numpy as np

D_MODEL = 2048
BATCH = 4
SEQ = 4096
DEPTH = 2

GRID_W = 64
CTX_LEN = 256
N_MOD = 6
NORM_EPS = 1e-6

A_DIM = 3 * D_MODEL // 8
A_HEAD_DIM = 64
A_HEADS = A_DIM // A_HEAD_DIM
A_DECAY_RANK = 64
A_ICLR_RANK = 64
A_GATE_RANK = 128
A_DECAY_SCALE = math.exp(-0.5)
A_GN_EPS = 64e-5

B_DIM = 3 * D_MODEL // 8
B_HEADS = 4
B_KEY_DIM = B_DIM // 2
B_HEAD_K = B_KEY_DIM // B_HEADS
B_HEAD_V = B_DIM // B_HEADS
B_GATE_RANK = 16
GLA_TAU = 16.0
GLA_CHUNK = 64

C_DIM = D_MODEL // 4
C_GROUP = 16
C_GROUPS = C_DIM // C_GROUP
C_STATE = 64
S5_DT_MIN = 1e-3
S5_DT_MAX = 1e-1

N_BRANCH = 3
CONV_DIM = 3 * A_DIM + 2 * B_KEY_DIM + B_DIM
IN_SPLITS = (A_DIM, A_DIM, A_DIM, B_KEY_DIM, B_KEY_DIM, B_DIM,
             2 * A_DECAY_RANK, 2 * A_ICLR_RANK, A_GATE_RANK, 2 * B_GATE_RANK,
             B_DIM, C_DIM, N_BRANCH * D_MODEL)
IN_DIM = sum(IN_SPLITS)
IN_OFFSETS = tuple(int(o) for o in np.cumsum(IN_SPLITS)[:-1])

N_EXPERTS = 16
N_EXPERT_GROUPS = 4
EXPERTS_PER_GROUP = N_EXPERTS // N_EXPERT_GROUPS
TOP_K = 2
D_EXPERT = D_MODEL // 2

kernel_name = "hybrid_rwkv7_gla_s5_moe_prefix_dit"


def rmsnorm(x, g):
    xf = x.astype(jnp.float32)
    y = xf * lax.rsqrt(jnp.mean(xf * xf, axis=-1, keepdims=True) + NORM_EPS)
    return y.astype(x.dtype) * g


def grid_dwconv(z, w, rows, cols):
    nb, n, ch = z.shape
    out = lax.conv_general_dilated(z.reshape(nb, rows, cols, ch), w[:, :, None, :], (1, 1), "SAME",
                                   dimension_numbers=("NHWC", "HWIO", "NHWC"), feature_group_count=ch)
    return out.reshape(nb, n, ch)


def orient(z):
    return jnp.stack([z[0], jnp.flip(z[1], axis=1)])


def both(z):
    return jnp.stack([z, jnp.flip(z, axis=1)])


def in_features(h, w_in, conv_w, rows, cols):
    p = h @ w_in
    p = jnp.concatenate([grid_dwconv(p[..., :CONV_DIM], conv_w, rows, cols), p[..., CONV_DIM:]], axis=-1)
    return jnp.split(p, IN_OFFSETS, axis=-1)


def rwkv7_branch(r, k, v, d_w, d_a, d_g, S0, w0, w2, a0, a2, g2, k_k, k_a, r_k, gn_w, gn_b, need_out):
    f32 = jnp.float32
    hd = lambda z: z.reshape(z.shape[:-1] + (A_HEADS, A_HEAD_DIM))
    tm = lambda z: jnp.moveaxis(z.astype(f32), 2, 0)
    w = jnp.exp(-A_DECAY_SCALE * jax.nn.sigmoid(
        (w0[:, None, None, :] + jnp.einsum("btdr,drc->dbtc", jnp.tanh(d_w), w2)).astype(f32)))
    a = jax.nn.sigmoid((a0[:, None, None, :] + jnp.einsum("btdr,drc->dbtc", d_a, a2)).astype(f32))
    kk = hd(k * k_k).astype(f32)
    kk = kk * lax.rsqrt(jnp.sum(kk * kk, axis=-1, keepdims=True) + 1e-12)
    kd = k.astype(f32)[None] * (1.0 + (a - 1.0) * k_a.astype(f32))
    xs = (tm(both(hd(r))), tm(orient(hd(w))), tm(orient(hd(kd))), tm(both(hd(v))),
          tm(both(kk)), tm(orient(hd(a))))

    def step(S, inp):
        r_t, w_t, k_t, v_t, kk_t, a_t = inp
        sa = jnp.einsum("dbhvk,dbhk->dbhv", S, kk_t)
        S = (S * w_t[..., None, :] - jnp.einsum("dbhv,dbhk->dbhvk", sa, kk_t * a_t)
             + jnp.einsum("dbhv,dbhk->dbhvk", v_t, k_t))
        return S, (jnp.einsum("dbhvk,dbhk->dbhv", S, r_t) if need_out else None)

    S_fin, y = lax.scan(step, S0, xs)
    if not need_out:
        return None, S_fin
    y = orient(jnp.moveaxis(y, 0, 2))
    mu = jnp.mean(y, axis=-1, keepdims=True)
    var = jnp.mean(jnp.square(y - mu), axis=-1, keepdims=True)
    y = (y - mu) * lax.rsqrt(var + A_GN_EPS) * hd(gn_w) + hd(gn_b)
    rf, vf = hd(r).astype(f32), hd(v).astype(f32)
    bonus = jnp.sum(rf[None] * hd(kd) * hd(r_k), axis=-1, keepdims=True) * vf[None]
    y = jnp.sum(y + bonus, axis=0).reshape(r.shape).astype(r.dtype)
    return y * (jax.nn.sigmoid(d_g) @ g2), S_fin


def gla_chunked(q, k, v, g, S0, need_out):
    nd, nb, t, nh, _ = q.shape
    nc = t // GLA_CHUNK
    blk = lambda z: z.reshape(nd, nb, nc, GLA_CHUNK, nh, z.shape[-1])
    q, k, v, g = blk(q), blk(k), blk(v), blk(g)
    cg = jnp.cumsum(g, axis=3)
    tot = cg[:, :, :, -1]
    U = jnp.einsum("dbnihk,dbnihv->dbnhkv", k * jnp.exp(tot[:, :, :, None] - cg), v)

    def step(S, inp):
        log_a, u_n = inp
        return jnp.exp(log_a)[..., None] * S + u_n, S

    S_fin, S_start = lax.scan(step, S0, (jnp.moveaxis(tot, 2, 0), jnp.moveaxis(U, 2, 0)))
    if not need_out:
        return None, S_fin
    S_start = jnp.moveaxis(S_start, 0, 2)
    inter = jnp.einsum("dbnihk,dbnhkv->dbnihv", q * jnp.exp(cg), S_start)
    ref = cg[:, :, :, GLA_CHUNK // 2 - 1:GLA_CHUNK // 2]
    scores = jnp.einsum("dbnihk,dbnjhk->dbnhij", q * jnp.exp(cg - ref), k * jnp.exp(ref - cg))
    mask = jnp.tril(jnp.ones((GLA_CHUNK, GLA_CHUNK), dtype=bool))
    intra = jnp.einsum("dbnhij,dbnjhv->dbnihv", jnp.where(mask, scores, 0.0), v)
    return (inter + intra).reshape(nd, nb, t, nh, v.shape[-1]), S_fin


def gla_branch(q, k, v, og, d_a, S0, a2, ab, norm_g, need_out):
    f32 = jnp.float32
    hk = lambda z: z.reshape(z.shape[:-1] + (B_HEADS, B_HEAD_K))
    hv = lambda z: z.reshape(z.shape[:-1] + (B_HEADS, B_HEAD_V))
    g = jax.nn.log_sigmoid((jnp.einsum("btdr,drc->dbtc", d_a, a2) + ab[:, None, None, :]).astype(f32)) / GLA_TAU
    qh = both(hk(q).astype(f32) * (B_HEAD_K ** -0.5))
    kh = both(hk(k).astype(f32))
    vh = both(hv(v).astype(f32))
    o, S_fin = gla_chunked(qh, kh, vh, orient(hk(g)), S0, need_out)
    if not need_out:
        return None, S_fin
    o = rmsnorm(jnp.sum(orient(o), axis=0), norm_g)
    return o.reshape(v.shape).astype(v.dtype) * jax.nn.silu(og), S_fin


def s5_discretise(lam_re, lam_im, log_dt, b_re, b_im):
    f32 = jnp.float32
    lr, li = lam_re.astype(f32), lam_im.astype(f32)
    dt = jnp.exp(log_dt.astype(f32))[..., None]
    mag = jnp.exp(lr * dt)
    ar, ai = mag * jnp.cos(li * dt), mag * jnp.sin(li * dt)
    den = lr * lr + li * li
    fr = ((ar - 1.0) * lr + ai * li) / den
    fi = (ai * lr - (ar - 1.0) * li) / den
    br, bi = b_re.astype(f32), b_im.astype(f32)
    bbr = fr[..., None] * br - fi[..., None] * bi
    bbi = fr[..., None] * bi + fi[..., None] * br
    return ar, ai, bbr, bbi


def s5_combine(e1, e2):
    a1r, a1i, b1r, b1i = e1
    a2r, a2i, b2r, b2i = e2
    return (a1r * a2r - a1i * a2i, a1r * a2i + a1i * a2r,
            a2r * b1r - a2i * b1i + b2r, a2r * b1i + a2i * b1r + b2i)


def s5_branch(u, h0r, h0i, lam_re, lam_im, log_dt, b_re, b_im, c_re, c_im, d_skip, glu_w, need_out):
    f32 = jnp.float32
    ug = u.astype(f32).reshape(u.shape[:-1] + (C_GROUPS, C_GROUP))
    ar, ai, bbr, bbi = s5_discretise(lam_re, lam_im, log_dt, b_re, b_im)
    bur = orient(jnp.einsum("dgpc,btgc->dbtgp", bbr, ug))
    bui = orient(jnp.einsum("dgpc,btgc->dbtgp", bbi, ug))
    bur = bur.at[:, :, 0].add(ar[:, None] * h0r - ai[:, None] * h0i)
    bui = bui.at[:, :, 0].add(ar[:, None] * h0i + ai[:, None] * h0r)
    shp = bur.shape
    _, _, xr, xi = lax.associative_scan(
        s5_combine, (jnp.broadcast_to(ar[:, None, None], shp), jnp.broadcast_to(ai[:, None, None], shp), bur, bui),
        axis=2)
    hr, hi = xr[:, :, -1], xi[:, :, -1]
    if not need_out:
        return None, hr, hi
    xr, xi = jnp.sum(orient(xr), axis=0), jnp.sum(orient(xi), axis=0)
    y = jnp.einsum("gcp,btgp->btgc", c_re, xr) - jnp.einsum("gcp,btgp->btgc", c_im, xi)
    y = jax.nn.gelu(y.reshape(u.shape).astype(u.dtype) + d_skip * u)
    ya, yg = jnp.split(y @ glu_w, 2, axis=-1)
    return ya * jax.nn.sigmoid(yg), hr, hi


def merge(ya, yb, yc, gates, pa, pb, pc, wo):
    ga, gb, gc = jnp.split(jax.nn.sigmoid(gates), N_BRANCH, axis=-1)
    return (ga * (ya @ pa) + gb * (yb @ pb) + gc * (yc @ pc)) @ wo


def moe_ffn(h, router_w, router_bias, w1, w3, w2):
    f32 = jnp.float32
    scores = jax.nn.sigmoid((h @ router_w).astype(f32))
    biased = scores + router_bias.astype(f32)
    grp = biased.reshape(biased.shape[:-1] + (N_EXPERT_GROUPS, EXPERTS_PER_GROUP))
    gsel = jnp.argmax(jnp.sum(lax.top_k(grp, TOP_K)[0], axis=-1), axis=-1)
    in_grp = (jnp.arange(N_EXPERT_GROUPS) == gsel[..., None])[..., None]
    masked = jnp.where(in_grp, grp, -jnp.inf).reshape(biased.shape)
    _, idx = lax.top_k(masked, TOP_K)
    wsel = jnp.take_along_axis(scores, idx, axis=-1)
    wsel = wsel / jnp.sum(wsel, axis=-1, keepdims=True)
    gate = jnp.sum(jax.nn.one_hot(idx, N_EXPERTS, dtype=f32) * wsel[..., None], axis=-2).astype(h.dtype)
    out = jnp.zeros_like(h)
    for e in range(N_EXPERTS):
        he = jax.nn.silu(h @ w1[e]) * (h @ w3[e])
        out = out + gate[..., e:e + 1] * (he @ w2[e])
    return out


def setup_inputs(seed: int = 0) -> dict:
    key = jax.random.key(seed)
    ks = iter(jax.random.split(key, 64))

    def nrm(shape, scale):
        return scale * jax.random.normal(next(ks), shape, jnp.float32)

    L, D = DEPTH, D_MODEL
    G, P = C_GROUPS, C_STATE
    centre = jnp.zeros((3, 3, 1), jnp.float32).at[1, 1, 0].set(1.0)
    lam_im0 = jnp.pi * jnp.arange(P, dtype=jnp.float32)
    return {
        "x": nrm((BATCH, SEQ, D), 1.0),
        "c": nrm((BATCH, D), 1.0),
        "ctx": nrm((BATCH, CTX_LEN, D), 1.0),
        "c_ctx": nrm((D,), 1.0),
        "mod_w": nrm((L, D, N_MOD * D), 0.5 * D ** -0.5),
        "mod_b": nrm((L, N_MOD * D), 0.02),
        "norm1_g": 1.0 + nrm((L, D), 0.1),
        "norm2_g": 1.0 + nrm((L, D), 0.1),
        "w_in": nrm((L, D, IN_DIM), D ** -0.5),
        "conv_w": centre + nrm((L, 3, 3, CONV_DIM), 0.2),
        "rk_w0": nrm((L, 2, A_DIM), 0.5),
        "rk_w2": nrm((L, 2, A_DECAY_RANK, A_DIM), A_DECAY_RANK ** -0.5),
        "rk_a0": nrm((L, 2, A_DIM), 0.1),
        "rk_a2": nrm((L, 2, A_ICLR_RANK, A_DIM), A_ICLR_RANK ** -0.5),
        "rk_g2": nrm((L, A_GATE_RANK, A_DIM), A_GATE_RANK ** -0.5),
        "rk_kk": 0.85 + nrm((L, A_DIM), 0.1),
        "rk_ka": 1.0 + nrm((L, A_DIM), 0.1),
        "rk_rk": nrm((L, A_DIM), 0.1),
        "rk_gn_w": 1.0 + nrm((L, A_DIM), 0.1),
        "rk_gn_b": nrm((L, A_DIM), 0.02),
        "gla_a2": nrm((L, 2, B_GATE_RANK, B_KEY_DIM), B_GATE_RANK ** -0.5),
        "gla_ab": nrm((L, 2, B_KEY_DIM), 0.1),
        "gla_norm_g": 1.0 + nrm((L, B_HEAD_V), 0.1),
        "s5_lam_re": -0.5 + nrm((L, 2, G, P), 0.01),
        "s5_lam_im": lam_im0 + nrm((L, 2, G, P), 0.01),
        "s5_log_dt": jax.random.uniform(next(ks), (L, 2, G), jnp.float32, math.log(S5_DT_MIN), math.log(S5_DT_MAX)),
        "s5_b_re": nrm((L, G, P, C_GROUP), (2.0 * C_GROUP) ** -0.5),
        "s5_b_im": nrm((L, G, P, C_GROUP), (2.0 * C_GROUP) ** -0.5),
        "s5_c_re": nrm((L, G, C_GROUP, P), (2.0 * P) ** -0.5),
        "s5_c_im": nrm((L, G, C_GROUP, P), (2.0 * P) ** -0.5),
        "s5_d": nrm((L, C_DIM), 0.5),
        "s5_glu_w": nrm((L, C_DIM, 2 * C_DIM), C_DIM ** -0.5),
        "proj_a": nrm((L, A_DIM, D), A_DIM ** -0.5),
        "proj_b": nrm((L, B_DIM, D), B_DIM ** -0.5),
        "proj_c": nrm((L, C_DIM, D), C_DIM ** -0.5),
        "w_out": nrm((L, D, D), D ** -0.5),
        "router_w": nrm((D, N_EXPERTS), D ** -0.5),
        "router_bias": nrm((N_EXPERTS,), 0.01),
        "exp_w1": nrm((L, N_EXPERTS, D, D_EXPERT), D ** -0.5),
        "exp_w3": nrm((L, N_EXPERTS, D, D_EXPERT), D ** -0.5),
        "exp_w2": nrm((L, N_EXPERTS, D_EXPERT, D), D_EXPERT ** -0.5),
        "final_g": 1.0 + nrm((D,), 0.1),
    }


def reference(x, c, ctx, c_ctx, mod_w, mod_b, norm1_g, norm2_g, w_in, conv_w,
              rk_w0, rk_w2, rk_a0, rk_a2, rk_g2, rk_kk, rk_ka, rk_rk, rk_gn_w, rk_gn_b,
              gla_a2, gla_ab, gla_norm_g,
              s5_lam_re, s5_lam_im, s5_log_dt, s5_b_re, s5_b_im, s5_c_re, s5_c_im, s5_d, s5_glu_w,
              proj_a, proj_b, proj_c, w_out, router_w, router_bias, exp_w1, exp_w3, exp_w2, final_g):
    f32 = jnp.float32
    nb, t_lat, _ = x.shape
    t_ctx = ctx.shape[1]
    rows = t_lat // GRID_W
    pair = lambda z: z.reshape(z.shape[:-1] + (2, z.shape[-1] // 2))
    for l in range(DEPTH):
        last = l == DEPTH - 1
        sh1, sc1, ga1, sh2, sc2, ga2 = jnp.split((jax.nn.silu(c) @ mod_w[l] + mod_b[l])[:, None, :], N_MOD, axis=-1)
        csh1, csc1, cga1, csh2, csc2, cga2 = jnp.split(jax.nn.silu(c_ctx) @ mod_w[l] + mod_b[l], N_MOD, axis=-1)
        hl = rmsnorm(x, norm1_g[l]) * (1.0 + sc1) + sh1
        hc = rmsnorm(ctx, norm1_g[l]) * (1.0 + csc1) + csh1
        fc = in_features(hc, w_in[l], conv_w[l], 1, t_ctx)
        fl = in_features(hl, w_in[l], conv_w[l], rows, GRID_W)

        def mix_a(f, S0, need):
            return rwkv7_branch(f[0], f[1], f[2], pair(f[6]), pair(f[7]), f[8], S0,
                                rk_w0[l], rk_w2[l], rk_a0[l], rk_a2[l], rk_g2[l], rk_kk[l], rk_ka[l],
                                rk_rk[l], rk_gn_w[l], rk_gn_b[l], need)

        def mix_b(f, S0, need):
            return gla_branch(f[3], f[4], f[5], f[10], pair(f[9]), S0, gla_a2[l], gla_ab[l], gla_norm_g[l], need)

        def mix_c(f, h0r, h0i, need):
            return s5_branch(f[11], h0r, h0i, s5_lam_re[l], s5_lam_im[l], s5_log_dt[l], s5_b_re[l], s5_b_im[l],
                             s5_c_re[l], s5_c_im[l], s5_d[l], s5_glu_w[l], need)

        ya_c, st_a = mix_a(fc, jnp.zeros((2, nb, A_HEADS, A_HEAD_DIM, A_HEAD_DIM), f32), not last)
        yb_c, st_b = mix_b(fc, jnp.zeros((2, nb, B_HEADS, B_HEAD_K, B_HEAD_V), f32), not last)
        h0 = jnp.zeros((2, nb, C_GROUPS, C_STATE), f32)
        yc_c, st_cr, st_ci = mix_c(fc, h0, h0, not last)
        ya_l, _ = mix_a(fl, st_a, True)
        yb_l, _ = mix_b(fl, st_b, True)
        yc_l, _, _ = mix_c(fl, st_cr, st_ci, True)
        x = x + ga1 * merge(ya_l, yb_l, yc_l, fl[12], proj_a[l], proj_b[l], proj_c[l], w_out[l])
        hl2 = rmsnorm(x, norm2_g[l]) * (1.0 + sc2) + sh2
        if last:
            x = x + ga2 * moe_ffn(hl2, router_w, router_bias, exp_w1[l], exp_w3[l], exp_w2[l])
        else:
            ctx = ctx + cga1 * merge(ya_c, yb_c, yc_c, fc[12], proj_a[l], proj_b[l], proj_c[l], w_out[l])
            hc2 = rmsnorm(ctx, norm2_g[l]) * (1.0 + csc2) + csh2
            y2 = moe_ffn(jnp.concatenate([hc2, hl2], axis=1), router_w, router_bias, exp_w1[l], exp_w3[l], exp_w2[l])
            ctx = ctx + cga2 * y2[:, :t_ctx]
            x = x + ga2 * y2[:, t_ctx:]
    return rmsnorm(x, final_g)
```

```cpp
#include <hip/hip_runtime.h>
#include <stdint.h>
#include <stdio.h>

typedef _Float16 half_t;
typedef _Float16 h8 __attribute__((ext_vector_type(8)));
typedef _Float16 h4 __attribute__((ext_vector_type(4)));
typedef _Float16 h2 __attribute__((ext_vector_type(2)));
typedef float f4 __attribute__((ext_vector_type(4)));
typedef float f2 __attribute__((ext_vector_type(2)));

constexpr int D = 2048, NBATCH = 4, SEQ = 4096, CTXL = 256, DEPTH = 2;
constexpr int RL = NBATCH * SEQ, RC = NBATCH * CTXL, MT = RL + RC;
constexpr int TS = SEQ + CTXL;
constexpr int ADIM = 768, AH = 12, BDIM = 768, BKEY = 384, BH = 4, BHK = 96, BHV = 192, CDIM = 512, CGR = 32, CP = 64;
constexpr int CONV = 3840, NLO = 1792, NGT = 6144, INSRC = 11680, INPAD = 11776;
constexpr int LO_DW = 0, LO_DA = 128, LO_DG = 256, LO_BG = 384, LO_OG = 416, LO_U = 1184;
constexpr int NE = 16, DE = 1024;
constexpr int SLOTS = 38912;
constexpr int YCP = 768;
constexpr int S5ROWS = NBATCH * (TS / 16);
constexpr int NTHREADS = 512;
#ifndef PROBE_SETUP
#define PROBE_SETUP 1
#endif
#ifndef PROBE_SCAN
#define PROBE_SCAN 1
#endif
#ifndef PROBE_INPROJ
#define PROBE_INPROJ 1
#endif
#ifndef PROBE_CONVF
#define PROBE_CONVF 1
#endif
#ifndef PROBE_MOE
#define PROBE_MOE 1
#endif
#ifndef PROBE_MERGE1
#define PROBE_MERGE1 1
#endif
#ifndef PROBE_GLA
#define PROBE_GLA 1
#endif
#ifndef PROBE_RWKV
#define PROBE_RWKV 1
#endif
#ifndef GATE_KU
#define GATE_KU 0
#endif
#ifndef PROBE_SCANS
#define PROBE_SCANS 1
#endif
#ifndef RWKV_REP
#define RWKV_REP 1
#endif
#ifndef PROBE_CONV1
#define PROBE_CONV1 1
#endif
#ifndef PROBE_S5G2
#define PROBE_S5G2 1
#endif
#ifndef NCONV
#define NCONV 16
#define CONV_GU 6
#define MOE_A 2048
#endif
#ifndef PROBE_P6
#define PROBE_P6 1
#endif
#define REP_1(...) __VA_ARGS__
#define REP_2(...) __VA_ARGS__ __VA_ARGS__
#define REP_3(...) __VA_ARGS__ __VA_ARGS__ __VA_ARGS__
#define REP_CAT(a, b) a##b
#define REP_X(n, ...) REP_CAT(REP_, n)(__VA_ARGS__)
#define REP(n, ...) REP_X(n, __VA_ARGS__)
#ifndef PROBE_COMB
#define PROBE_COMB 1
#endif
constexpr int LDS_BYTES = 139264;

constexpr size_t al_(size_t x) { return (x + 255) & ~(size_t)255; }
constexpr size_t OFF_bar = 0;
constexpr size_t OFF_cnt = OFF_bar + al_(16384);
constexpr size_t OFF_MOD = OFF_cnt + al_(256);
constexpr size_t OFF_Xc = OFF_MOD + al_((size_t)2 * 5 * 6 * D * 4);
constexpr size_t OFF_pos = OFF_Xc + al_((size_t)RC * D * 4);
constexpr size_t OFF_wsel = OFF_pos + al_((size_t)MT * 2 * 4);
constexpr size_t OFF_WinT = OFF_wsel + al_((size_t)MT * 2 * 4);
constexpr size_t OFF_PaT = OFF_WinT + al_((size_t)INPAD * D * 2);
constexpr size_t OFF_WoT = OFF_PaT + al_((size_t)3 * D * YCP * 2);
constexpr size_t OFF_W13T = OFF_WoT + al_((size_t)D * D * 2);
constexpr size_t OFF_W2T = OFF_W13T + al_((size_t)NE * 2 * DE * D * 2);
constexpr size_t OFF_GluT = OFF_W2T + al_((size_t)NE * D * DE * 2);
constexpr size_t OFF_MstT = OFF_GluT + al_((size_t)2 * CDIM * CDIM * 2);
constexpr size_t OFF_McatT = OFF_MstT + al_((size_t)CGR * 256 * 256 * 2);
constexpr size_t OFF_LW2T = OFF_McatT + al_((size_t)CGR * 256 * 512 * 2);
constexpr size_t OFF_LA2T = OFF_LW2T + al_((size_t)2 * ADIM * 64 * 2);
constexpr size_t OFF_LG2T = OFF_LA2T + al_((size_t)2 * ADIM * 64 * 2);
constexpr size_t OFF_LGLT = OFF_LG2T + al_((size_t)ADIM * 128 * 2);
constexpr size_t OFF_XinH = OFF_LGLT + al_((size_t)2 * BKEY * 64 * 2);
constexpr size_t OFF_H = OFF_XinH + al_((size_t)CGR * S5ROWS * 256 * 2);
constexpr size_t OFF_Pconv = OFF_H + al_((size_t)MT * D * 2);
constexpr size_t OFF_Plo = OFF_Pconv + al_((size_t)MT * CONV * 2);
constexpr size_t OFF_Pg = OFF_Plo + al_((size_t)MT * NLO * 2);
constexpr size_t OFF_F = OFF_Pg + al_((size_t)MT * NGT * 2);
constexpr size_t OFF_KK = OFF_F + al_((size_t)MT * CONV * 2);
constexpr int GLT = 2 * NBATCH * BH * (TS / 64);
constexpr size_t OFF_GS = OFF_KK + al_((size_t)MT * (ADIM * 5 + BKEY * 2) * 2);
constexpr size_t OFF_GQ = OFF_GS + al_((size_t)GLT * BHV * BHK * 2);
constexpr size_t OFF_GE = OFF_GQ + al_((size_t)GLT * 64 * BHK * 2);
constexpr size_t OFF_Sloc = OFF_GE + al_((size_t)GLT * BHK * 4);
constexpr size_t WS_TOTAL = OFF_Sloc + al_((size_t)CGR * S5ROWS * 256 * 4);
static_assert(WS_TOTAL <= (size_t)1416134720, "workspace must fit the guaranteed size (sum of the input bytes)");
static_assert((size_t)SLOTS * D * 2 <= (size_t)MT * (ADIM * 5 + BKEY * 2) * 2, "Hs must fit the feature region");
static_assert((size_t)SLOTS * D * 2 <= (size_t)MT * NGT * 2 && (size_t)SLOTS * DE * 2 <= (size_t)MT * CONV * 2, "Y / Hg must fit");
constexpr size_t OFF_Z = OFF_Pconv, OFF_O = OFF_Pconv + (size_t)2 * MT * ADIM * 2, OFF_Hg = OFF_Pconv, OFF_Y = OFF_Pg;
constexpr size_t OFF_YA = OFF_F, OFF_YB = OFF_YA + (size_t)MT * YCP * 2, OFF_YC = OFF_YB + (size_t)MT * YCP * 2, OFF_TC = OFF_YC + (size_t)MT * CDIM * 2;
constexpr size_t OFF_SW = OFF_KK + (size_t)MT * ADIM * 2, OFF_AA = OFF_SW + (size_t)2 * MT * ADIM * 2, OFF_GG = OFF_AA + (size_t)2 * MT * ADIM * 2, OFF_U = OFF_KK, OFF_Hs = OFF_KK;
constexpr size_t OFF_PbT = OFF_PaT + (size_t)D * YCP * 2, OFF_PcT = OFF_PbT + (size_t)D * YCP * 2, OFF_cursor = OFF_cnt + 64;
#define GAS __attribute__((address_space(1)))
struct Params {
    const float* in[42];
    float* out;
    unsigned char* ws;
#define WSP(type, name) __device__ __forceinline__ type* name() const { GAS unsigned char* w = (GAS unsigned char*)ws; asm volatile("" : "+s"(w)); return (type*)(GAS type*)(w + OFF_##name); }
    WSP(unsigned, bar) WSP(int, cnt) WSP(int, cursor) WSP(float, MOD) WSP(float, Xc) WSP(int, pos) WSP(float, wsel) WSP(float, Sloc)
    WSP(half_t, WinT) WSP(half_t, PaT) WSP(half_t, PbT) WSP(half_t, PcT) WSP(half_t, WoT) WSP(half_t, W13T) WSP(half_t, W2T) WSP(half_t, GluT) WSP(half_t, MstT) WSP(half_t, McatT)
    WSP(half_t, LW2T) WSP(half_t, LA2T) WSP(half_t, LG2T) WSP(half_t, LGLT) WSP(half_t, XinH) WSP(half_t, H) WSP(half_t, Pconv) WSP(half_t, Plo) WSP(half_t, Pg) WSP(half_t, F)
    WSP(half_t, KK) WSP(half_t, SW) WSP(half_t, AA) WSP(half_t, GG) WSP(half_t, Z) WSP(half_t, O) WSP(half_t, TC) WSP(half_t, YA) WSP(half_t, YB) WSP(half_t, YC) WSP(half_t, U)
    WSP(half_t, Hg) WSP(half_t, Y) WSP(half_t, Hs) WSP(half_t, GS) WSP(half_t, GQ) WSP(float, GE)
#undef WSP
};
enum { I_X = 0, I_C, I_CTX, I_CCTX, I_MODW, I_MODB, I_N1G, I_N2G, I_WIN, I_CONVW, I_RKW0, I_RKW2, I_RKA0, I_RKA2, I_RKG2, I_RKKK, I_RKKA, I_RKRK, I_RKGNW, I_RKGNB,
       I_GLAA2, I_GLAAB, I_GLANG, I_S5LRE, I_S5LIM, I_S5LDT, I_S5BRE, I_S5BIM, I_S5CRE, I_S5CIM, I_S5D, I_S5GLU, I_PA, I_PB, I_PC, I_WOUT, I_RW, I_RB, I_W1, I_W3, I_W2, I_FG };

extern __shared__ __attribute__((aligned(16))) unsigned char smem[];

__device__ __forceinline__ float sigmoidf_(float x) { return 1.0f / (1.0f + __expf(-x)); }
__device__ __forceinline__ float siluf_(float x) { return x * sigmoidf_(x); }
__device__ __forceinline__ float wave_sum(float v) {
#pragma unroll
    for (int o = 1; o < 64; o <<= 1) v += __shfl_xor(v, o);
    return v;
}
template <int CTRL> __device__ __forceinline__ float dpp_f(float x) {
    return __builtin_bit_cast(float, __builtin_amdgcn_update_dpp(0, __builtin_bit_cast(int, x), CTRL, 0xf, 0xf, true));
}
__device__ __forceinline__ float red8(float x) { x += dpp_f<0xB1>(x); x += dpp_f<0x4E>(x); x += dpp_f<0x141>(x); return x; }
__device__ __forceinline__ float wave_sum_fast(float x);
__device__ __forceinline__ float red16(float x) { x = red8(x); x += dpp_f<0x140>(x); return x; }
__device__ __forceinline__ void lds_barrier() { asm volatile("s_waitcnt lgkmcnt(0)" ::: "memory"); __builtin_amdgcn_s_barrier(); asm volatile("" ::: "memory"); }
__device__ __forceinline__ float wave_sum_fast(float x) { x = red16(x); const int xi = __builtin_bit_cast(int, x);
    const float a = __builtin_bit_cast(float, __builtin_amdgcn_readlane(xi, 0)), b = __builtin_bit_cast(float, __builtin_amdgcn_readlane(xi, 16));
    const float c = __builtin_bit_cast(float, __builtin_amdgcn_readlane(xi, 32)), d = __builtin_bit_cast(float, __builtin_amdgcn_readlane(xi, 48)); return (a + b) + (c + d); }
__device__ __forceinline__ int modrow_of(int row) { return row < RL ? (row >> 12) : 4; }
__device__ __forceinline__ float* xrow_ptr(const Params& P, int row) { return row < RL ? P.out + (size_t)row * D : P.Xc() + (size_t)(row - RL) * D; }
__device__ __forceinline__ const float* pin(int i);
__device__ __forceinline__ const float* xsrc_ptr(const Params& P, int row, int l) {
    if (l == 0) return row < RL ? pin(I_X) + (size_t)row * D : pin(I_CTX) + (size_t)(row - RL) * D;
    return xrow_ptr(P, row);
}
__device__ __forceinline__ int tokrow(int d, int b, int s) {
    if (s < CTXL) return RL + b * CTXL + (d ? (CTXL - 1 - s) : s);
    const int t = s - CTXL; return b * SEQ + (d ? (SEQ - 1 - t) : t);
}
__device__ __forceinline__ int s5_block_row0(int b, int n) { return n < 16 ? RL + b * CTXL + n * 16 : b * SEQ + (n - 16) * 16; }
__device__ __forceinline__ h4 to_h4(f4 v) { h4 r; r[0] = (half_t)v[0]; r[1] = (half_t)v[1]; r[2] = (half_t)v[2]; r[3] = (half_t)v[3]; return r; }

__device__ __forceinline__ int tid_() { int t = threadIdx.x; asm volatile("" : "+v"(t)); return t; }
__device__ __forceinline__ const float* pin(int i) { asm volatile("" : "+s"(i)); const float* p = ((const float* const __attribute__((address_space(4)))*)__builtin_amdgcn_kernarg_segment_ptr())[i];
    return (const float*)(const GAS float*)p; }
__device__ __forceinline__ int wid_of(int tid) { return __builtin_amdgcn_readfirstlane(tid >> 6); }
__device__ __forceinline__ int bid_() { int b = blockIdx.x; asm volatile("" : "+s"(b)); return b; }
#define XB_TMO      128
#define XB_XCNT(j)  (256  + 64 * (j))
#define XB_XSUB(j)  (1280 + 64 * (j))
#define XB_XGEN(j)  (2304 + 64 * (j))
#define XB_TOP      3328
#define XB_TOPGEN   3392
#define XCD_BAR_WORDS 3456
#define XB_SPIN_CAP (1u << 22)
#define LAS __attribute__((address_space(3)))

__device__ __forceinline__ unsigned xb_ld(unsigned* p)              { return __hip_atomic_load(p, __ATOMIC_RELAXED, __HIP_MEMORY_SCOPE_AGENT); }
__device__ __forceinline__ unsigned xb_add(unsigned* p, unsigned v) { return __hip_atomic_fetch_add(p, v, __ATOMIC_RELAXED, __HIP_MEMORY_SCOPE_AGENT); }
__device__ __forceinline__ unsigned xb_xcc_id() { return (unsigned)__builtin_amdgcn_s_getreg((3 << 11) | 20) & 0xFu; }
#define XB_SPIN(cond, bar) do { unsigned _sp = 0; while (cond) { __builtin_amdgcn_s_sleep(1); \
    if ((++_sp & 255u) == 0u) { if (xb_ld(&(bar)[XB_TMO])) break; if (_sp > XB_SPIN_CAP) { atomicAdd(&(bar)[XB_TMO], 1u); break; } } } } while (0)

struct XcdBarrier {
    unsigned* bar; unsigned x;
    volatile LAS unsigned* st;
};

__device__ __forceinline__ XcdBarrier xcd_barrier_post(unsigned* bar, volatile LAS unsigned* st) {
    XcdBarrier b; b.bar = bar; b.x = xb_xcc_id(); b.st = st;
    if (threadIdx.x == 0) (void)xb_add(&bar[XB_XCNT(b.x)], 1u);
    return b;
}
__device__ __forceinline__ void xcd_barrier_complete(unsigned* bar, unsigned x, unsigned& nloc, unsigned& nx) {
    asm volatile("" : "+s"(x));
    const unsigned G = gridDim.x * gridDim.y * gridDim.z;
    unsigned sum, cnt, mine, sp = 0u;
    for (;;) {
        sum = 0u; cnt = 0u; mine = 0u;
#pragma unroll
        for (unsigned j = 0; j < 16; ++j) { const unsigned c = xb_ld(&bar[XB_XCNT(j)]); sum += c; cnt += (c > 0u) ? 1u : 0u; mine = (j == x) ? c : mine; }
        if (sum == G) break;
        __builtin_amdgcn_s_sleep(1);
        if ((++sp & 255u) == 0u) { if (xb_ld(&bar[XB_TMO])) break; if (sp > XB_SPIN_CAP) { atomicAdd(&bar[XB_TMO], 1u); break; } }
    }
    nloc = mine > 0u ? mine : 1u; nx = cnt > 0u ? cnt : 1u;
}

__device__ __forceinline__ void xcd_barrier(const XcdBarrier& b) {
    asm volatile("s_waitcnt vmcnt(0)" ::: "memory");
    __syncthreads();
    if (threadIdx.x == 0) {
        __attribute__((address_space(1))) unsigned* gbar = (__attribute__((address_space(1))) unsigned*)b.bar; asm volatile("" : "+s"(gbar));
        unsigned* bar = (unsigned*)gbar;
        __builtin_amdgcn_s_waitcnt(0);
        unsigned nloc = b.st[0], nx = b.st[1];
        if (nloc == 0u) { xcd_barrier_complete(bar, b.x, nloc, nx); b.st[0] = nloc; b.st[1] = nx; }
        const unsigned old = xb_add(&bar[XB_XSUB(b.x)], 1u);
        const unsigned gen = old / nloc;
        if (old + 1u == (gen + 1u) * nloc) {
            __builtin_amdgcn_fence(__ATOMIC_RELEASE, "agent");
            asm volatile("s_waitcnt vmcnt(0)" ::: "memory");
            const unsigned og = xb_add(&bar[XB_TOP], 1u);
            const unsigned tg = og / nx;
            if (og + 1u == (tg + 1u) * nx) xb_add(&bar[XB_TOPGEN], 1u);
            else XB_SPIN(xb_ld(&bar[XB_TOPGEN]) == tg, bar);
            __builtin_amdgcn_fence(__ATOMIC_ACQUIRE, "agent");
            xb_add(&bar[XB_XGEN(b.x)], 1u);
            asm volatile("s_waitcnt vmcnt(0)" ::: "memory");
        } else {
            XB_SPIN(xb_ld(&bar[XB_XGEN(b.x)]) == gen, bar);
            __builtin_amdgcn_fence(__ATOMIC_ACQUIRE, "agent");
            asm volatile("s_waitcnt vmcnt(0)" ::: "memory");
        }
    }
    __syncthreads();
}


constexpr int GST = 72;
constexpr int GEMM_LDS = 2 * 2 * 128 * GST * 2;
template <class AF, class BF>
__device__ __forceinline__ void gemm_tile(int nk, AF afn, BF bfn, f4 (&acc)[4][2]) {
    half_t* As = (half_t*)smem; half_t* Bs = As + 2 * 128 * GST;
    const int tid = tid_(), lane = tid & 63, w = wid_of(tid), wm = w >> 2, wn = w & 3;
    const int pr0 = tid >> 3, pk = (tid & 7) * 8;
    uint4 ra[2], rb[2];
#pragma unroll
    for (int i = 0; i < 2; ++i) { ra[i] = afn(pr0 + 64 * i, pk); rb[i] = bfn(pr0 + 64 * i, pk); }
    __syncthreads();
#pragma unroll
    for (int i = 0; i < 2; ++i) { *(uint4*)(As + (pr0 + 64 * i) * GST + pk) = ra[i]; *(uint4*)(Bs + (pr0 + 64 * i) * GST + pk) = rb[i]; }
    __syncthreads();
    for (int kt = 0; kt < nk; ++kt) {
        const int cur = kt & 1;
        if (kt + 1 < nk) {
#pragma unroll
            for (int i = 0; i < 2; ++i) { ra[i] = afn(pr0 + 64 * i, (kt + 1) * 64 + pk); rb[i] = bfn(pr0 + 64 * i, (kt + 1) * 64 + pk); }
        }
        const half_t* Ac = As + cur * 128 * GST; const half_t* Bc = Bs + cur * 128 * GST;
#pragma unroll
        for (int ks = 0; ks < 2; ++ks) {
            h8 af[4], bf[2];
#pragma unroll
            for (int mi = 0; mi < 4; ++mi) af[mi] = *(const h8*)(Ac + (64 * wm + 16 * mi + (lane & 15)) * GST + 32 * ks + 8 * (lane >> 4));
#pragma unroll
            for (int ni = 0; ni < 2; ++ni) bf[ni] = *(const h8*)(Bc + (32 * wn + 16 * ni + (lane & 15)) * GST + 32 * ks + 8 * (lane >> 4));
#pragma unroll
            for (int mi = 0; mi < 4; ++mi)
#pragma unroll
                for (int ni = 0; ni < 2; ++ni) acc[mi][ni] = __builtin_amdgcn_mfma_f32_16x16x32_f16(bf[ni], af[mi], acc[mi][ni], 0, 0, 0);
        }
        if (kt + 1 < nk) {
            half_t* An = As + (cur ^ 1) * 128 * GST; half_t* Bn = Bs + (cur ^ 1) * 128 * GST;
#pragma unroll
            for (int i = 0; i < 2; ++i) { *(uint4*)(An + (pr0 + 64 * i) * GST + pk) = ra[i]; *(uint4*)(Bn + (pr0 + 64 * i) * GST + pk) = rb[i]; }
        }
        __syncthreads();
    }
}
__device__ __forceinline__ void acc_zero(f4 (&acc)[4][2]) {
#pragma unroll
    for (int mi = 0; mi < 4; ++mi)
#pragma unroll
        for (int ni = 0; ni < 2; ++ni) acc[mi][ni] = (f4){0.f, 0.f, 0.f, 0.f};
}
template <class FN> __device__ __forceinline__ void acc_foreach(const f4 (&acc)[4][2], FN fn) {
    const int lane = tid_() & 63, w = wid_of(tid_()), wm = w >> 2, wn = w & 3;
#pragma unroll
    for (int mi = 0; mi < 4; ++mi)
#pragma unroll
        for (int ni = 0; ni < 2; ++ni) fn(64 * wm + 16 * mi + (lane & 15), 32 * wn + 16 * ni + 4 * (lane >> 4), acc[mi][ni]);
}
template <class LD, class ST> __device__ __forceinline__ void acc_foreach2(const f4 (&acc)[4][2], LD ld, ST st) {
    const int lane = tid_() & 63, w = wid_of(tid_()), wm = w >> 2, wn = w & 3;
    decltype(ld(0, 0)) tmp[4][2];
#pragma unroll
    for (int mi = 0; mi < 4; ++mi)
#pragma unroll
        for (int ni = 0; ni < 2; ++ni) tmp[mi][ni] = ld(64 * wm + 16 * mi + (lane & 15), 32 * wn + 16 * ni + 4 * (lane >> 4));
#pragma unroll
    for (int mi = 0; mi < 4; ++mi)
#pragma unroll
        for (int ni = 0; ni < 2; ++ni) st(64 * wm + 16 * mi + (lane & 15), 32 * wn + 16 * ni + 4 * (lane >> 4), acc[mi][ni], tmp[mi][ni]);
}
__device__ __forceinline__ uint4 ld16(const half_t* p) { return *(const uint4*)p; }
__device__ __forceinline__ uint4 zero16() { return make_uint4(0u, 0u, 0u, 0u); }

namespace pg8 {
constexpr int BM = 256, BK = 64, HALF = 128, HTB = HALF * BK * 2, STAGE_BYTES = 8 * HTB, NXCD = 8, WGM = 8;
__host__ __device__ __forceinline__ int lds_byte(int r, int c) { const int st = (r >> 4) * 2 + (c >> 5), rr = r & 15, cc = c & 31, ob = rr * 64 + cc * 2; return st * 1024 + (ob ^ (((ob >> 9) & 1) << 5)); }
__host__ __device__ __forceinline__ void stage_rc(int b, int& R, int& C) { const int st = b / 1024, sb = b % 1024, swz = sb ^ (((sb >> 9) & 1) << 5); R = (st >> 1) * 16 + swz / 64; C = (st & 1) * 32 + (swz % 64) / 2; }
__host__ __device__ __forceinline__ int perm32(int rho) { const int n = rho >> 4, i = rho & 15; return 8 * (i >> 2) + 4 * n + (i & 3); }
struct Unit { const char* A; const char* B; int pm, pn; };
struct TileOrder {
    int nM, nN, nwg, G, c, lim;
    __device__ __forceinline__ void init(int nM_, int nN_, int G_, int c_, int lim_ = 1 << 30) { nM = nM_; nN = nN_; nwg = nM * nN; G = G_; c = c_; lim = lim_ < nwg ? lim_ : nwg; }
    __device__ __forceinline__ bool tile(int i, int& pm, int& pn) const {
        const long L = (long)i * G + c; if (L >= lim) return false;
        int wgid = (int)L; { const int q = nwg / NXCD, r = nwg % NXCD, xcd = wgid % NXCD, off = wgid / NXCD; wgid = (xcd < r ? xcd * (q + 1) : r * (q + 1) + (xcd - r) * q) + off; }
        const int nig = WGM * nN, gid = wgid / nig, fm = gid * WGM, gsz = (nM - fm) < WGM ? (nM - fm) : WGM;
        pm = fm + ((wgid % nig) % gsz); pn = (wgid % nig) / gsz; return true;
    }
};
typedef f4 Acc[2][2][4][2];
template <bool PERM = false, class Sched, class Epi>
__device__ __forceinline__ void gemm_phase(const int K, const Sched& S, const Epi& E) {
    LAS unsigned char* lds = (LAS unsigned char*)smem;
    const int tid = tid_(), wid = __builtin_amdgcn_readfirstlane(tid >> 6), lane = tid & 63, wr = wid >> 2, wc = wid & 3, fr = lane & 15, fq = lane >> 4;
    const int nt = K / BK;
    unsigned voff[2], voffB[2];
#pragma unroll
    for (int i = 0; i < 2; ++i) { int R, C; stage_rc(tid * 16 + i * 8192, R, C); const int Rb = PERM ? ((R & ~31) + perm32(R & 31)) : R; voff[i] = (unsigned)(R * K + C) * 2u; voffB[i] = (unsigned)(Rb * K + C) * 2u; }
    const size_t kstep = (size_t)(BK * 2);
    const size_t hstep = (size_t)HALF * K * 2;
    const unsigned ldsw = (unsigned)wid * 1024u;
    const int aoff = lds_byte(wr * 64 + fr, fq * 8), boff = lds_byte(wc * 32 + fr, fq * 8);
#define PG8_SA(b, h) (((b) * 2 + (h)) * HTB)
#define PG8_SB(b, h) ((4 + (b) * 2 + (h)) * HTB)
#define PG8_STAGEV(bufoff, gbase, vo) do { _Pragma("unroll") for (int _i = 0; _i < 2; ++_i) \
        __builtin_amdgcn_global_load_lds((const unsigned*)((const char*)(gbase) + vo[_i]), (LAS unsigned*)(lds + (bufoff) + ldsw + _i * 8192), 16, 0, 0); } while (0)
#define PG8_STAGE(bufoff, gbase) PG8_STAGEV(bufoff, gbase, voff)
#define PG8_STAGEB(bufoff, gbase) PG8_STAGEV(bufoff, gbase, voffB)
#define PG8_LDA(dst, b, h) do { _Pragma("unroll") for (int m = 0; m < 4; ++m) _Pragma("unroll") for (int k = 0; k < 2; ++k) dst[m][k] = *(const LAS h8*)(lds + PG8_SA(b, h) + aoff + m * 2048 + k * 1024); } while (0)
#define PG8_LDB(dst, b, h) do { _Pragma("unroll") for (int n = 0; n < 2; ++n) _Pragma("unroll") for (int k = 0; k < 2; ++k) dst[n][k] = *(const LAS h8*)(lds + PG8_SB(b, h) + boff + n * 2048 + k * 1024); } while (0)
#define PG8_MMA(ai, bj, At, Bt) do { __builtin_amdgcn_s_setprio(1); _Pragma("unroll") for (int m = 0; m < 4; ++m) _Pragma("unroll") for (int n = 0; n < 2; ++n) _Pragma("unroll") for (int k = 0; k < 2; ++k) \
        acc[ai][bj][m][n] = __builtin_amdgcn_mfma_f32_16x16x32_f16(Bt[n][k], At[m][k], acc[ai][bj][m][n], 0, 0, 0); __builtin_amdgcn_s_setprio(0); } while (0)
#define PG8_WAIT_V(n) asm volatile("s_waitcnt vmcnt(" #n ")" ::: "memory")
#define PG8_WAIT_L(n) asm volatile("s_waitcnt lgkmcnt(" #n ")" ::: "memory")
#define PG8_BAR __builtin_amdgcn_s_barrier()
#define PG8_SCHED __builtin_amdgcn_sched_barrier(0)
    Unit cur, nxt; int ui = 0;
    if (!S.next(0, cur)) return;
    Acc acc;
#pragma unroll
    for (int a = 0; a < 2; ++a)
#pragma unroll
        for (int b = 0; b < 2; ++b)
#pragma unroll
            for (int m = 0; m < 4; ++m)
#pragma unroll
                for (int n = 0; n < 2; ++n) acc[a][b][m][n] = (f4){0.f, 0.f, 0.f, 0.f};
    h8 At[4][2], B0[2][2], B1[2][2];
    const char* cA = cur.A; const char* cB = cur.B;
    PG8_STAGEB(PG8_SB(0, 0), cB); PG8_STAGE(PG8_SA(0, 0), cA); PG8_STAGEB(PG8_SB(0, 1), cB + hstep); PG8_STAGE(PG8_SA(0, 1), cA + hstep);
    if (wr == 1) PG8_BAR;
    PG8_WAIT_V(4); PG8_BAR;
    PG8_STAGEB(PG8_SB(1, 0), cB + kstep); PG8_STAGE(PG8_SA(1, 0), cA + kstep); PG8_STAGEB(PG8_SB(1, 1), cB + hstep + kstep);
    PG8_WAIT_V(6); PG8_BAR;
    for (;;) {
        const bool has_next = S.next(ui + 1, nxt);
        const char* nA = has_next ? nxt.A : cA; const char* nB = has_next ? nxt.B : cB;
        for (int t = 0; t < nt; t += 2) {
            const bool last = (t == nt - 2);
            const char* a1 = cA + (size_t)(t + 1) * kstep;
            const char* a2 = last ? nA : cA + (size_t)(t + 2) * kstep; const char* b2 = last ? nB : cB + (size_t)(t + 2) * kstep;
            const char* a3 = a2 + kstep; const char* b3 = b2 + kstep;
            PG8_LDB(B0, 0, 0); PG8_SCHED; PG8_LDA(At, 0, 0); PG8_STAGE(PG8_SA(1, 1), a1 + hstep);
            PG8_WAIT_L(8); PG8_BAR; PG8_WAIT_L(0); PG8_MMA(0, 0, At, B0); PG8_BAR; PG8_SCHED;
            PG8_LDB(B1, 0, 1); PG8_STAGEB(PG8_SB(0, 0), b2);
            PG8_BAR; PG8_WAIT_L(0); PG8_MMA(0, 1, At, B1); PG8_BAR;
            PG8_LDA(At, 0, 1); PG8_STAGE(PG8_SA(0, 0), a2);
            PG8_BAR; PG8_WAIT_L(0); PG8_MMA(1, 0, At, B0); PG8_BAR; PG8_SCHED;
            PG8_STAGEB(PG8_SB(0, 1), b2 + hstep);
            PG8_WAIT_V(6); PG8_BAR; PG8_MMA(1, 1, At, B1); PG8_BAR;
            PG8_LDB(B0, 1, 0); PG8_SCHED; PG8_LDA(At, 1, 0); PG8_STAGE(PG8_SA(0, 1), a2 + hstep);
            PG8_WAIT_L(8); PG8_BAR; PG8_WAIT_L(0); PG8_MMA(0, 0, At, B0); PG8_BAR; PG8_SCHED;
            PG8_LDB(B1, 1, 1); PG8_STAGEB(PG8_SB(1, 0), b3);
            PG8_BAR; PG8_WAIT_L(0); PG8_MMA(0, 1, At, B1); PG8_BAR;
            PG8_LDA(At, 1, 1); PG8_STAGE(PG8_SA(1, 0), a3);
            PG8_BAR; PG8_WAIT_L(0); PG8_MMA(1, 0, At, B0); PG8_BAR; PG8_SCHED;
            PG8_STAGEB(PG8_SB(1, 1), b3 + hstep);
            PG8_WAIT_V(6); PG8_BAR; PG8_MMA(1, 1, At, B1); PG8_BAR;
        }
        E(acc, cur, wr, wc, fr, fq);
        if (!has_next) break;
#pragma unroll
        for (int a = 0; a < 2; ++a)
#pragma unroll
            for (int b = 0; b < 2; ++b)
#pragma unroll
                for (int m = 0; m < 4; ++m)
#pragma unroll
                    for (int n = 0; n < 2; ++n) acc[a][b][m][n] = (f4){0.f, 0.f, 0.f, 0.f};
        cur = nxt; cA = nA; cB = nB; ++ui;
    }
    PG8_WAIT_V(0);
    if (wr == 0) PG8_BAR;
    PG8_BAR;
#undef PG8_SA
#undef PG8_SB
#undef PG8_STAGE
#undef PG8_STAGEB
#undef PG8_STAGEV
#undef PG8_LDA
#undef PG8_LDB
#undef PG8_MMA
#undef PG8_WAIT_V
#undef PG8_WAIT_L
#undef PG8_BAR
#undef PG8_SCHED
}
template <class FN> __device__ __forceinline__ void foreach_frag(const Acc& acc, int wr, int wc, int fr, int fq, FN fn) {
#pragma unroll
    for (int ai = 0; ai < 2; ++ai)
#pragma unroll
        for (int m = 0; m < 4; ++m)
        { int row = ai * HALF + wr * 64 + m * 16 + fr; asm volatile("" : "+v"(row));
#pragma unroll
            for (int bj = 0; bj < 2; ++bj)
#pragma unroll
                for (int n = 0; n < 2; ++n) fn(row, bj * HALF + wc * 32 + n * 16 + 4 * fq, acc[ai][bj][m][n]); }
}
template <class FN> __device__ __forceinline__ void foreach_frag8(const Acc& acc, int wr, int wc, int fr, int fq, FN fn) {
#pragma unroll
    for (int ai = 0; ai < 2; ++ai)
#pragma unroll
        for (int m = 0; m < 4; ++m)
        { int row = ai * HALF + wr * 64 + m * 16 + fr; asm volatile("" : "+v"(row));
#pragma unroll
            for (int bj = 0; bj < 2; ++bj) fn(row, bj * HALF + wc * 32 + 8 * fq, acc[ai][bj][m][0], acc[ai][bj][m][1]); }
}
template <class LD, class ST> __device__ __forceinline__ void foreach_frag2(const Acc& acc, int wr, int wc, int fr, int fq, LD ld, ST st) {
#pragma unroll
    for (int ai = 0; ai < 2; ++ai)
#pragma unroll
        for (int mp = 0; mp < 2; ++mp) {
            int row0 = ai * HALF + wr * 64 + mp * 32 + fr; asm volatile("" : "+v"(row0));
            decltype(ld(0, 0)) tmp[2][2][2];
#pragma unroll
            for (int mm = 0; mm < 2; ++mm)
#pragma unroll
                for (int bj = 0; bj < 2; ++bj)
#pragma unroll
                    for (int n = 0; n < 2; ++n) tmp[mm][bj][n] = ld(row0 + 16 * mm, bj * HALF + wc * 32 + n * 16 + 4 * fq);
#pragma unroll
            for (int mm = 0; mm < 2; ++mm)
#pragma unroll
                for (int bj = 0; bj < 2; ++bj)
#pragma unroll
                    for (int n = 0; n < 2; ++n) st(row0 + 16 * mm, bj * HALF + wc * 32 + n * 16 + 4 * fq, acc[ai][bj][2 * mp + mm][n], tmp[mm][bj][n]);
        }
}
template <class FN> __device__ __forceinline__ void foreach_pair(const Acc& acc, int wr, int wc, int fr, int fq, FN fn) {
#pragma unroll
    for (int ai = 0; ai < 2; ++ai)
#pragma unroll
        for (int m = 0; m < 4; ++m)
        { int row = ai * HALF + wr * 64 + m * 16 + fr; asm volatile("" : "+v"(row));
#pragma unroll
            for (int bj = 0; bj < 2; ++bj) fn(row, bj * 64 + wc * 16 + 4 * fq, acc[ai][bj][m][0], acc[ai][bj][m][1]); }
}
}

__device__ __forceinline__ void ph_prologue(const Params& P) {
    const int tid = tid_(), G = gridDim.x, bid = bid_();
    float* cs = (float*)smem;
    float* red = cs + 5 * D;
    for (int i = tid; i < 5 * D; i += NTHREADS) { const int r = i / D, k = i % D; const float v = r < 4 ? pin(I_C)[r * D + k] : pin(I_CCTX)[k]; cs[i] = siluf_(v); }
    __syncthreads();
    const int lane = tid & 63, w = wid_of(tid);
    for (int t = bid; t < 2 * 96; t += G) {
        const int l = t / 96, n0 = (t % 96) * 128;
        const float* W = pin(I_MODW) + (size_t)l * D * (6 * D) + n0 + 2 * lane;
        float a[5][2];
#pragma unroll
        for (int r = 0; r < 5; ++r) { a[r][0] = 0.f; a[r][1] = 0.f; }
#pragma unroll 16
        for (int k = w * 256; k < w * 256 + 256; ++k) {
            const f2 wv = *(const f2*)(W + (size_t)k * (6 * D));
#pragma unroll
            for (int r = 0; r < 5; ++r) { const float c = cs[r * D + k]; a[r][0] += c * wv[0]; a[r][1] += c * wv[1]; }
        }
#pragma unroll
        for (int r = 0; r < 5; ++r) { red[(w * 5 + r) * 128 + 2 * lane] = a[r][0]; red[(w * 5 + r) * 128 + 2 * lane + 1] = a[r][1]; }
        __syncthreads();
        for (int i = tid; i < 5 * 128; i += NTHREADS) {
            const int r = i / 128, n = i % 128; float s = 0.f;
#pragma unroll
            for (int ww = 0; ww < 8; ++ww) s += red[(ww * 5 + r) * 128 + n];
            P.MOD()[((size_t)l * 5 + r) * (6 * D) + n0 + n] = s + pin(I_MODB)[(size_t)l * 6 * D + n0 + n];
        }
        __syncthreads();
    }
}

template <int KT = 1, class CF> __device__ __forceinline__ void convert_tile(half_t* dst, int K, int ld, int tn, int tk, CF colptr, int kmax = 1 << 30) {
    float* st = (float*)smem;
    const int tid = tid_(), n0 = tn * 64, k0 = tk * 64 * KT;
    {
        const int nl = tid & 63, kk = wid_of(tid); bool ok = true; const float* cp = colptr(n0 + nl, ok);
        float v[8 * KT];
#pragma unroll
        for (int i = 0; i < 8 * KT; ++i) { const int k = kk + 8 * i; const bool kin = (k0 + k) < kmax; v[i] = cp[(size_t)(kin ? k0 + k : 0) * ld]; v[i] = (ok && kin) ? v[i] : 0.f; }
#pragma unroll
        for (int i = 0; i < 8 * KT; ++i) st[(kk + 8 * i) * 65 + nl] = v[i];
    }
    __syncthreads();
    {
        const int nl = tid >> 3, kc = (tid & 7) * 8;
#pragma unroll
        for (int j = 0; j < KT; ++j) { h8 v;
#pragma unroll
            for (int i = 0; i < 8; ++i) v[i] = (half_t)st[(64 * j + kc + i) * 65 + nl];
            *(h8*)(dst + (size_t)(n0 + nl) * K + k0 + 64 * j + kc) = v; }
    }
    __syncthreads();
}
template <class CF> __device__ __forceinline__ void convert_wide(half_t* dst, int K, int ld, int tn, int tk, CF colptr4) {
    float* st = (float*)smem;
    const int tid = tid_(), n0 = tn * 256, k0 = tk * 64;
    {
        const int ng = (tid & 63) * 4, kk = wid_of(tid); bool ok = true; const float* cp = colptr4(n0 + ng, ok);
        f4 v[8];
#pragma unroll
        for (int i = 0; i < 8; ++i) { v[i] = *(const f4*)(cp + (size_t)(k0 + kk + 8 * i) * ld); if (!ok) v[i] = (f4){0.f, 0.f, 0.f, 0.f}; }
#pragma unroll
        for (int i = 0; i < 8; ++i) { const int k = kk + 8 * i; *(f4*)(st + k * 260 + (ng ^ (8 * ((k >> 3) & 3)))) = v[i]; }
    }
    __syncthreads();
#pragma unroll
    for (int j = 0; j < 4; ++j) { const int pidx = tid + NTHREADS * j, nl = pidx >> 3, kc = (pidx & 7) * 8, nsw = nl ^ (8 * ((kc >> 3) & 3)); h8 v;
#pragma unroll
        for (int i = 0; i < 8; ++i) v[i] = (half_t)st[(kc + i) * 260 + nsw];
        *(h8*)(dst + (size_t)(n0 + nl) * K + k0 + kc) = v; }
    __syncthreads();
}
__device__ __forceinline__ void ph_setup(const Params& P, int l_in) {
    const int l = l_in;
    const int G = gridDim.x, bid = bid_(), tid = tid_();
    constexpr int T_WIN = (INPAD / 256) * (D / 64), T_PA = (D / 64) * (ADIM / 64), T_PB = T_PA, T_PC = (D / 64) * (CDIM / 64), T_WO = (D / 256) * (D / 64);
    constexpr int T_LW = 2 * (ADIM / 64), T_LA = T_LW, T_LG = (ADIM / 64) * 2, T_LL = 2 * (BKEY / 64);
    constexpr int T_W13 = NE * (2 * DE / 256) * (D / 64), T_W2 = NE * (D / 256) * (DE / 64), T_GLU = (2 * CDIM / 64) * (CDIM / 64);
    constexpr int T_ALL = T_WIN + T_PA + T_PB + T_PC + T_WO + T_GLU + T_LW + T_LA + T_LG + T_LL;
    const bool s5blk = (G == 256) && bid < 32;
    const int t_first = (G != 256) ? bid : (s5blk ? 224 + (bid % 24) + 248 * (bid / 24) : bid - 32), t_step = (G != 256) ? G : 248;
    for (int tq = t_first, qi = bid; tq < T_ALL; ) {
        const int t = tq;
        if (s5blk) { qi += 32; tq = 248 * (qi / 24) + 224 + (qi % 24); } else tq += t_step;
        int r = t, l = l_in; asm volatile("" : "+s"(l));

        if (r < T_WIN) { const float* src = pin(I_WIN) + (size_t)l * D * INSRC;
            convert_wide(P.WinT(), D, INSRC, r / (D / 64), r % (D / 64), [&](int n, bool& ok) -> const float* { ok = !(n >= 5536 && n < 5632); return src + (n < 5536 ? n : (n < 5632 ? 0 : n - 96)); }); continue; } r -= T_WIN;
        if (r < T_PA) { const float* src = pin(I_PA) + (size_t)l * ADIM * D; convert_tile(P.PaT(), ADIM, D, r / (ADIM / 64), r % (ADIM / 64), [&](int n, bool&) -> const float* { return src + n; }); continue; } r -= T_PA;
        if (r < T_PB) { const float* src = pin(I_PB) + (size_t)l * BDIM * D; convert_tile(P.PbT(), BDIM, D, r / (BDIM / 64), r % (BDIM / 64), [&](int n, bool&) -> const float* { return src + n; }); continue; } r -= T_PB;
        if (r < T_PC) { const float* src = pin(I_PC) + (size_t)l * CDIM * D; convert_tile(P.PcT(), CDIM, D, r / (CDIM / 64), r % (CDIM / 64), [&](int n, bool&) -> const float* { return src + n; }); continue; } r -= T_PC;
        if (r < T_LW) { const int d = r / (ADIM / 64); const float* src = pin(I_RKW2) + (size_t)(l * 2 + d) * 64 * ADIM; convert_tile(P.LW2T() + (size_t)d * ADIM * 64, 64, ADIM, r % (ADIM / 64), 0, [&](int n, bool&) -> const float* { return src + n; }); continue; } r -= T_LW;
        if (r < T_LA) { const int d = r / (ADIM / 64); const float* src = pin(I_RKA2) + (size_t)(l * 2 + d) * 64 * ADIM; convert_tile(P.LA2T() + (size_t)d * ADIM * 64, 64, ADIM, r % (ADIM / 64), 0, [&](int n, bool&) -> const float* { return src + n; }); continue; } r -= T_LA;
        if (r < T_LG) { const float* src = pin(I_RKG2) + (size_t)l * 128 * ADIM; convert_tile(P.LG2T(), 128, ADIM, r >> 1, r & 1, [&](int n, bool&) -> const float* { return src + n; }); continue; } r -= T_LG;
        if (r < T_LL) { const int d = r / (BKEY / 64); const float* src = pin(I_GLAA2) + (size_t)(l * 2 + d) * 16 * BKEY; convert_tile(P.LGLT() + (size_t)d * BKEY * 64, 64, BKEY, r % (BKEY / 64), 0, [&](int n, bool&) -> const float* { return src + n; }, 16); continue; } r -= T_LL;
        if (r < T_WO) { const float* src = pin(I_WOUT) + (size_t)l * D * D; convert_wide(P.WoT(), D, D, r / (D / 64), r % (D / 64), [&](int n, bool&) -> const float* { return src + n; }); continue; } r -= T_WO;
        { const float* src = pin(I_S5GLU) + (size_t)l * CDIM * 2 * CDIM;
            convert_tile(P.GluT(), CDIM, 2 * CDIM, r / (CDIM / 64), r % (CDIM / 64),
                         [&](int n, bool&) -> const float* { const int j = n >> 5, wi = n & 31; return wi < 16 ? src + 16 * j + wi : src + CDIM + 16 * j + wi - 16; }); }
    }
    float* apr = (float*)smem;
    float* api = apr + 2 * 17 * 64;
    float* bbr = api + 2 * 17 * 64;
    float* bbi = bbr + 2 * 64 * 16;
    float* cre = bbi + 2 * 64 * 16;
    float* cim = cre + 16 * 64;
    float* kern = cim + 16 * 64;
    for (int g = bid; g < CGR; g += G) {
        __syncthreads();
        for (int i = tid; i < 2 * 17 * 64; i += NTHREADS) {
            const int d = i / (17 * 64), tau = (i / 64) % 17, p = i % 64;
            const float lr = pin(I_S5LRE)[((l * 2 + d) * CGR + g) * CP + p], li = pin(I_S5LIM)[((l * 2 + d) * CGR + g) * CP + p];
            const float dt = expf(pin(I_S5LDT)[(l * 2 + d) * CGR + g]);
            const float mag = expf(lr * dt * (float)tau), ang = li * dt * (float)tau;
            apr[i] = mag * cosf(ang); api[i] = mag * sinf(ang);
        }
        for (int i = tid; i < 16 * 64; i += NTHREADS) { cre[i] = pin(I_S5CRE)[((size_t)l * CGR + g) * 16 * 64 + i]; cim[i] = pin(I_S5CIM)[((size_t)l * CGR + g) * 16 * 64 + i]; }
        __syncthreads();
        for (int i = tid; i < 2 * 64 * 16; i += NTHREADS) {
            const int d = i / (64 * 16), p = (i / 16) % 64, c = i % 16;
            const float lr = pin(I_S5LRE)[((l * 2 + d) * CGR + g) * CP + p], li = pin(I_S5LIM)[((l * 2 + d) * CGR + g) * CP + p];
            const float ar = apr[(d * 17 + 1) * 64 + p], ai = api[(d * 17 + 1) * 64 + p], den = lr * lr + li * li;
            const float fr = ((ar - 1.0f) * lr + ai * li) / den, fi = (ai * lr - (ar - 1.0f) * li) / den;
            const float br = pin(I_S5BRE)[(((size_t)l * CGR + g) * CP + p) * 16 + c], bi = pin(I_S5BIM)[(((size_t)l * CGR + g) * CP + p) * 16 + c];
            bbr[i] = fr * br - fi * bi; bbi[i] = fr * bi + fi * br;
        }
        __syncthreads();
        for (int i = tid; i < 2 * 16 * 16 * 16; i += NTHREADS) {
            const int d = i >> 12, tau = (i >> 8) & 15, c = (i >> 4) & 15, c2 = i & 15; float s = 0.f;
            for (int p = 0; p < 64; ++p) {
                const float ar = apr[(d * 17 + tau) * 64 + p], ai = api[(d * 17 + tau) * 64 + p], br = bbr[(d * 64 + p) * 16 + c2], bi = bbi[(d * 64 + p) * 16 + c2];
                const float er = ar * br - ai * bi, ei = ar * bi + ai * br;
                s += cre[c * 64 + p] * er - cim[c * 64 + p] * ei;
            }
            kern[i] = s;
        }
        __syncthreads();
        half_t* Mst = P.MstT() + (size_t)g * 256 * 256; half_t* Mcat = P.McatT() + (size_t)g * 256 * 512;
        for (int i = tid; i < 256 * 256; i += NTHREADS) {
            const int n = i >> 8, k = i & 255, d = n >> 7, q = n & 127, p = q & 63, tau = k >> 4, c2 = k & 15;
            const int pw = d ? tau : 15 - tau;
            const float ar = apr[(d * 17 + pw) * 64 + p], ai = api[(d * 17 + pw) * 64 + p], br = bbr[(d * 64 + p) * 16 + c2], bi = bbi[(d * 64 + p) * 16 + c2];
            Mst[i] = (half_t)(q < 64 ? ar * br - ai * bi : ar * bi + ai * br);
        }
        for (int i = tid; i < 256 * 512; i += NTHREADS) {
            const int n = i >> 9, k = i & 511, tau = n >> 4, c = n & 15; float v;
            if (k < 256) { const int t2 = k >> 4, c2 = k & 15; v = 0.f;
                if (t2 <= tau) v += kern[((0 * 16 + (tau - t2)) * 16 + c) * 16 + c2];
                if (t2 >= tau) v += kern[((1 * 16 + (t2 - tau)) * 16 + c) * 16 + c2];
            } else { const int kk = k - 256, d = kk >> 7, q = kk & 127, p = q & 63, pw = d ? 16 - tau : tau + 1;
                const float ar = apr[(d * 17 + pw) * 64 + p], ai = api[(d * 17 + pw) * 64 + p];
                v = q < 64 ? cre[c * 64 + p] * ar - cim[c * 64 + p] * ai : -(cre[c * 64 + p] * ai + cim[c * 64 + p] * ar);
            }
            Mcat[i] = (half_t)v;
        }
    }
    if (bid == 0 && tid < 64) { P.cnt()[tid] = 0; }
}

__device__ __forceinline__ void ph_moe_convert(const Params& P, int l, int qn, int t_begin, int t_end) {
    constexpr int T_W13 = NE * (2 * DE / 256) * (D / 64);
    int* head = P.cnt() + 32 + qn; int* slot = (int*)(smem + 131072 + 1024);
    const int lim = t_end;
    for (;;) {
        __syncthreads();
        if (tid_() == 0) *slot = t_begin + atomicAdd(head, 2);
        __syncthreads();
        const int t0 = *slot;
        if (t0 >= lim) break;
#pragma unroll 1
        for (int q = 0; q < 2; ++q) { int r = t0 + q; if (r >= lim) break;
            if (r < T_W13) { const int e = r / ((2 * DE / 256) * (D / 64)), rr = r % ((2 * DE / 256) * (D / 64));
                const float* s1 = pin(I_W1) + ((size_t)l * NE + e) * D * DE; const float* s3 = pin(I_W3) + ((size_t)l * NE + e) * D * DE;
                convert_wide(P.W13T() + (size_t)e * 2 * DE * D, D, DE, rr / (D / 64), rr % (D / 64),
                             [&](int n, bool&) -> const float* { const int j = n >> 5, wi = n & 31; return wi < 16 ? s1 + 16 * j + wi : s3 + 16 * j + wi - 16; }); }
            else { r -= T_W13; const int e = r / ((D / 256) * (DE / 64)), rr = r % ((D / 256) * (DE / 64)); const float* src = pin(I_W2) + ((size_t)l * NE + e) * DE * D;
                convert_wide(P.W2T() + (size_t)e * D * DE, DE, D, rr / (DE / 64), rr % (DE / 64), [&](int n, bool&) -> const float* { return src + n; }); } }
    }
}
template <int MODE> __device__ __forceinline__ void ph_rows(const Params& P, int l) {
    const int lane = tid_() & 63, gw = bid_() * 8 + wid_of(tid_()), NW = gridDim.x * 8;
    const int nrows = MODE == 2 ? RL : MT;
    const float* gvec = MODE == 2 ? pin(I_FG) : pin(I_N1G) + (size_t)l * D;
    for (int row = gw; row < nrows; row += NW) {
        float* xr = xrow_ptr(P, row); const float* xs = MODE == 0 ? xsrc_ptr(P, row, 0) : xr; const int mr = modrow_of(row);
        f4 v[8]; float ss = 0.f;
#pragma unroll
        for (int j = 0; j < 8; ++j) v[j] = *(const f4*)(xs + (j * 64 + lane) * 4);
        if (MODE >= 1) {
            const int lp = MODE == 2 ? 1 : l - 1;
            const float* ga2 = P.MOD() + ((size_t)lp * 5 + mr) * (6 * D) + 5 * D;
            const int p0 = P.pos()[row * 2], p1 = P.pos()[row * 2 + 1]; const float w0 = P.wsel()[row * 2], w1 = P.wsel()[row * 2 + 1];
            const half_t* y0 = P.Y() + (size_t)p0 * D; const half_t* y1 = P.Y() + (size_t)p1 * D;
#pragma unroll
            for (int j = 0; j < 8; ++j) {
                const int c = (j * 64 + lane) * 4; const h4 a = *(const h4*)(y0 + c), b = *(const h4*)(y1 + c); const f4 g = *(const f4*)(ga2 + c);
#pragma unroll
                for (int i = 0; i < 4; ++i) v[j][i] += g[i] * (w0 * (float)a[i] + w1 * (float)b[i]);
            }
            if (MODE == 1) {
#pragma unroll
                for (int j = 0; j < 8; ++j) *(f4*)(xr + (j * 64 + lane) * 4) = v[j];
            }
        }
#pragma unroll
        for (int j = 0; j < 8; ++j) ss += (v[j][0] * v[j][0] + v[j][1] * v[j][1]) + (v[j][2] * v[j][2] + v[j][3] * v[j][3]);
        ss = wave_sum(ss);
        const float rstd = rsqrtf(ss * (1.0f / D) + 1e-6f);
        if (MODE == 2) {
            const float* fg = gvec;
#pragma unroll
            for (int j = 0; j < 8; ++j) { const int c = (j * 64 + lane) * 4; const f4 g = *(const f4*)(fg + c); f4 o;
#pragma unroll
                for (int i = 0; i < 4; ++i) o[i] = v[j][i] * rstd * g[i];
                *(f4*)(xr + c) = o; }
        } else {
            const float* ng = gvec; const float* sh = P.MOD() + ((size_t)l * 5 + mr) * (6 * D); const float* sc = sh + D;
            half_t* hr = P.H() + (size_t)row * D;
#pragma unroll
            for (int j = 0; j < 8; ++j) { const int c = (j * 64 + lane) * 4; const f4 g = *(const f4*)(ng + c), s1 = *(const f4*)(sc + c), s0 = *(const f4*)(sh + c); f4 o;
#pragma unroll
                for (int i = 0; i < 4; ++i) o[i] = v[j][i] * rstd * g[i] * (1.0f + s1[i]) + s0[i];
                *(h4*)(hr + c) = to_h4(o); }
        }
    }
}

struct SchedDense {
    pg8::TileOrder T; const char* A; const char* B; size_t tstepA, tstepB;
    __device__ __forceinline__ bool next(int i, pg8::Unit& u) const { int pm, pn; if (!T.tile(i, pm, pn)) return false; u.pm = pm; u.pn = pn; u.A = A + (size_t)pm * tstepA; u.B = B + (size_t)pn * tstepB; return true; }
};
template <int PART> __device__ __forceinline__ void ph_inproj(const Params& P, int c, int G, int lim = 1 << 30, int mrows = MT) {
    constexpr int NT0 = (CONV + NLO) / 256, NT1 = NGT / 256, NTOFF = PART ? NT0 : 0;
    SchedDense S; S.T.init(mrows / 256, PART ? NT1 : NT0, G, c, lim); S.A = (const char*)P.H(); S.B = (const char*)(P.WinT() + (size_t)NTOFF * 256 * D); S.tstepA = (size_t)256 * D * 2; S.tstepB = (size_t)256 * D * 2;
    pg8::gemm_phase<true>(D, S, [&](const pg8::Acc& acc, const pg8::Unit& u, int wr, int wc, int fr, int fq) {
        const int m0 = u.pm * 256, n0 = (u.pn + NTOFF) * 256;
        auto st8 = [](half_t* p, f4 a, f4 b) { const h4 x = to_h4(a), y = to_h4(b); h8 o; for (int i = 0; i < 4; ++i) { o[i] = x[i]; o[4 + i] = y[i]; } *(h8*)p = o; };
        if (PART) pg8::foreach_frag8(acc, wr, wc, fr, fq, [&](int m, int n, f4 a, f4 b) { for (int i = 0; i < 4; ++i) { a[i] = sigmoidf_(a[i]); b[i] = sigmoidf_(b[i]); } st8(P.Pg() + (size_t)(m0 + m) * NGT + (n0 - CONV - NLO) + n, a, b); });
        else if (n0 < CONV) pg8::foreach_frag8(acc, wr, wc, fr, fq, [&](int m, int n, f4 a, f4 b) { st8(P.Pconv() + (size_t)(m0 + m) * CONV + n0 + n, a, b); });
        else pg8::foreach_frag8(acc, wr, wc, fr, fq, [&](int m, int n, f4 a, f4 b) { st8(P.Plo() + (size_t)(m0 + m) * NLO + (n0 - CONV) + n, a, b); });
    });
}

__device__ __forceinline__ void ph_convf(const Params& P, int l) {
    const int tid = tid_();
    const float* cw = pin(I_CONVW) + (size_t)l * 9 * CONV;
    for (int it = bid_(); it < MT / 16; it += gridDim.x) {
        const int row0 = it * 16;
        int rows, cols, gi, gj0, base;
        if (row0 < RL) { const int t = row0 & (SEQ - 1); rows = 64; cols = 64; gi = t >> 6; gj0 = t & 63; base = row0 - t; }
        else { const int t = (row0 - RL) & (CTXL - 1); rows = 1; cols = CTXL; gi = 0; gj0 = t; base = row0 - t; }
        __syncthreads();
#pragma unroll 1
        for (int rnd = 0; rnd < 2; ++rnd) {
            const int c0 = (tid + NTHREADS * rnd) * 4;
            if (c0 < CONV) {
                float wt[3][3][4];
#pragma unroll
                for (int u = 0; u < 3; ++u)
#pragma unroll
                    for (int v = 0; v < 3; ++v) { const f4 a = *(const f4*)(cw + (u * 3 + v) * CONV + c0);
#pragma unroll
                        for (int i = 0; i < 4; ++i) wt[u][v][i] = a[i]; }
                h4 win[3][3];
                const h4 hz = {0, 0, 0, 0};
                auto ldp = [&](int u, int j) -> h4 { const int gr = gi + u - 1; if (gr < 0 || gr >= rows || j < 0 || j >= cols) return hz; return *(const h4*)(P.Pconv() + (size_t)(base + gr * cols + j) * CONV + c0); };
#pragma unroll
                for (int u = 0; u < 3; ++u) { win[u][0] = ldp(u, gj0 - 1); win[u][1] = ldp(u, gj0); }
                const bool is_k = (c0 >= ADIM && c0 < 2 * ADIM);
                f4 kkw = (f4){0.f, 0.f, 0.f, 0.f};
                if (is_k) kkw = *(const f4*)(pin(I_RKKK) + l * ADIM + c0 - ADIM);
#pragma unroll 1
                for (int jb = 0; jb < 16; jb += 4) {
                    h4 nw[3][4];
#pragma unroll
                    for (int e = 0; e < 4; ++e)
#pragma unroll
                        for (int u = 0; u < 3; ++u) nw[u][e] = ldp(u, gj0 + jb + e + 1);
                    f4 ov[4], qv[4];
#pragma unroll
                    for (int e = 0; e < 4; ++e) {
#pragma unroll
                        for (int u = 0; u < 3; ++u) win[u][2] = nw[u][e];
                        f4 o = (f4){0.f, 0.f, 0.f, 0.f};
#pragma unroll
                        for (int u = 0; u < 3; ++u)
#pragma unroll
                            for (int v = 0; v < 3; ++v)
#pragma unroll
                                for (int i = 0; i < 4; ++i) o[i] += (float)win[u][v][i] * wt[u][v][i];
                        ov[e] = o;
                        {
                            f4 q; float sq = 0.f;
#pragma unroll
                            for (int i = 0; i < 4; ++i) { q[i] = o[i] * kkw[i]; sq += q[i] * q[i]; }
                            sq = red16(sq);
                            const float inv = rsqrtf(sq + 1e-12f);
#pragma unroll
                            for (int i = 0; i < 4; ++i) q[i] *= inv;
                            qv[e] = q;
                        }
#pragma unroll
                        for (int u = 0; u < 3; ++u) { win[u][0] = win[u][1]; win[u][1] = win[u][2]; }
                    }
#pragma unroll
                    for (int e = 0; e < 4; ++e) { *(h4*)(P.F() + (size_t)(row0 + jb + e) * CONV + c0) = to_h4(ov[e]);
                        if (is_k) *(h4*)(P.KK() + (size_t)(row0 + jb + e) * ADIM + c0 - ADIM) = to_h4(qv[e]); }
                }
            }
        }
    }
}

__device__ __forceinline__ uint4 tanh8(uint4 x) { h8 v = __builtin_bit_cast(h8, x);
#pragma unroll
    for (int i = 0; i < 8; ++i) v[i] = (half_t)tanhf((float)v[i]);
    return __builtin_bit_cast(uint4, v); }
__device__ __forceinline__ uint4 sigm8(uint4 x) { h8 v = __builtin_bit_cast(h8, x);
#pragma unroll
    for (int i = 0; i < 8; ++i) v[i] = (half_t)sigmoidf_((float)v[i]);
    return __builtin_bit_cast(uint4, v); }
__device__ __forceinline__ void ph_lora(const Params& P, int l, int first, int stride) {
    constexpr int NTM = MT / 128;
    half_t* As = (half_t*)smem; half_t* Bs = As + 128 * GST;
    const int tid = tid_(), lane = tid & 63, w = wid_of(tid), wm = w >> 2, wn = w & 3, pr0 = tid >> 3, pk = (tid & 7) * 8;
    for (int u = first; u < 6 * NTM; u += stride) {
        const int kind = u / NTM, tm = u - kind * NTM, m0 = tm * 128, d = kind & 1, cls = kind >> 1;
        const int ncol = cls == 2 ? BKEY : ADIM, nnt = ncol / 128;
        const half_t* A = P.Plo() + (size_t)m0 * NLO + (cls == 0 ? LO_DW + d * 64 : (cls == 1 ? LO_DA + d * 64 : LO_BG + d * 16));
        const half_t* B = (cls == 0 ? P.LW2T() : (cls == 1 ? P.LA2T() : P.LGLT())) + (size_t)d * ncol * 64;
        const float* bw = pin(I_RKW0); const float* ba = pin(I_RKA0); const float* bg = pin(I_GLAAB);
        const float* bias = (cls == 0 ? bw : (cls == 1 ? ba : bg)) + (l * 2 + d) * ncol;
        half_t* O = (cls == 0 ? P.SW() : (cls == 1 ? P.AA() : P.GG())) + ((size_t)d * MT + m0) * ncol;
        uint4 ra[2], rb[2];
#pragma unroll
        for (int i = 0; i < 2; ++i) { uint4 x = (cls == 2 && pk >= 16) ? zero16() : ld16(A + (size_t)(pr0 + 64 * i) * NLO + pk); if (cls == 0) x = tanh8(x); ra[i] = x; rb[i] = ld16(B + (size_t)(pr0 + 64 * i) * 64 + pk); }
        __syncthreads();
#pragma unroll
        for (int i = 0; i < 2; ++i) *(uint4*)(As + (pr0 + 64 * i) * GST + pk) = ra[i];
        for (int nt = 0; nt < nnt; ++nt) {
            half_t* Bc = Bs + (nt & 1) * 128 * GST;
#pragma unroll
            for (int i = 0; i < 2; ++i) *(uint4*)(Bc + (pr0 + 64 * i) * GST + pk) = rb[i];
            if (nt + 1 < nnt) {
#pragma unroll
                for (int i = 0; i < 2; ++i) rb[i] = ld16(B + (size_t)((nt + 1) * 128 + pr0 + 64 * i) * 64 + pk); }
            const f4 bb0 = *(const f4*)(bias + nt * 128 + 32 * wn + 4 * (lane >> 4)), bb1 = *(const f4*)(bias + nt * 128 + 32 * wn + 16 + 4 * (lane >> 4));
            __syncthreads();
            f4 acc[4][2]; acc_zero(acc);
#pragma unroll
            for (int ks = 0; ks < 2; ++ks) {
                h8 af[4], bf[2];
#pragma unroll
                for (int mi = 0; mi < 4; ++mi) af[mi] = *(const h8*)(As + (64 * wm + 16 * mi + (lane & 15)) * GST + 32 * ks + 8 * (lane >> 4));
#pragma unroll
                for (int ni = 0; ni < 2; ++ni) bf[ni] = *(const h8*)(Bc + (32 * wn + 16 * ni + (lane & 15)) * GST + 32 * ks + 8 * (lane >> 4));
#pragma unroll
                for (int mi = 0; mi < 4; ++mi)
#pragma unroll
                    for (int ni = 0; ni < 2; ++ni) acc[mi][ni] = __builtin_amdgcn_mfma_f32_16x16x32_f16(bf[ni], af[mi], acc[mi][ni], 0, 0, 0);
            }
#pragma unroll
            for (int mi = 0; mi < 4; ++mi)
#pragma unroll
                for (int ni = 0; ni < 2; ++ni) { const f4 bb = ni ? bb1 : bb0; const int m = 64 * wm + 16 * mi + (lane & 15), n = nt * 128 + 32 * wn + 16 * ni + 4 * (lane >> 4); f4 o;
#pragma unroll
                    for (int i = 0; i < 4; ++i) { const float x = acc[mi][ni][i] + bb[i]; o[i] = cls == 2 ? (fminf(x, 0.f) - log1pf(__expf(-fabsf(x)))) * (1.0f / 16.0f) : sigmoidf_(x); }
                    *(h4*)(O + (size_t)m * ncol + n) = to_h4(o); }
        }
    }
    __syncthreads();
}

__device__ __forceinline__ h8 ldfrag(const half_t* base, int stride, int row0, int red0, int lane) { return *(const h8*)(base + (row0 + (lane & 15)) * stride + red0 + 8 * (lane >> 4)); }
__device__ __forceinline__ half_t clamp_h(float x) { return (half_t)__builtin_amdgcn_fmed3f(x, -60000.f, 60000.f); }
__device__ __forceinline__ f4 mma16(h8 x, h8 y, f4 c) { return __builtin_amdgcn_mfma_f32_16x16x32_f16(x, y, c, 0, 0, 0); }
__device__ __forceinline__ void ph_rwkv(const Params& P, int l, int first_item, int stride) {
    constexpr int CH = 32, SK = 72, ST = 40;
    const int tid = tid_(), lane = tid & 63, w = wid_of(tid), q = lane >> 4, i16 = lane & 15;
    half_t* Kt = (half_t*)smem; half_t* Rt = Kt + CH * SK; half_t* Bt = Rt + CH * SK; half_t* Dt = Bt + CH * SK; half_t* Wm = Dt + CH * SK; half_t* HTs = Wm + CH * SK;
    half_t* KtT = HTs + 64 * SK; half_t* DhT = KtT + 64 * ST; half_t* BhTn = DhT + 64 * ST; half_t* VT = BhTn + 64 * ST; half_t* UT = VT + 64 * ST; half_t* G1T = UT + 64 * ST;
    half_t* Akd = G1T + 64 * ST; half_t* Ard = Akd + CH * ST; half_t* Arbn = Ard + CH * ST;
    half_t* Pn0 = Arbn + CH * ST; half_t* Pn1 = Pn0 + CH * ST; half_t* PT0 = Pn1 + CH * ST; half_t* PT1 = PT0 + CH * ST; half_t* Tn0 = PT1 + CH * ST; half_t* Tn1 = Tn0 + CH * ST;
    float* Lc = (float*)(Tn1 + CH * ST);
    float* segt = Lc + CH * 64;
    float* gC = segt + 8 * 64; float* gref = gC + 64; float* bonus = gref + 64; float* Yb = bonus + 32;
    for (int item = first_item; item < 2 * NBATCH * AH; item += stride) {
        const int d = item / (NBATCH * AH), b = (item / AH) % NBATCH, h = item % AH;
        const half_t* SWd = P.SW() + (size_t)d * MT * ADIM + h * 64; const half_t* AAd = P.AA() + (size_t)d * MT * ADIM + h * 64; half_t* Zd = P.Z() + (size_t)d * MT * ADIM + h * 64;
        const half_t* Fh = P.F() + h * 64; const half_t* KKh = P.KK() + h * 64;
        const float* kap = pin(I_RKKA) + l * ADIM + h * 64; const float* rkp = pin(I_RKRK) + l * ADIM + h * 64;
        const float* gnw = pin(I_RKGNW) + l * ADIM + h * 64; const float* gnb = pin(I_RKGNB) + l * ADIM + h * 64;
        const int ck = tid & 63, seg = w;
        const float ka_c = kap[ck], rk_c = rkp[ck];
        f4 accH[2];
        accH[0] = (f4){0.f, 0.f, 0.f, 0.f}; accH[1] = (f4){0.f, 0.f, 0.f, 0.f};
        unsigned pr[4], pk[4], pv[4], pkk[4], psw[4], pa[4];
        auto ldu = [](const half_t* p) -> unsigned { return (unsigned)*(const unsigned short*)p; };
        auto h2f = [](unsigned u) -> float { return (float)__builtin_bit_cast(half_t, (unsigned short)u); };
        auto prefetch = [&](int s0) {
#pragma unroll
            for (int i = 0; i < 4; ++i) { const int row = __builtin_amdgcn_readfirstlane(tokrow(d, b, s0 + 4 * seg + i)); const half_t* f = Fh + (size_t)row * CONV + ck;
                pr[i] = ldu(f); pk[i] = ldu(f + ADIM); pv[i] = ldu(f + 2 * ADIM); pkk[i] = ldu(KKh + (size_t)row * ADIM + ck); psw[i] = ldu(SWd + (size_t)row * ADIM + ck); pa[i] = ldu(AAd + (size_t)row * ADIM + ck); }
        };
        prefetch(0);
        for (int s0 = 0; s0 < TS; s0 += CH) {
            float rr[4], kdv[4], bb[4], kkv[4], vv[4], Lv[4];
            { float run = 0.f;
#pragma unroll
              for (int i = 0; i < 4; ++i) { const float a = h2f(pa[i]), kk = h2f(pkk[i]), k = h2f(pk[i]);
                  rr[i] = h2f(pr[i]); vv[i] = h2f(pv[i]); kkv[i] = kk; kdv[i] = k * (1.0f + (a - 1.0f) * ka_c); bb[i] = kk * a; run += -0.6065306597126334f * h2f(psw[i]); Lv[i] = run; } }
            lds_barrier();
            segt[seg * 64 + ck] = Lv[3];
            if (s0 + CH < TS) prefetch(s0 + CH);
            lds_barrier();
            { float off = 0.f;
#pragma unroll
              for (int sg = 0; sg < 8; ++sg) off += (sg < seg) ? segt[sg * 64 + ck] : 0.f;
#pragma unroll
              for (int i = 0; i < 4; ++i) { Lv[i] += off; Lc[(4 * seg + i) * 64 + ck] = Lv[i]; }
#pragma unroll
              for (int i = 0; i < 4; ++i) { const float bs = wave_sum_fast(rr[i] * kdv[i] * rk_c); if (lane == 0) bonus[4 * seg + i] = bs; }
            }
            lds_barrier();
            { const float Lref = Lc[15 * 64 + ck], L31 = Lc[31 * 64 + ck];
              if (seg == 0) { gC[ck] = __expf(L31); gref[ck] = __expf(Lref); }
              h4 ktp, dhp, bhp, vtp;
              const float c3 = __expf(L31 - Lref); float eprev = __expf(((seg == 0) ? 0.f : Lc[(4 * seg - 1) * 64 + ck]) - Lref);
#pragma unroll
              for (int i = 0; i < 4; ++i) { const int t = 4 * seg + i; const float Lt = Lv[i];
                  const float ep = eprev, et = __expf(Lt - Lref), er = __builtin_amdgcn_rcpf(et), e3 = c3 * er; eprev = et;
                  const half_t ktv = clamp_h(kkv[i] * ep);
                  Kt[t * SK + ck] = ktv; ktp[i] = ktv; Rt[t * SK + ck] = clamp_h(rr[i] * et); Bt[t * SK + ck] = clamp_h(bb[i] * er); Dt[t * SK + ck] = clamp_h(kdv[i] * er);
                  dhp[i] = (half_t)(kdv[i] * e3); bhp[i] = (half_t)(-bb[i] * e3); vtp[i] = (half_t)vv[i]; }
              *(h4*)(KtT + ck * ST + 4 * seg) = ktp; *(h4*)(DhT + ck * ST + 4 * seg) = dhp; *(h4*)(BhTn + ck * ST + 4 * seg) = bhp; *(h4*)(VT + ck * ST + 4 * seg) = vtp;
            }
            lds_barrier();
#pragma unroll
            for (int x = 0; x < 2; ++x) { const int id = 2 * w + x, kt = id >> 2, vt = id & 3, k0 = kt * 16 + 4 * q; h4 hv;
#pragma unroll
                for (int r = 0; r < 4; ++r) hv[r] = (half_t)(accH[x][r] * gref[k0 + r]);
                *(h4*)(HTs + (vt * 16 + i16) * SK + k0) = hv; }
            for (int rwrep = 0; rwrep < RWKV_REP; ++rwrep) {
#pragma unroll
            for (int x = 0; x < 2; ++x) {
                const int id = 2 * w + x, mat = id >> 2, tt = (id >> 1) & 1, ts = id & 1;
                f4 acc = (f4){0.f, 0.f, 0.f, 0.f};
                if (ts <= tt) { const half_t* X = (mat & 1) ? Dt : Bt; const half_t* Yp = (mat & 2) ? Rt : Kt;
#pragma unroll
                    for (int ks = 0; ks < 2; ++ks) acc = mma16(ldfrag(X, SK, ts * 16, ks * 32, lane), ldfrag(Yp, SK, tt * 16, ks * 32, lane), acc); }
                const int t = tt * 16 + i16, sb = ts * 16 + 4 * q; h4 av;
#pragma unroll
                for (int r = 0; r < 4; ++r) { const bool keep = (mat & 2) ? (sb + r <= t) : (sb + r < t); av[r] = (half_t)__builtin_amdgcn_fmed3f(keep ? acc[r] : 0.f, -60000.f, 60000.f); }
                if (mat == 0) { *(h4*)(Pn0 + t * ST + sb) = av; h4 tv;
#pragma unroll
                    for (int r = 0; r < 4; ++r) { PT0[(sb + r) * ST + t] = av[r]; tv[r] = (half_t)(((sb + r == t) ? 1.0f : 0.f) - (float)av[r]); }
                    *(h4*)(Tn0 + t * ST + sb) = tv; }
                else if (mat == 1) *(h4*)(Akd + t * ST + sb) = av;
                else if (mat == 2) { h4 nv;
#pragma unroll
                    for (int r = 0; r < 4; ++r) nv[r] = -av[r];
                    *(h4*)(Arbn + t * ST + sb) = nv; }
                else *(h4*)(Ard + t * ST + sb) = av;
            }
            lds_barrier();
            {   half_t* Pc = Pn0; half_t* PTc = PT0; half_t* Pq = Pn1; half_t* PTq = PT1; half_t* Tc = Tn0; half_t* Tq = Tn1;
                const int tl = w & 3, t0 = (tl >> 1) * 16, c0 = (tl & 1) * 16;
#pragma unroll 1
                for (int lev = 0; lev < 5; ++lev) {
                    if (w >= 4) {
                        if (lev < 4) {
                            f4 acc = mma16(ldfrag(Pc, ST, t0, 0, lane), ldfrag(PTc, ST, c0, 0, lane), (f4){0.f, 0.f, 0.f, 0.f});
                            const int tb = t0 + 4 * q, sc = c0 + i16; h4 pv4;
#pragma unroll
                            for (int r = 0; r < 4; ++r) { pv4[r] = (half_t)acc[r]; Pq[(tb + r) * ST + sc] = pv4[r]; }
                            *(h4*)(PTq + sc * ST + tb) = pv4;
                        }
                    } else if (lev > 0) {
                        f4 acc = mma16(ldfrag(Tc, ST, t0, 0, lane), ldfrag(PTc, ST, c0, 0, lane), (f4){0.f, 0.f, 0.f, 0.f});
                        const int tb = t0 + 4 * q, sc = c0 + i16;
#pragma unroll
                        for (int r = 0; r < 4; ++r) Tq[(tb + r) * ST + sc] = (half_t)(acc[r] + (float)Tc[(tb + r) * ST + sc]);
                    }
                    lds_barrier();
                    if (lev < 4) { half_t* tp = Pc; Pc = Pq; Pq = tp; tp = PTc; PTc = PTq; PTq = tp; }
                    if (lev > 0) { half_t* tp = Tc; Tc = Tq; Tq = tp; }
                }
                {   const int kt = w >> 1, tt = w & 1;
                    f4 acc = mma16(ldfrag(KtT, ST, kt * 16, 0, lane), ldfrag(Tc, ST, tt * 16, 0, lane), (f4){0.f, 0.f, 0.f, 0.f});
                    h4 wv;
#pragma unroll
                    for (int r = 0; r < 4; ++r) wv[r] = (half_t)__builtin_amdgcn_fmed3f(acc[r], -60000.f, 60000.f);
                    *(h4*)(Wm + (tt * 16 + i16) * SK + kt * 16 + 4 * q) = wv;
                    const int t2 = w >> 2, vt = w & 3;
                    f4 acc2 = mma16(ldfrag(Akd, ST, t2 * 16, 0, lane), ldfrag(VT, ST, vt * 16, 0, lane), (f4){0.f, 0.f, 0.f, 0.f});
                    h4 gv;
#pragma unroll
                    for (int r = 0; r < 4; ++r) gv[r] = (half_t)__builtin_amdgcn_fmed3f(acc2[r], -60000.f, 60000.f);
                    *(h4*)(G1T + (vt * 16 + i16) * ST + t2 * 16 + 4 * q) = gv;
                }
                lds_barrier();
                {   const int t2 = w >> 2, vt = w & 3;
                    f4 acc = mma16(ldfrag(Tc, ST, t2 * 16, 0, lane), ldfrag(G1T, ST, vt * 16, 0, lane), (f4){0.f, 0.f, 0.f, 0.f});
#pragma unroll
                    for (int ks = 0; ks < 2; ++ks) acc = mma16(ldfrag(Wm, SK, t2 * 16, ks * 32, lane), ldfrag(HTs, SK, vt * 16, ks * 32, lane), acc);
                    h4 uv;
#pragma unroll
                    for (int r = 0; r < 4; ++r) uv[r] = (half_t)__builtin_amdgcn_fmed3f(acc[r], -60000.f, 60000.f);
                    *(h4*)(UT + (vt * 16 + i16) * ST + t2 * 16 + 4 * q) = uv;
                }
            }
            lds_barrier();
            }
            {   const int vt = w >> 1, tt = w & 1;
                f4 acc = (f4){0.f, 0.f, 0.f, 0.f};
#pragma unroll
                for (int ks = 0; ks < 2; ++ks) acc = mma16(ldfrag(HTs, SK, vt * 16, ks * 32, lane), ldfrag(Rt, SK, tt * 16, ks * 32, lane), acc);
                acc = mma16(ldfrag(VT, ST, vt * 16, 0, lane), ldfrag(Ard, ST, tt * 16, 0, lane), acc);
                acc = mma16(ldfrag(UT, ST, vt * 16, 0, lane), ldfrag(Arbn, ST, tt * 16, 0, lane), acc);
                *(f4*)(Yb + (tt * 16 + i16) * 68 + vt * 16 + 4 * q) = acc;
#pragma unroll
                for (int x = 0; x < 2; ++x) { const int id = 2 * w + x, kt = id >> 2, v2 = id & 3, k0 = kt * 16 + 4 * q;
#pragma unroll
                    for (int r = 0; r < 4; ++r) accH[x][r] *= gC[k0 + r];
                    accH[x] = mma16(ldfrag(DhT, ST, kt * 16, 0, lane), ldfrag(VT, ST, v2 * 16, 0, lane), accH[x]);
                    accH[x] = mma16(ldfrag(BhTn, ST, kt * 16, 0, lane), ldfrag(UT, ST, v2 * 16, 0, lane), accH[x]); }
            }
            lds_barrier();
            {   const int t = tid >> 4, c = 4 * (tid & 15), row = tokrow(d, b, s0 + t);
                const f4 y = *(const f4*)(Yb + t * 68 + c); const f4 gw = *(const f4*)(gnw + c), gb = *(const f4*)(gnb + c);
                float sm = (y[0] + y[1]) + (y[2] + y[3]); sm = red16(sm);
                const float mu = sm * (1.0f / 64.0f); float sq = 0.f;
#pragma unroll
                for (int i = 0; i < 4; ++i) { const float dd = y[i] - mu; sq += dd * dd; }
                sq = red16(sq);
                const float rs = rsqrtf(sq * (1.0f / 64.0f) + 64e-5f), bo = bonus[t]; h4 o;
#pragma unroll
                for (int i = 0; i < 4; ++i) o[i] = (half_t)((y[i] - mu) * rs * gw[i] + gb[i] + bo * (float)VT[(c + i) * ST + t]);
                *(h4*)(Zd + (size_t)row * ADIM + c) = o;
            }
        }
        lds_barrier();
    }
}

__device__ __forceinline__ void ph_gla_a(const Params& P, int first, int stride) {
    constexpr int QS = 104, TSR = 72;
    half_t* Q2s = (half_t*)smem; half_t* K2s = Q2s + 64 * QS; half_t* K3T = K2s + 64 * QS; half_t* VT = K3T + 96 * TSR; half_t* Ps = VT + 192 * TSR;
    float* cgf = (float*)(Ps + 64 * TSR); float* segt = cgf + 64 * 96;
    const int tid = tid_(), lane = tid & 63, w = wid_of(tid);
    for (int task = first; task < GLT; task += stride) {
        const int n = task % 68, c = task / 68, h = c & 3, b = (c >> 2) & 3, d = c >> 4, s0 = n * 64;
        const half_t* GGd = P.GG() + (size_t)d * MT * BKEY + h * BHK; half_t* Od = P.O() + (size_t)d * MT * BDIM + h * BHV;
        const half_t* Fq = P.F() + 2304 + h * BHK; const half_t* Fv = P.F() + 3072 + h * BHV;
        lds_barrier();
        h8 qv[2], kv[2];
#pragma unroll
        for (int j = 0; j < 2; ++j) { const int p = tid + NTHREADS * j;
            if (p < 768) { const int i = p / 12, kc = (p % 12) * 8, row = tokrow(d, b, s0 + i);
                qv[j] = *(const h8*)(Fq + (size_t)row * CONV + kc); kv[j] = *(const h8*)(Fq + (size_t)row * CONV + BKEY + kc);
                const h8 g = *(const h8*)(GGd + (size_t)row * BKEY + kc);
#pragma unroll
                for (int e = 0; e < 8; ++e) cgf[i * 96 + kc + e] = (float)g[e]; } }
#pragma unroll
        for (int j = 0; j < 3; ++j) { const int p = tid + NTHREADS * j, i = p / 24, vc = (p % 24) * 8, row = tokrow(d, b, s0 + i);
            const h8 v = *(const h8*)(Fv + (size_t)row * CONV + vc);
#pragma unroll
            for (int e = 0; e < 8; ++e) VT[(vc + e) * TSR + i] = v[e]; }
        lds_barrier();
        { float loc[16]; const int ck = tid % 96, cseg = tid / 96;
          if (tid < 384) { float run = 0.f;
#pragma unroll
              for (int i = 0; i < 16; ++i) { run += cgf[(cseg * 16 + i) * 96 + ck]; loc[i] = run; }
              segt[cseg * 96 + ck] = run; }
          lds_barrier();
          if (tid < 384) { float off = 0.f;
#pragma unroll
              for (int sg = 0; sg < 4; ++sg) off += (sg < cseg) ? segt[sg * 96 + ck] : 0.f;
#pragma unroll
              for (int i = 0; i < 16; ++i) cgf[(cseg * 16 + i) * 96 + ck] = loc[i] + off; }
        }
        lds_barrier();
#pragma unroll
        for (int j = 0; j < 2; ++j) { const int p = tid + NTHREADS * j;
            if (p < 768) { const int i = p / 12, kc = (p % 12) * 8; h8 q1, q2, k2;
#pragma unroll
                for (int e = 0; e < 8; ++e) { const float cg = cgf[i * 96 + kc + e], rf = cgf[31 * 96 + kc + e], tt = cgf[63 * 96 + kc + e];
                    const float qf = (float)qv[j][e] * 0.10206207261596575f, kf = (float)kv[j][e];
                    q1[e] = clamp_h(qf * __expf(cg)); q2[e] = clamp_h(qf * __expf(cg - rf)); k2[e] = clamp_h(kf * __expf(rf - cg)); K3T[(kc + e) * TSR + i] = clamp_h(kf * __expf(tt - cg)); }
                *(h8*)(P.GQ() + ((size_t)task * 64 + i) * BHK + kc) = q1; *(h8*)(Q2s + i * QS + kc) = q2; *(h8*)(K2s + i * QS + kc) = k2; } }
        if (tid < 96) P.GE()[(size_t)task * BHK + tid] = __expf(cgf[63 * 96 + tid]);
        lds_barrier();
#pragma unroll
        for (int x = 0; x < 2; ++x) {
            const int id = w * 2 + x, it = id >> 2, jt = id & 3; f4 a = (f4){0.f, 0.f, 0.f, 0.f};
            if (jt <= it) {
#pragma unroll
                for (int ks = 0; ks < 3; ++ks) a = mma16(ldfrag(K2s, QS, jt * 16, ks * 32, lane), ldfrag(Q2s, QS, it * 16, ks * 32, lane), a);
            }
            const int i = it * 16 + (lane & 15), j = jt * 16 + 4 * (lane >> 4); h4 pv;
#pragma unroll
            for (int r = 0; r < 4; ++r) pv[r] = (j + r <= i) ? clamp_h(a[r]) : (half_t)0.f;
            *(h4*)(Ps + i * TSR + j) = pv;
        }
        lds_barrier();
        {   const int it = w & 3, i = it * 16 + (lane & 15), row = tokrow(d, b, s0 + i);
            const h8 p0 = ldfrag(Ps, TSR, it * 16, 0, lane), p1 = ldfrag(Ps, TSR, it * 16, 32, lane);
#pragma unroll
            for (int x = 0; x < 6; ++x) { const int vt = (w >> 2) * 6 + x;
                f4 a = mma16(ldfrag(VT, TSR, vt * 16, 0, lane), p0, (f4){0.f, 0.f, 0.f, 0.f}); a = mma16(ldfrag(VT, TSR, vt * 16, 32, lane), p1, a);
                *(h4*)(Od + (size_t)row * BDIM + vt * 16 + 4 * (lane >> 4)) = to_h4(a); }
        }
        {   half_t* gs = P.GS() + (size_t)task * BHV * BHK;
#pragma unroll
            for (int x = 0; x < 9; ++x) { const int id = w * 9 + x, kt = id / 12, vt = id - kt * 12;
                f4 a = mma16(ldfrag(K3T, TSR, kt * 16, 0, lane), ldfrag(VT, TSR, vt * 16, 0, lane), (f4){0.f, 0.f, 0.f, 0.f});
                a = mma16(ldfrag(K3T, TSR, kt * 16, 32, lane), ldfrag(VT, TSR, vt * 16, 32, lane), a);
                *(h4*)(gs + (size_t)(vt * 16 + (lane & 15)) * BHK + kt * 16 + 4 * (lane >> 4)) = to_h4(a); }
        }
    }
    __syncthreads();
}
__device__ __forceinline__ void ph_gla_b(const Params& P, int first, int stride) {
    constexpr int NBLK = 32 * (BHV * BHK / 8) / NTHREADS;
    for (int blk = first; blk < NBLK; blk += stride) {
        const int gid = blk * NTHREADS + tid_(), c = gid / (BHV * BHK / 8), e = gid - c * (BHV * BHK / 8), v = e / 12, kc = (e - v * 12) * 8;
        half_t* base = P.GS() + ((size_t)c * 68 * BHV + v) * BHK + kc; const float* eb = P.GE() + (size_t)c * 68 * BHK + kc;
        float S[8];
#pragma unroll
        for (int j = 0; j < 8; ++j) S[j] = 0.f;
        for (int n0 = 0; n0 < 68; n0 += 4) {
            h8 U[4]; f4 e0[4], e1[4];
#pragma unroll
            for (int u = 0; u < 4; ++u) { U[u] = *(const h8*)(base + (size_t)(n0 + u) * BHV * BHK); e0[u] = *(const f4*)(eb + (n0 + u) * BHK); e1[u] = *(const f4*)(eb + (n0 + u) * BHK + 4); }
#pragma unroll
            for (int u = 0; u < 4; ++u) { h8 o;
#pragma unroll
                for (int j = 0; j < 8; ++j) o[j] = clamp_h(S[j]);
                *(h8*)(base + (size_t)(n0 + u) * BHV * BHK) = o;
#pragma unroll
                for (int j = 0; j < 4; ++j) { S[j] = e0[u][j] * S[j] + (float)U[u][j]; S[4 + j] = e1[u][j] * S[4 + j] + (float)U[u][4 + j]; } }
        }
    }
}
__device__ __forceinline__ void ph_gla_c(const Params& P, int l, int first, int stride, bool latent_only) {
    const int tid = tid_(), lane = tid & 63, w = wid_of(tid), q = lane >> 4, i16 = lane & 15;
    const float* ng = pin(I_GLANG) + l * BHV;
    for (int u = first; u < NBATCH * BH * 68 / 2; u += stride) {
        const int t = 2 * u + (w >> 2), m = t % 68, h = (t / 68) & 3, b = t / (68 * 4), it = w & 3, j = it * 16 + i16;
        if (latent_only && m < 4) continue;
        const int row = (m < 4) ? RL + b * CTXL + 64 * m + j : b * SEQ + 64 * (m - 4) + j;
        const int task0 = ((0 * 4 + b) * 4 + h) * 68 + m, task1 = ((1 * 4 + b) * 4 + h) * 68 + (m < 4 ? 3 - m : 71 - m);
        h8 y0[3], y1[3];
        { const half_t* q0 = P.GQ() + ((size_t)task0 * 64 + j) * BHK + 8 * q; const half_t* q1 = P.GQ() + ((size_t)task1 * 64 + (63 - j)) * BHK + 8 * q;
#pragma unroll
          for (int ks = 0; ks < 3; ++ks) { y0[ks] = *(const h8*)(q0 + 32 * ks); y1[ks] = *(const h8*)(q1 + 32 * ks); } }
        const half_t* s0p = P.GS() + ((size_t)task0 * BHV + i16) * BHK + 8 * q; const half_t* s1p = P.GS() + ((size_t)task1 * BHV + i16) * BHK + 8 * q;
        const half_t* o0 = P.O() + (size_t)row * BDIM + h * BHV + 4 * q; const half_t* o1 = o0 + (size_t)MT * BDIM;
        f4 o[12]; float ss = 0.f;
#pragma unroll
        for (int vt = 0; vt < 12; ++vt) {
            f4 a = (f4){0.f, 0.f, 0.f, 0.f};
#pragma unroll
            for (int ks = 0; ks < 3; ++ks) { a = mma16(*(const h8*)(s0p + (size_t)vt * 16 * BHK + 32 * ks), y0[ks], a); a = mma16(*(const h8*)(s1p + (size_t)vt * 16 * BHK + 32 * ks), y1[ks], a); }
            const h4 i0 = *(const h4*)(o0 + vt * 16), i1 = *(const h4*)(o1 + vt * 16);
#pragma unroll
            for (int r = 0; r < 4; ++r) { a[r] += (float)i0[r] + (float)i1[r]; ss += a[r] * a[r]; }
            o[vt] = a;
        }
        ss += __shfl_xor(ss, 16); ss += __shfl_xor(ss, 32);
        const float rs = rsqrtf(ss * (1.0f / BHV) + 1e-6f);
        const half_t* ogp = P.Plo() + (size_t)row * NLO + LO_OG + h * BHV + 4 * q; half_t* yb = P.YB() + (size_t)row * YCP + h * BHV + 4 * q;
#pragma unroll
        for (int vt = 0; vt < 12; ++vt) { const h4 og = *(const h4*)(ogp + vt * 16); const f4 g = *(const f4*)(ng + vt * 16 + 4 * q); f4 r4;
#pragma unroll
            for (int r = 0; r < 4; ++r) r4[r] = o[vt][r] * rs * g[r] * siluf_((float)og[r]);
            *(h4*)(yb + vt * 16) = to_h4(r4); }
    }
}

template <class FN> __device__ __forceinline__ void acc_foreach_pair(const f4 (&acc)[4][2], FN fn) {
    const int lane = tid_() & 63, w = wid_of(tid_()), wm = w >> 2, wn = w & 3;
#pragma unroll
    for (int mi = 0; mi < 4; ++mi) fn(64 * wm + 16 * mi + (lane & 15), 16 * wn + 4 * (lane >> 4), acc[mi][0], acc[mi][1]);
}
__device__ __forceinline__ float gelu_tanh(float x) { const float u = 0.7978845608028654f * (x + 0.044715f * x * x * x); return 0.5f * x * (1.0f + tanhf(u)); }

__device__ __forceinline__ uint4 s5_u_piece(const Params& P, int g, int m, int k) {
    if (m >= S5ROWS) return zero16();
    const int b = m / 272, n = m - b * 272, row0 = s5_block_row0(b, n);
    return ld16(P.Plo() + (size_t)(row0 + (k >> 4)) * NLO + LO_U + g * 16 + (k & 15));
}
__device__ __forceinline__ void ph_s5g2(const Params& P, int first, int stride) {
    for (int u = first; u < CGR * 9 * 2; u += stride) {
        const int g = u / 18, tm = (u % 18) >> 1, tn = u & 1;
        const half_t* B = P.MstT() + (size_t)g * 256 * 256 + (size_t)tn * 128 * 256;
        f4 acc[4][2]; acc_zero(acc);
        gemm_tile(4, [&](int r, int k) { return s5_u_piece(P, g, tm * 128 + r, k); }, [&](int r, int k) { return ld16(B + r * 256 + k); }, acc);
        acc_foreach(acc, [&](int m, int n, f4 v) { const int mm = tm * 128 + m; if (mm < S5ROWS) *(f4*)(P.Sloc() + ((size_t)g * S5ROWS + mm) * 256 + tn * 128 + n) = v; });
    }
}
__device__ __forceinline__ void ph_s5scan(const Params& P, int l, int first, int stride) {
    for (int blk = first; blk < 32; blk += stride) {
        const int gid = blk * NTHREADS + tid_(), p = gid & 63, d = (gid >> 6) & 1, b = (gid >> 7) & 3, g = gid >> 9;
        const float lr = pin(I_S5LRE)[((l * 2 + d) * CGR + g) * CP + p], li = pin(I_S5LIM)[((l * 2 + d) * CGR + g) * CP + p];
        const float dt = expf(pin(I_S5LDT)[(l * 2 + d) * CGR + g]);
        const float mag = expf(lr * dt * 16.0f), ang = li * dt * 16.0f, ar = mag * cosf(ang), ai = mag * sinf(ang);
        float xr = 0.f, xi = 0.f;
        for (int n0 = 0; n0 < 272; n0 += 16) {
            float sr[16], si[16]; size_t oo[16];
#pragma unroll
            for (int u = 0; u < 16; ++u) { const int ns = n0 + u, nb = d == 0 ? ns : (ns < 16 ? 15 - ns : 287 - ns);
                oo[u] = ((size_t)g * S5ROWS + b * 272 + nb) * 256 + d * 128 + p; sr[u] = P.Sloc()[oo[u]]; si[u] = P.Sloc()[oo[u] + 64]; }
#pragma unroll
            for (int u = 0; u < 16; ++u) { P.XinH()[oo[u]] = (half_t)xr; P.XinH()[oo[u] + 64] = (half_t)xi;
                const float nr = ar * xr - ai * xi + sr[u], ni = ar * xi + ai * xr + si[u]; xr = nr; xi = ni; }
        }
    }
}
__device__ __forceinline__ void ph_s5g1(const Params& P, int l, int first, int stride) {
    const float* s5d = pin(I_S5D) + l * CDIM;
    for (int u = first; u < CGR * 9 * 2; u += stride) {
        const int g = u / 18, tm = (u % 18) >> 1, tn = u & 1;
        const half_t* B = P.McatT() + (size_t)g * 256 * 512 + (size_t)tn * 128 * 512;
        f4 acc[4][2]; acc_zero(acc);
        gemm_tile(8, [&](int r, int k) -> uint4 { const int m = tm * 128 + r; if (k < 256) return s5_u_piece(P, g, m, k); if (m >= S5ROWS) return zero16();
                         return ld16(P.XinH() + ((size_t)g * S5ROWS + m) * 256 + (k - 256)); },
                  [&](int r, int k) { return ld16(B + r * 512 + k); }, acc);
        struct UD { h4 u; f4 d; };
        acc_foreach2(acc, [&](int m, int n) { UD r; const int mm = tm * 128 + m < S5ROWS ? tm * 128 + m : S5ROWS - 1;
            const int nn = tn * 128 + n, tau = nn >> 4, c = nn & 15, b = mm / 272, nb = mm - b * 272, row = s5_block_row0(b, nb) + tau, ch = g * 16 + c;
            r.u = *(const h4*)(P.Plo() + (size_t)row * NLO + LO_U + ch); r.d = *(const f4*)(s5d + ch); return r; },
          [&](int m, int n, f4 v, UD r) { const int mm = tm * 128 + m; if (mm >= S5ROWS) return;
            const int nn = tn * 128 + n, tau = nn >> 4, c = nn & 15, b = mm / 272, nb = mm - b * 272, row = s5_block_row0(b, nb) + tau, ch = g * 16 + c; f4 o;
#pragma unroll
            for (int i = 0; i < 4; ++i) o[i] = gelu_tanh(v[i] + r.d[i] * (float)r.u[i]);
            *(h4*)(P.TC() + (size_t)row * CDIM + ch) = to_h4(o); });
    }
}
__device__ __forceinline__ void ph_glu(const Params& P, int mrows) {
    SchedDense S; S.T.init(mrows / 256, (2 * CDIM) / 256, gridDim.x, bid_()); S.A = (const char*)P.TC(); S.B = (const char*)P.GluT(); S.tstepA = (size_t)256 * CDIM * 2; S.tstepB = (size_t)256 * CDIM * 2;
    pg8::gemm_phase(CDIM, S, [&](const pg8::Acc& acc, const pg8::Unit& u, int wr, int wc, int fr, int fq) {
        pg8::foreach_pair(acc, wr, wc, fr, fq, [&](int m, int hc, f4 a, f4 g) { f4 o;
#pragma unroll
            for (int i = 0; i < 4; ++i) o[i] = a[i] * sigmoidf_(g[i]);
            *(h4*)(P.YC() + (size_t)(u.pm * 256 + m) * CDIM + u.pn * 128 + hc) = to_h4(o); });
    });
}

__device__ __forceinline__ void ph_comb(const Params& P, int l, int mrows) {
    const int tid = tid_();
    for (int u = bid_(); u < (mrows / 128) * 6; u += gridDim.x) {
        const int tm = u / 6, tn = u % 6, m0 = tm * 128, n0 = tn * 128;
        const half_t* A = P.Plo() + (size_t)m0 * NLO + LO_DG; const half_t* B = P.LG2T() + (size_t)n0 * 128;
        f4 acc[4][2]; acc_zero(acc);
        gemm_tile(2, [&](int rr, int k) { return sigm8(ld16(A + (size_t)rr * NLO + k)); }, [&](int rr, int k) { return ld16(B + rr * 128 + k); }, acc);
        struct ZZ { h4 a, b; };
        acc_foreach2(acc, [&](int m, int n) { ZZ z; const size_t o = (size_t)(m0 + m) * ADIM + n0 + n; z.a = *(const h4*)(P.Z() + o); z.b = *(const h4*)(P.Z() + (size_t)MT * ADIM + o); return z; },
          [&](int m, int n, f4 v, ZZ z) { const size_t o = (size_t)(m0 + m) * ADIM + n0 + n; f4 r;
#pragma unroll
            for (int i = 0; i < 4; ++i) r[i] = ((float)z.a[i] + (float)z.b[i]) * v[i];
            *(h4*)(P.YA() + o) = to_h4(r); });
    }
}

struct SchedMerge1 {
    pg8::TileOrder T; const char *a, *b; int nb, br0, K;
    __device__ __forceinline__ bool next(int i, pg8::Unit& u) const { const int t = i / nb, br = i - nb * t; int pm, pn; if (!T.tile(t, pm, pn)) return false; u.pm = pm; u.pn = pn * 4 + br0 + br;
        u.A = a + ((size_t)br * MT + (size_t)pm * 256) * K * 2; u.B = b + ((size_t)br * D + (size_t)pn * 256) * K * 2; return true; }
};
template <class S_> __device__ __forceinline__ void merge1_call(const Params& P, const S_& S, int K) {
    pg8::gemm_phase(K, S, [&](const pg8::Acc& acc, const pg8::Unit& u, int wr, int wc, int fr, int fq) {
        const int br = u.pn & 3, m0 = u.pm * 256, n0 = (u.pn >> 2) * 256;
        struct GO { h4 g, o; };
        pg8::foreach_frag2(acc, wr, wc, fr, fq,
            [&](int m, int n) { GO r; r.g = *(const h4*)(P.Pg() + (size_t)(m0 + m) * NGT + br * D + n0 + n); r.o = (h4){0, 0, 0, 0}; if (br != 0) r.o = *(const h4*)(P.U() + (size_t)(m0 + m) * D + n0 + n); return r; },
            [&](int m, int n, f4 v, GO r) { f4 x;
#pragma unroll
                for (int i = 0; i < 4; ++i) x[i] = (float)r.o[i] + (float)r.g[i] * v[i];
                *(h4*)(P.U() + (size_t)(m0 + m) * D + n0 + n) = to_h4(x); });
    });
}
__device__ __forceinline__ void ph_merge1(const Params& P, int mrows_all) {
    const int mrows = RL;
    if (mrows_all > RL) {
        for (int u = bid_(); u < (RC / 128) * (D / 128); u += gridDim.x) {
            const int tm = u >> 4, tn = u & 15, m0 = RL + tm * 128, n0 = tn * 128;
            f4 tot[4][2]; acc_zero(tot);
#pragma unroll 1
            for (int br = 0; br < 3; ++br) {
                const int K = br == 2 ? CDIM : YCP;
                const half_t* A = (br == 0 ? P.YA() : (br == 1 ? P.YB() : P.YC())) + (size_t)m0 * K;
                const half_t* B = (br == 0 ? P.PaT() : (br == 1 ? P.PbT() : P.PcT())) + (size_t)n0 * K;
                f4 acc[4][2]; acc_zero(acc);
                gemm_tile(K / 64, [&](int r, int k) { return ld16(A + (size_t)r * K + k); }, [&](int r, int k) { return ld16(B + (size_t)r * K + k); }, acc);
                const int lane = tid_() & 63, w = wid_of(tid_()), wm = w >> 2, wn = w & 3;
                h4 gt[4][2];
#pragma unroll
                for (int mi = 0; mi < 4; ++mi)
#pragma unroll
                    for (int ni = 0; ni < 2; ++ni) gt[mi][ni] = *(const h4*)(P.Pg() + (size_t)(m0 + 64 * wm + 16 * mi + (lane & 15)) * NGT + br * D + n0 + 32 * wn + 16 * ni + 4 * (lane >> 4));
#pragma unroll
                for (int mi = 0; mi < 4; ++mi)
#pragma unroll
                    for (int ni = 0; ni < 2; ++ni)
#pragma unroll
                        for (int i = 0; i < 4; ++i) tot[mi][ni][i] += (float)gt[mi][ni][i] * acc[mi][ni][i];
            }
            acc_foreach(tot, [&](int m, int n, f4 v) { *(h4*)(P.U() + (size_t)(m0 + m) * D + n0 + n) = to_h4(v); });
        }
        __syncthreads();
    }
    SchedMerge1 S; S.T.init(mrows / 256, D / 256, gridDim.x, bid_()); S.a = (const char*)P.YA(); S.b = (const char*)P.PaT(); S.nb = 2; S.br0 = 0; S.K = YCP;
    merge1_call(P, S, YCP);
    SchedMerge1 S2; S2.T.init(mrows / 256, D / 256, gridDim.x, bid_()); S2.a = (const char*)P.YC(); S2.b = (const char*)P.PcT(); S2.nb = 1; S2.br0 = 2; S2.K = CDIM;
    merge1_call(P, S2, CDIM);
}
__device__ __forceinline__ void ph_merge2(const Params& P, int l, int mrows_all) {
    const int mrows = RL;
    if (mrows_all > RL) {
        for (int u = bid_(); u < (RC / 128) * (D / 128); u += gridDim.x) {
            const int tm = u >> 4, tn = u & 15, m0 = RL + tm * 128, n0 = tn * 128;
            const half_t* A = P.U() + (size_t)m0 * D; const half_t* B = P.WoT() + (size_t)n0 * D;
            f4 acc[4][2]; acc_zero(acc);
            gemm_tile(D / 64, [&](int r, int k) { return ld16(A + (size_t)r * D + k); }, [&](int r, int k) { return ld16(B + (size_t)r * D + k); }, acc);
            const float* gap = P.MOD() + ((size_t)l * 5 + 4) * (6 * D) + 2 * D + n0;
            struct XG { f4 x, g; };
            acc_foreach2(acc, [&](int m, int n) { XG r; r.x = *(const f4*)(xsrc_ptr(P, m0 + m, l) + n0 + n); r.g = *(const f4*)(gap + n); return r; },
                [&](int m, int n, f4 v, XG r) {
#pragma unroll
                    for (int i = 0; i < 4; ++i) r.x[i] += r.g[i] * v[i];
                    *(f4*)(xrow_ptr(P, m0 + m) + n0 + n) = r.x; });
        }
        __syncthreads();
    }
    SchedDense S; S.T.init(mrows / 256, D / 256, gridDim.x, bid_()); S.A = (const char*)P.U(); S.B = (const char*)P.WoT(); S.tstepA = (size_t)256 * D * 2; S.tstepB = (size_t)256 * D * 2;
    pg8::gemm_phase(D, S, [&](const pg8::Acc& acc, const pg8::Unit& u, int wr, int wc, int fr, int fq) {
        const int m0 = u.pm * 256, n0 = u.pn * 256;
        const float* gap = P.MOD() + ((size_t)l * 5 + modrow_of(m0)) * (6 * D) + 2 * D + n0;
        struct XG { f4 x, g; };
        pg8::foreach_frag2(acc, wr, wc, fr, fq,
            [&](int m, int n) { XG r; r.x = *(const f4*)(xsrc_ptr(P, m0 + m, l) + n0 + n); r.g = *(const f4*)(gap + n); return r; },
            [&](int m, int n, f4 v, XG r) {
#pragma unroll
                for (int i = 0; i < 4; ++i) r.x[i] += r.g[i] * v[i];
                *(f4*)(xrow_ptr(P, m0 + m) + n0 + n) = r.x; });
    });
}

__device__ __forceinline__ void ph_route(const Params& P, int l, int mrows) {
    const int tid = tid_(), lane = tid & 63, gw = bid_() * 8 + wid_of(tid), NW = gridDim.x * 8;
    float* rwT = (float*)smem;
    { const float* rwp = pin(I_RW); for (int i = tid; i < D * NE; i += NTHREADS) rwT[(i & 15) * D + (i >> 4)] = rwp[i]; }
    const float* rbias = pin(I_RB); const float* n2g = pin(I_N2G) + (size_t)l * D;
    __syncthreads();
    for (int row = gw; row < mrows; row += NW) {
        const float* xr = xrow_ptr(P, row); const int mr = modrow_of(row);
        const float* ng = n2g; const float* sh = P.MOD() + ((size_t)l * 5 + mr) * (6 * D) + 3 * D; const float* sc = sh + D;
        f4 v[8]; float ss = 0.f;
#pragma unroll
        for (int j = 0; j < 8; ++j) { v[j] = *(const f4*)(xr + (j * 64 + lane) * 4); ss += (v[j][0] * v[j][0] + v[j][1] * v[j][1]) + (v[j][2] * v[j][2] + v[j][3] * v[j][3]); }
        ss = wave_sum(ss);
        const float rstd = rsqrtf(ss * (1.0f / D) + 1e-6f);
        float lg[NE];
#pragma unroll
        for (int e = 0; e < NE; ++e) lg[e] = 0.f;
        half_t* hr = P.H() + (size_t)row * D;
#pragma unroll
        for (int j = 0; j < 8; ++j) { const int c = (j * 64 + lane) * 4; const f4 g = *(const f4*)(ng + c), s1 = *(const f4*)(sc + c), s0 = *(const f4*)(sh + c); f4 o;
#pragma unroll
            for (int i = 0; i < 4; ++i) o[i] = v[j][i] * rstd * g[i] * (1.0f + s1[i]) + s0[i];
#pragma unroll
            for (int e = 0; e < NE; ++e) { const f4 wv = *(const f4*)(rwT + e * D + c); lg[e] += (o[0] * wv[0] + o[1] * wv[1]) + (o[2] * wv[2] + o[3] * wv[3]); }
            *(h4*)(hr + c) = to_h4(o); asm volatile("" ::: "memory"); }
#pragma unroll
        for (int e = 0; e < NE; ++e) lg[e] = wave_sum(lg[e]);
        float sc16[NE], bi[NE];
#pragma unroll
        for (int e = 0; e < NE; ++e) { sc16[e] = sigmoidf_(lg[e]); bi[e] = sc16[e] + rbias[e]; }
        int gsel = 0; float gbest = -1e30f;
#pragma unroll
        for (int g = 0; g < 4; ++g) { float m1 = -1e30f, m2 = -1e30f;
#pragma unroll
            for (int i = 0; i < 4; ++i) { const float x = bi[4 * g + i]; if (x > m1) { m2 = m1; m1 = x; } else if (x > m2) m2 = x; }
            const float s = m1 + m2; if (s > gbest) { gbest = s; gsel = g; } }
        int i0 = 0, i1 = 0; float b0 = -1e30f, b1 = -1e30f, s0v = 0.f, s1v = 0.f;
#pragma unroll
        for (int e = 0; e < NE; ++e) { const bool in = (e >> 2) == gsel; const float x = bi[e];
            if (in && x > b0) { b1 = b0; i1 = i0; s1v = s0v; b0 = x; i0 = e; s0v = sc16[e]; } else if (in && x > b1) { b1 = x; i1 = e; s1v = sc16[e]; } }
        if (lane == 0) { const float inv = 1.0f / (s0v + s1v);
            P.wsel()[row * 2] = s0v * inv; P.wsel()[row * 2 + 1] = s1v * inv; P.pos()[row * 2] = i0; P.pos()[row * 2 + 1] = i1;
            atomicAdd(&P.cnt()[i0], 1); atomicAdd(&P.cnt()[i1], 1); }
    }
}
__device__ __forceinline__ void seg_starts(const Params& P, int (&st)[NE + 1]) {
    int a = 0;
#pragma unroll
    for (int e = 0; e < NE; ++e) { st[e] = a; a += (P.cnt()[e] + 255) & ~255; }
    st[NE] = a;
}
__device__ __forceinline__ void ph_slot(const Params& P, int mrows) {
    int st[NE + 1]; seg_starts(P, st);
    const int tid = tid_(), lane = tid & 63, gw = bid_() * 8 + wid_of(tid), NW = gridDim.x * 8;
    for (int base = gw * 16; base < mrows; base += NW * 16) {
        int s0 = 0, s1 = 0;
        if (lane < 16) { const int row = base + lane; const int e0 = P.pos()[row * 2], e1 = P.pos()[row * 2 + 1]; int b0 = 0, b1 = 0;
#pragma unroll
            for (int q = 0; q < NE; ++q) { b0 = (q == e0) ? st[q] : b0; b1 = (q == e1) ? st[q] : b1; }
            s0 = b0 + atomicAdd(&P.cursor()[e0], 1); s1 = b1 + atomicAdd(&P.cursor()[e1], 1);
            P.pos()[row * 2] = s0; P.pos()[row * 2 + 1] = s1; }
#pragma unroll 4
        for (int r = 0; r < 16; ++r) {
            const int d0s = __shfl(s0, r), d1s = __shfl(s1, r);
            const uint4* src = (const uint4*)(P.H() + (size_t)(base + r) * D);
            uint4* d0 = (uint4*)(P.Hs() + (size_t)d0s * D); uint4* d1 = (uint4*)(P.Hs() + (size_t)d1s * D);
            const uint4 c0 = src[lane], c1 = src[64 + lane], c2 = src[128 + lane], c3 = src[192 + lane];
            d0[lane] = c0; d0[64 + lane] = c1; d0[128 + lane] = c2; d0[192 + lane] = c3;
            d1[lane] = c0; d1[64 + lane] = c1; d1[128 + lane] = c2; d1[192 + lane] = c3;
        }
    }
}
struct SchedMoe {
    pg8::TileOrder T; const char* A; const char* B; size_t tstepA, tstepB, estepB; int st[NE + 1];
    __device__ __forceinline__ bool next(int i, pg8::Unit& u) const { int pm, pn; if (!T.tile(i, pm, pn)) return false; u.pm = pm; u.pn = pn; const int s0 = pm * 256; int e = 0;
#pragma unroll
        for (int q = 1; q < NE; ++q) e = (s0 >= st[q]) ? q : e;
        u.A = A + (size_t)pm * tstepA; u.B = B + (size_t)e * estepB + (size_t)pn * tstepB; return true; }
};
__device__ __forceinline__ void ph_up(const Params& P) {
    SchedMoe S; seg_starts(P, S.st); S.T.init(S.st[NE] >> 8, (2 * DE) / 256, gridDim.x, bid_());
    S.A = (const char*)P.Hs(); S.B = (const char*)P.W13T(); S.tstepA = (size_t)256 * D * 2; S.tstepB = (size_t)256 * D * 2; S.estepB = (size_t)2 * DE * D * 2;
    pg8::gemm_phase(D, S, [&](const pg8::Acc& acc, const pg8::Unit& u, int wr, int wc, int fr, int fq) {
        pg8::foreach_pair(acc, wr, wc, fr, fq, [&](int m, int hc, f4 a, f4 g) { f4 o;
#pragma unroll
            for (int i = 0; i < 4; ++i) o[i] = siluf_(a[i]) * g[i];
            *(h4*)(P.Hg() + (size_t)(u.pm * 256 + m) * DE + u.pn * 128 + hc) = to_h4(o); });
    });
}
__device__ __forceinline__ void ph_down(const Params& P) {
    SchedMoe S; seg_starts(P, S.st); S.T.init(S.st[NE] >> 8, D / 256, gridDim.x, bid_());
    S.A = (const char*)P.Hg(); S.B = (const char*)P.W2T(); S.tstepA = (size_t)256 * DE * 2; S.tstepB = (size_t)256 * DE * 2; S.estepB = (size_t)D * DE * 2;
    pg8::gemm_phase<true>(DE, S, [&](const pg8::Acc& acc, const pg8::Unit& u, int wr, int wc, int fr, int fq) {
        pg8::foreach_frag8(acc, wr, wc, fr, fq, [&](int m, int n, f4 a, f4 b) { const h4 x = to_h4(a), y = to_h4(b); h8 o;
#pragma unroll
            for (int i = 0; i < 4; ++i) { o[i] = x[i]; o[4 + i] = y[i]; }
            *(h8*)(P.Y() + (size_t)(u.pm * 256 + m) * D + u.pn * 256 + n) = o; });
    });
}

#ifndef PROBE_BAR
#define PROBE_BAR 1
#endif
#define XBAR(b) REP(PROBE_BAR, xcd_barrier(b);)
template <int l> __device__ __forceinline__ void layer_body(const Params& P, const XcdBarrier& bar, const int bid, const int G) {
    constexpr int MR = (l == DEPTH - 1) ? RL : MT;

    if (l == 0) { ph_prologue(P); REP(PROBE_SETUP, ph_setup(P, 0); XBAR(bar);) ph_rows<0>(P, 0); }
    else { ph_setup(P, l); ph_rows<1>(P, l); }
    XBAR(bar);
    REP(PROBE_INPROJ, ph_inproj<0>(P, bid, G); XBAR(bar);)
    REP(PROBE_CONVF, REP(PROBE_CONV1, ph_convf(P, l);) ph_lora(P, l, bid, G); REP(PROBE_S5G2, ph_s5g2(P, bid, G);) XBAR(bar);)
    REP(PROBE_SCANS,
    if (G >= 224) { if (bid < 96) { REP(PROBE_RWKV, ph_rwkv(P, l, bid, 1 << 30);) ph_inproj<1>(P, bid, 96, 96 * GATE_KU, MR); }
                    else if (bid >= G - NCONV) { ph_moe_convert(P, l, 2, 0, MOE_A); ph_inproj<1>(P, bid - (G - NCONV), NCONV, NCONV * CONV_GU, MR); }
                    else { ph_s5scan(P, l, bid - 96, G - 96 - NCONV); ph_gla_a(P, bid - 96, G - 96 - NCONV); ph_inproj<1>(P, NCONV * CONV_GU + bid - 96, G - 96 - NCONV, 1 << 30, MR); } }
    else { ph_rwkv(P, l, bid, G); ph_s5scan(P, l, bid, G); ph_gla_a(P, bid, G); ph_inproj<1>(P, bid, G, 1 << 30, MR); ph_moe_convert(P, l, 2, 0, MOE_A); }
    XBAR(bar);)
    ph_gla_b(P, bid, G); ph_s5g1(P, l, bid, G); ph_comb(P, l, MR); ph_moe_convert(P, l, 0, MOE_A, MOE_A + (6144 - MOE_A) / 2);
    XBAR(bar);
    REP(PROBE_P6, ph_gla_c(P, l, bid, G, l == DEPTH - 1); ph_glu(P, MR);) ph_moe_convert(P, l, 1, MOE_A + (6144 - MOE_A) / 2, 6144); XBAR(bar);
    REP(PROBE_MERGE1, ph_merge1(P, MR); XBAR(bar);)
    ph_merge2(P, l, MR);
    XBAR(bar);
    ph_route(P, l, MR);
    XBAR(bar);
    ph_slot(P, MR);
    XBAR(bar);
    REP(PROBE_MOE, ph_up(P); XBAR(bar); ph_down(P); XBAR(bar);)
    }
__global__ void __launch_bounds__(NTHREADS, 2) k_fused(Params P) {
    const int bid = blockIdx.x, G = gridDim.x;
    volatile LAS unsigned* xbw = (volatile LAS unsigned*)(LAS unsigned char*)(smem + LDS_BYTES - 16);
    if (threadIdx.x == 0) { xbw[0] = 0u; xbw[1] = 0u; xbw[2] = 0u; xbw[3] = 0u; }
    __syncthreads();
    const XcdBarrier bar = xcd_barrier_post(P.bar(), xbw);
    layer_body<0>(P, bar, bid, G);
    layer_body<1>(P, bar, bid, G);
    ph_rows<2>(P, 1);
}

extern "C" void kernel_launch(void* const* d_in, const int* in_sizes, int n_in, void* d_out, int out_size, void* d_ws, size_t ws_size, hipStream_t stream) {
    static int grid = 0;
    if (grid == 0) { int dev = 0, cus = 0; (void)hipGetDevice(&dev); (void)hipDeviceGetAttribute(&cus, hipDeviceAttributeMultiprocessorCount, dev); grid = cus > 0 ? cus : 256;
        (void)hipFuncSetAttribute((const void*)k_fused, hipFuncAttributeMaxDynamicSharedMemorySize, LDS_BYTES); }
    Params P{};
    for (int i = 0; i < 42; ++i) P.in[i] = (const float*)d_in[i];
    P.out = (float*)d_out;
    P.ws = (unsigned char*)d_ws;
    if (WS_TOTAL > ws_size || n_in != 42 || out_size != RL * D) { fprintf(stderr, "kernel_launch: workspace %zu < %zu or bad shapes\n", ws_size, (size_t)WS_TOTAL); return; }
    (void)hipMemsetAsync(P.ws + OFF_bar, 0, XCD_BAR_WORDS * sizeof(unsigned), stream);
    hipLaunchKernelGGL(k_fused, dim3(grid), dim3(NTHREADS), LDS_BYTES, stream, P);
}
```

```cpp
#include <hip/hip_runtime.h>
#include <stdint.h>
#include <stdio.h>

typedef _Float16 half_t;
typedef _Float16 h8 __attribute__((ext_vector_type(8)));
typedef _Float16 h4 __attribute__((ext_vector_type(4)));
typedef _Float16 h2 __attribute__((ext_vector_type(2)));
typedef float f4 __attribute__((ext_vector_type(4)));
typedef float f2 __attribute__((ext_vector_type(2)));

constexpr int D = 2048, NBATCH = 4, SEQ = 4096, CTXL = 256, DEPTH = 2;
constexpr int RL = NBATCH * SEQ, RC = NBATCH * CTXL, MT = RL + RC;
constexpr int TS = SEQ + CTXL;
constexpr int ADIM = 768, AH = 12, BDIM = 768, BKEY = 384, BH = 4, BHK = 96, BHV = 192, CDIM = 512, CGR = 32, CP = 64;
constexpr int CONV = 3840, NLO = 1792, NGT = 6144, INSRC = 11680, INPAD = 11776;
constexpr int LO_DW = 0, LO_DA = 128, LO_DG = 256, LO_BG = 384, LO_OG = 416, LO_U = 1184;
constexpr int NE = 16, DE = 1024;
constexpr int SLOTS = 38912;
constexpr int YCP = 768;
constexpr int S5ROWS = NBATCH * (TS / 16);
constexpr int NTHREADS = 512;
#ifndef PROBE_SETUP
#define PROBE_SETUP 1
#endif
#ifndef PROBE_SCAN
#define PROBE_SCAN 1
#endif
#ifndef PROBE_INPROJ
#define PROBE_INPROJ 1
#endif
#ifndef PROBE_CONVF
#define PROBE_CONVF 1
#endif
#ifndef PROBE_MOE
#define PROBE_MOE 1
#endif
#ifndef PROBE_MERGE1
#define PROBE_MERGE1 1
#endif
#ifndef PROBE_GLA
#define PROBE_GLA 1
#endif
#ifndef PROBE_RWKV
#define PROBE_RWKV 1
#endif
#ifndef GATE_KU
#define GATE_KU 1
#endif
#ifndef PROBE_SCANS
#define PROBE_SCANS 1
#endif
#ifndef RWKV_REP
#define RWKV_REP 1
#endif
#ifndef PROBE_CONV1
#define PROBE_CONV1 1
#endif
#ifndef PROBE_S5G2
#define PROBE_S5G2 1
#endif
#ifndef NCONV
#define NCONV 16
#define CONV_GU 6
#define MOE_A 2048
#endif
#ifndef PROBE_P6
#define PROBE_P6 1
#endif
#define REP_1(...) __VA_ARGS__
#define REP_2(...) __VA_ARGS__ __VA_ARGS__
#define REP_3(...) __VA_ARGS__ __VA_ARGS__ __VA_ARGS__
#define REP_CAT(a, b) a##b
#define REP_X(n, ...) REP_CAT(REP_, n)(__VA_ARGS__)
#define REP(n, ...) REP_X(n, __VA_ARGS__)
#ifndef PROBE_COMB
#define PROBE_COMB 1
#endif
constexpr int LDS_BYTES = 139264;

constexpr size_t al_(size_t x) { return (x + 255) & ~(size_t)255; }
constexpr size_t OFF_bar = 0;
constexpr size_t OFF_cnt = OFF_bar + al_(16384);
constexpr size_t OFF_MOD = OFF_cnt + al_(256);
constexpr size_t OFF_Xc = OFF_MOD + al_((size_t)2 * 5 * 6 * D * 4);
constexpr size_t OFF_pos = OFF_Xc + al_((size_t)RC * D * 4);
constexpr size_t OFF_wsel = OFF_pos + al_((size_t)MT * 2 * 4);
constexpr size_t OFF_WinT = OFF_wsel + al_((size_t)MT * 2 * 4);
constexpr size_t OFF_PaT = OFF_WinT + al_((size_t)INPAD * D * 2);
constexpr size_t OFF_WoT = OFF_PaT + al_((size_t)3 * D * YCP * 2);
constexpr size_t OFF_W13T = OFF_WoT + al_((size_t)D * D * 2);
constexpr size_t OFF_W2T = OFF_W13T + al_((size_t)NE * 2 * DE * D * 2);
constexpr size_t OFF_GluT = OFF_W2T + al_((size_t)NE * D * DE * 2);
constexpr size_t OFF_MstT = OFF_GluT + al_((size_t)2 * CDIM * CDIM * 2);
constexpr size_t OFF_McatT = OFF_MstT + al_((size_t)CGR * 256 * 256 * 2);
constexpr size_t OFF_LW2T = OFF_McatT + al_((size_t)CGR * 256 * 512 * 2);
constexpr size_t OFF_LA2T = OFF_LW2T + al_((size_t)2 * ADIM * 64 * 2);
constexpr size_t OFF_LG2T = OFF_LA2T + al_((size_t)2 * ADIM * 64 * 2);
constexpr size_t OFF_LGLT = OFF_LG2T + al_((size_t)ADIM * 128 * 2);
constexpr size_t OFF_XinH = OFF_LGLT + al_((size_t)2 * BKEY * 64 * 2);
constexpr size_t OFF_H = OFF_XinH + al_((size_t)CGR * S5ROWS * 256 * 2);
constexpr size_t OFF_Pconv = OFF_H + al_((size_t)MT * D * 2);
constexpr size_t OFF_Plo = OFF_Pconv + al_((size_t)MT * CONV * 2);
constexpr size_t OFF_Pg = OFF_Plo + al_((size_t)MT * NLO * 2);
constexpr size_t OFF_F = OFF_Pg + al_((size_t)MT * NGT * 2);
constexpr size_t OFF_KK = OFF_F + al_((size_t)MT * CONV * 2);
constexpr int GLT = 2 * NBATCH * BH * (TS / 64);
constexpr size_t OFF_GS = OFF_KK + al_((size_t)MT * (ADIM * 5 + BKEY * 2) * 2);
constexpr size_t OFF_GQ = OFF_GS + al_((size_t)GLT * BHV * BHK * 2);
constexpr size_t OFF_GE = OFF_GQ + al_((size_t)GLT * 64 * BHK * 2);
constexpr size_t OFF_Sloc = OFF_GE + al_((size_t)GLT * BHK * 4);
constexpr size_t WS_TOTAL = OFF_Sloc + al_((size_t)CGR * S5ROWS * 256 * 4);
static_assert(WS_TOTAL <= (size_t)1416134720, "workspace must fit the guaranteed size (sum of the input bytes)");
static_assert((size_t)SLOTS * D * 2 <= (size_t)MT * (ADIM * 5 + BKEY * 2) * 2, "Hs must fit the feature region");
static_assert((size_t)SLOTS * D * 2 <= (size_t)MT * NGT * 2 && (size_t)SLOTS * DE * 2 <= (size_t)MT * CONV * 2, "Y / Hg must fit");
constexpr size_t OFF_Z = OFF_Pconv, OFF_O = OFF_Pconv + (size_t)2 * MT * ADIM * 2, OFF_Hg = OFF_Pconv, OFF_Y = OFF_Pg;
constexpr size_t OFF_YA = OFF_F, OFF_YB = OFF_YA + (size_t)MT * YCP * 2, OFF_YC = OFF_YB + (size_t)MT * YCP * 2, OFF_TC = OFF_YC + (size_t)MT * CDIM * 2;
constexpr size_t OFF_SW = OFF_KK + (size_t)MT * ADIM * 2, OFF_AA = OFF_SW + (size_t)2 * MT * ADIM * 2, OFF_GG = OFF_AA + (size_t)2 * MT * ADIM * 2, OFF_U = OFF_KK, OFF_Hs = OFF_KK;
constexpr size_t OFF_PbT = OFF_PaT + (size_t)D * YCP * 2, OFF_PcT = OFF_PbT + (size_t)D * YCP * 2, OFF_cursor = OFF_cnt + 64;
#define GAS __attribute__((address_space(1)))
struct Params {
    const float* in[42];
    float* out;
    unsigned char* ws;
#define WSP(type, name) __device__ __forceinline__ type* name() const { GAS unsigned char* w = (GAS unsigned char*)ws; asm volatile("" : "+s"(w)); return (type*)(GAS type*)(w + OFF_##name); }
    WSP(unsigned, bar) WSP(int, cnt) WSP(int, cursor) WSP(float, MOD) WSP(float, Xc) WSP(int, pos) WSP(float, wsel) WSP(float, Sloc)
    WSP(half_t, WinT) WSP(half_t, PaT) WSP(half_t, PbT) WSP(half_t, PcT) WSP(half_t, WoT) WSP(half_t, W13T) WSP(half_t, W2T) WSP(half_t, GluT) WSP(half_t, MstT) WSP(half_t, McatT)
    WSP(half_t, LW2T) WSP(half_t, LA2T) WSP(half_t, LG2T) WSP(half_t, LGLT) WSP(half_t, XinH) WSP(half_t, H) WSP(half_t, Pconv) WSP(half_t, Plo) WSP(half_t, Pg) WSP(half_t, F)
    WSP(half_t, KK) WSP(half_t, SW) WSP(half_t, AA) WSP(half_t, GG) WSP(half_t, Z) WSP(half_t, O) WSP(half_t, TC) WSP(half_t, YA) WSP(half_t, YB) WSP(half_t, YC) WSP(half_t, U)
    WSP(half_t, Hg) WSP(half_t, Y) WSP(half_t, Hs) WSP(half_t, GS) WSP(half_t, GQ) WSP(float, GE)
#undef WSP
};
enum { I_X = 0, I_C, I_CTX, I_CCTX, I_MODW, I_MODB, I_N1G, I_N2G, I_WIN, I_CONVW, I_RKW0, I_RKW2, I_RKA0, I_RKA2, I_RKG2, I_RKKK, I_RKKA, I_RKRK, I_RKGNW, I_RKGNB,
       I_GLAA2, I_GLAAB, I_GLANG, I_S5LRE, I_S5LIM, I_S5LDT, I_S5BRE, I_S5BIM, I_S5CRE, I_S5CIM, I_S5D, I_S5GLU, I_PA, I_PB, I_PC, I_WOUT, I_RW, I_RB, I_W1, I_W3, I_W2, I_FG };

extern __shared__ __attribute__((aligned(16))) unsigned char smem[];

__device__ __forceinline__ float sigmoidf_(float x) { return 1.0f / (1.0f + __expf(-x)); }
__device__ __forceinline__ float siluf_(float x) { return x * sigmoidf_(x); }
__device__ __forceinline__ float wave_sum(float v) {
#pragma unroll
    for (int o = 1; o < 64; o <<= 1) v += __shfl_xor(v, o);
    return v;
}
template <int CTRL> __device__ __forceinline__ float dpp_f(float x) {
    return __builtin_bit_cast(float, __builtin_amdgcn_update_dpp(0, __builtin_bit_cast(int, x), CTRL, 0xf, 0xf, true));
}
__device__ __forceinline__ float red8(float x) { x += dpp_f<0xB1>(x); x += dpp_f<0x4E>(x); x += dpp_f<0x141>(x); return x; }
__device__ __forceinline__ float wave_sum_fast(float x);
__device__ __forceinline__ float red16(float x) { x = red8(x); x += dpp_f<0x140>(x); return x; }
__device__ __forceinline__ void lds_barrier() { asm volatile("s_waitcnt lgkmcnt(0)" ::: "memory"); __builtin_amdgcn_s_barrier(); asm volatile("" ::: "memory"); }
__device__ __forceinline__ float wave_sum_fast(float x) { x = red16(x); const int xi = __builtin_bit_cast(int, x);
    const float a = __builtin_bit_cast(float, __builtin_amdgcn_readlane(xi, 0)), b = __builtin_bit_cast(float, __builtin_amdgcn_readlane(xi, 16));
    const float c = __builtin_bit_cast(float, __builtin_amdgcn_readlane(xi, 32)), d = __builtin_bit_cast(float, __builtin_amdgcn_readlane(xi, 48)); return (a + b) + (c + d); }
__device__ __forceinline__ int modrow_of(int row) { return row < RL ? (row >> 12) : 4; }
__device__ __forceinline__ float* xrow_ptr(const Params& P, int row) { return row < RL ? P.out + (size_t)row * D : P.Xc() + (size_t)(row - RL) * D; }
__device__ __forceinline__ const float* pin(int i);
__device__ __forceinline__ const float* xsrc_ptr(const Params& P, int row, int l) {
    if (l == 0) return row < RL ? pin(I_X) + (size_t)row * D : pin(I_CTX) + (size_t)(row - RL) * D;
    return xrow_ptr(P, row);
}
__device__ __forceinline__ int tokrow(int d, int b, int s) {
    if (s < CTXL) return RL + b * CTXL + (d ? (CTXL - 1 - s) : s);
    const int t = s - CTXL; return b * SEQ + (d ? (SEQ - 1 - t) : t);
}
__device__ __forceinline__ int s5_block_row0(int b, int n) { return n < 16 ? RL + b * CTXL + n * 16 : b * SEQ + (n - 16) * 16; }
__device__ __forceinline__ h4 to_h4(f4 v) { h4 r; r[0] = (half_t)v[0]; r[1] = (half_t)v[1]; r[2] = (half_t)v[2]; r[3] = (half_t)v[3]; return r; }

__device__ __forceinline__ int tid_() { int t = threadIdx.x; asm volatile("" : "+v"(t)); return t; }
__device__ __forceinline__ const float* pin(int i) { asm volatile("" : "+s"(i)); const float* p = ((const float* const __attribute__((address_space(4)))*)__builtin_amdgcn_kernarg_segment_ptr())[i];
    return (const float*)(const GAS float*)p; }
__device__ __forceinline__ int wid_of(int tid) { return __builtin_amdgcn_readfirstlane(tid >> 6); }
__device__ __forceinline__ int bid_() { int b = blockIdx.x; asm volatile("" : "+s"(b)); return b; }
#define XB_TMO      128
#define XB_XCNT(j)  (256  + 64 * (j))
#define XB_XSUB(j)  (1280 + 64 * (j))
#define XB_XGEN(j)  (2304 + 64 * (j))
#define XB_TOP      3328
#define XB_TOPGEN   3392
#define XCD_BAR_WORDS 3456
#define XB_SPIN_CAP (1u << 22)
#define LAS __attribute__((address_space(3)))

__device__ __forceinline__ unsigned xb_ld(unsigned* p)              { return __hip_atomic_load(p, __ATOMIC_RELAXED, __HIP_MEMORY_SCOPE_AGENT); }
__device__ __forceinline__ unsigned xb_add(unsigned* p, unsigned v) { return __hip_atomic_fetch_add(p, v, __ATOMIC_RELAXED, __HIP_MEMORY_SCOPE_AGENT); }
__device__ __forceinline__ unsigned xb_xcc_id() { return (unsigned)__builtin_amdgcn_s_getreg((3 << 11) | 20) & 0xFu; }
#define XB_SPIN(cond, bar) do { unsigned _sp = 0; while (cond) { __builtin_amdgcn_s_sleep(1); \
    if ((++_sp & 255u) == 0u) { if (xb_ld(&(bar)[XB_TMO])) break; if (_sp > XB_SPIN_CAP) { atomicAdd(&(bar)[XB_TMO], 1u); break; } } } } while (0)

struct XcdBarrier {
    unsigned* bar; unsigned x;
    volatile LAS unsigned* st;
};

__device__ __forceinline__ XcdBarrier xcd_barrier_post(unsigned* bar, volatile LAS unsigned* st) {
    XcdBarrier b; b.bar = bar; b.x = xb_xcc_id(); b.st = st;
    if (threadIdx.x == 0) (void)xb_add(&bar[XB_XCNT(b.x)], 1u);
    return b;
}
__device__ __forceinline__ void xcd_barrier_complete(unsigned* bar, unsigned x, unsigned& nloc, unsigned& nx) {
    asm volatile("" : "+s"(x));
    const unsigned G = gridDim.x * gridDim.y * gridDim.z;
    unsigned sum, cnt, mine, sp = 0u;
    for (;;) {
        sum = 0u; cnt = 0u; mine = 0u;
#pragma unroll
        for (unsigned j = 0; j < 16; ++j) { const unsigned c = xb_ld(&bar[XB_XCNT(j)]); sum += c; cnt += (c > 0u) ? 1u : 0u; mine = (j == x) ? c : mine; }
        if (sum == G) break;
        __builtin_amdgcn_s_sleep(1);
        if ((++sp & 255u) == 0u) { if (xb_ld(&bar[XB_TMO])) break; if (sp > XB_SPIN_CAP) { atomicAdd(&bar[XB_TMO], 1u); break; } }
    }
    nloc = mine > 0u ? mine : 1u; nx = cnt > 0u ? cnt : 1u;
}

__device__ __forceinline__ void xcd_barrier(const XcdBarrier& b) {
    asm volatile("s_waitcnt vmcnt(0)" ::: "memory");
    __syncthreads();
    if (threadIdx.x == 0) {
        __attribute__((address_space(1))) unsigned* gbar = (__attribute__((address_space(1))) unsigned*)b.bar; asm volatile("" : "+s"(gbar));
        unsigned* bar = (unsigned*)gbar;
        __builtin_amdgcn_s_waitcnt(0);
        unsigned nloc = b.st[0], nx = b.st[1];
        if (nloc == 0u) { xcd_barrier_complete(bar, b.x, nloc, nx); b.st[0] = nloc; b.st[1] = nx; }
        const unsigned old = xb_add(&bar[XB_XSUB(b.x)], 1u);
        const unsigned gen = old / nloc;
        if (old + 1u == (gen + 1u) * nloc) {
            __builtin_amdgcn_fence(__ATOMIC_RELEASE, "agent");
            asm volatile("s_waitcnt vmcnt(0)" ::: "memory");
            const unsigned og = xb_add(&bar[XB_TOP], 1u);
            const unsigned tg = og / nx;
            if (og + 1u == (tg + 1u) * nx) xb_add(&bar[XB_TOPGEN], 1u);
            else XB_SPIN(xb_ld(&bar[XB_TOPGEN]) == tg, bar);
            __builtin_amdgcn_fence(__ATOMIC_ACQUIRE, "agent");
            xb_add(&bar[XB_XGEN(b.x)], 1u);
            asm volatile("s_waitcnt vmcnt(0)" ::: "memory");
        } else {
            XB_SPIN(xb_ld(&bar[XB_XGEN(b.x)]) == gen, bar);
            __builtin_amdgcn_fence(__ATOMIC_ACQUIRE, "agent");
            asm volatile("s_waitcnt vmcnt(0)" ::: "memory");
        }
    }
    __syncthreads();
}


constexpr int GST = 72;
constexpr int GEMM_LDS = 2 * 2 * 128 * GST * 2;
template <class AF, class BF>
__device__ __forceinline__ void gemm_tile(int nk, AF afn, BF bfn, f4 (&acc)[4][2]) {
    half_t* As = (half_t*)smem; half_t* Bs = As + 2 * 128 * GST;
    const int tid = tid_(), lane = tid & 63, w = wid_of(tid), wm = w >> 2, wn = w & 3;
    const int pr0 = tid >> 3, pk = (tid & 7) * 8;
    uint4 ra[2], rb[2];
#pragma unroll
    for (int i = 0; i < 2; ++i) { ra[i] = afn(pr0 + 64 * i, pk); rb[i] = bfn(pr0 + 64 * i, pk); }
    __syncthreads();
#pragma unroll
    for (int i = 0; i < 2; ++i) { *(uint4*)(As + (pr0 + 64 * i) * GST + pk) = ra[i]; *(uint4*)(Bs + (pr0 + 64 * i) * GST + pk) = rb[i]; }
    __syncthreads();
    for (int kt = 0; kt < nk; ++kt) {
        const int cur = kt & 1;
        if (kt + 1 < nk) {
#pragma unroll
            for (int i = 0; i < 2; ++i) { ra[i] = afn(pr0 + 64 * i, (kt + 1) * 64 + pk); rb[i] = bfn(pr0 + 64 * i, (kt + 1) * 64 + pk); }
        }
        const half_t* Ac = As + cur * 128 * GST; const half_t* Bc = Bs + cur * 128 * GST;
#pragma unroll
        for (int ks = 0; ks < 2; ++ks) {
            h8 af[4], bf[2];
#pragma unroll
            for (int mi = 0; mi < 4; ++mi) af[mi] = *(const h8*)(Ac + (64 * wm + 16 * mi + (lane & 15)) * GST + 32 * ks + 8 * (lane >> 4));
#pragma unroll
            for (int ni = 0; ni < 2; ++ni) bf[ni] = *(const h8*)(Bc + (32 * wn + 16 * ni + (lane & 15)) * GST + 32 * ks + 8 * (lane >> 4));
#pragma unroll
            for (int mi = 0; mi < 4; ++mi)
#pragma unroll
                for (int ni = 0; ni < 2; ++ni) acc[mi][ni] = __builtin_amdgcn_mfma_f32_16x16x32_f16(bf[ni], af[mi], acc[mi][ni], 0, 0, 0);
        }
        if (kt + 1 < nk) {
            half_t* An = As + (cur ^ 1) * 128 * GST; half_t* Bn = Bs + (cur ^ 1) * 128 * GST;
#pragma unroll
            for (int i = 0; i < 2; ++i) { *(uint4*)(An + (pr0 + 64 * i) * GST + pk) = ra[i]; *(uint4*)(Bn + (pr0 + 64 * i) * GST + pk) = rb[i]; }
        }
        __syncthreads();
    }
}
__device__ __forceinline__ void acc_zero(f4 (&acc)[4][2]) {
#pragma unroll
    for (int mi = 0; mi < 4; ++mi)
#pragma unroll
        for (int ni = 0; ni < 2; ++ni) acc[mi][ni] = (f4){0.f, 0.f, 0.f, 0.f};
}
template <class FN> __device__ __forceinline__ void acc_foreach(const f4 (&acc)[4][2], FN fn) {
    const int lane = tid_() & 63, w = wid_of(tid_()), wm = w >> 2, wn = w & 3;
#pragma unroll
    for (int mi = 0; mi < 4; ++mi)
#pragma unroll
        for (int ni = 0; ni < 2; ++ni) fn(64 * wm + 16 * mi + (lane & 15), 32 * wn + 16 * ni + 4 * (lane >> 4), acc[mi][ni]);
}
template <class LD, class ST> __device__ __forceinline__ void acc_foreach2(const f4 (&acc)[4][2], LD ld, ST st) {
    const int lane = tid_() & 63, w = wid_of(tid_()), wm = w >> 2, wn = w & 3;
    decltype(ld(0, 0)) tmp[4][2];
#pragma unroll
    for (int mi = 0; mi < 4; ++mi)
#pragma unroll
        for (int ni = 0; ni < 2; ++ni) tmp[mi][ni] = ld(64 * wm + 16 * mi + (lane & 15), 32 * wn + 16 * ni + 4 * (lane >> 4));
#pragma unroll
    for (int mi = 0; mi < 4; ++mi)
#pragma unroll
        for (int ni = 0; ni < 2; ++ni) st(64 * wm + 16 * mi + (lane & 15), 32 * wn + 16 * ni + 4 * (lane >> 4), acc[mi][ni], tmp[mi][ni]);
}
__device__ __forceinline__ uint4 ld16(const half_t* p) { return *(const uint4*)p; }
__device__ __forceinline__ uint4 zero16() { return make_uint4(0u, 0u, 0u, 0u); }

namespace pg8 {
constexpr int BM = 256, BK = 64, HALF = 128, HTB = HALF * BK * 2, STAGE_BYTES = 8 * HTB, NXCD = 8, WGM = 8;
__host__ __device__ __forceinline__ int lds_byte(int r, int c) { const int st = (r >> 4) * 2 + (c >> 5), rr = r & 15, cc = c & 31, ob = rr * 64 + cc * 2; return st * 1024 + (ob ^ (((ob >> 9) & 1) << 5)); }
__host__ __device__ __forceinline__ void stage_rc(int b, int& R, int& C) { const int st = b / 1024, sb = b % 1024, swz = sb ^ (((sb >> 9) & 1) << 5); R = (st >> 1) * 16 + swz / 64; C = (st & 1) * 32 + (swz % 64) / 2; }
__host__ __device__ __forceinline__ int perm32(int rho) { const int n = rho >> 4, i = rho & 15; return 8 * (i >> 2) + 4 * n + (i & 3); }
struct Unit { const char* A; const char* B; int pm, pn; };
struct TileOrder {
    int nM, nN, nwg, G, c, lim;
    __device__ __forceinline__ void init(int nM_, int nN_, int G_, int c_, int lim_ = 1 << 30) { nM = nM_; nN = nN_; nwg = nM * nN; G = G_; c = c_; lim = lim_ < nwg ? lim_ : nwg; }
    __device__ __forceinline__ bool tile(int i, int& pm, int& pn) const {
        const long L = (long)i * G + c; if (L >= lim) return false;
        int wgid = (int)L; { const int q = nwg / NXCD, r = nwg % NXCD, xcd = wgid % NXCD, off = wgid / NXCD; wgid = (xcd < r ? xcd * (q + 1) : r * (q + 1) + (xcd - r) * q) + off; }
        const int nig = WGM * nN, gid = wgid / nig, fm = gid * WGM, gsz = (nM - fm) < WGM ? (nM - fm) : WGM;
        pm = fm + ((wgid % nig) % gsz); pn = (wgid % nig) / gsz; return true;
    }
};
typedef f4 Acc[2][2][4][2];
template <bool PERM = false, class Sched, class Epi>
__device__ __forceinline__ void gemm_phase(const int K, const Sched& S, const Epi& E) {
    LAS unsigned char* lds = (LAS unsigned char*)smem;
    const int tid = tid_(), wid = __builtin_amdgcn_readfirstlane(tid >> 6), lane = tid & 63, wr = wid >> 2, wc = wid & 3, fr = lane & 15, fq = lane >> 4;
    const int nt = K / BK;
    unsigned voff[2], voffB[2];
#pragma unroll
    for (int i = 0; i < 2; ++i) { int R, C; stage_rc(tid * 16 + i * 8192, R, C); const int Rb = PERM ? ((R & ~31) + perm32(R & 31)) : R; voff[i] = (unsigned)(R * K + C) * 2u; voffB[i] = (unsigned)(Rb * K + C) * 2u; }
    const size_t kstep = (size_t)(BK * 2);
    const size_t hstep = (size_t)HALF * K * 2;
    const unsigned ldsw = (unsigned)wid * 1024u;
    const int aoff = lds_byte(wr * 64 + fr, fq * 8), boff = lds_byte(wc * 32 + fr, fq * 8);
#define PG8_SA(b, h) (((b) * 2 + (h)) * HTB)
#define PG8_SB(b, h) ((4 + (b) * 2 + (h)) * HTB)
#define PG8_STAGEV(bufoff, gbase, vo) do { _Pragma("unroll") for (int _i = 0; _i < 2; ++_i) \
        __builtin_amdgcn_global_load_lds((const unsigned*)((const char*)(gbase) + vo[_i]), (LAS unsigned*)(lds + (bufoff) + ldsw + _i * 8192), 16, 0, 0); } while (0)
#define PG8_STAGE(bufoff, gbase) PG8_STAGEV(bufoff, gbase, voff)
#define PG8_STAGEB(bufoff, gbase) PG8_STAGEV(bufoff, gbase, voffB)
#define PG8_LDA(dst, b, h) do { _Pragma("unroll") for (int m = 0; m < 4; ++m) _Pragma("unroll") for (int k = 0; k < 2; ++k) dst[m][k] = *(const LAS h8*)(lds + PG8_SA(b, h) + aoff + m * 2048 + k * 1024); } while (0)
#define PG8_LDB(dst, b, h) do { _Pragma("unroll") for (int n = 0; n < 2; ++n) _Pragma("unroll") for (int k = 0; k < 2; ++k) dst[n][k] = *(const LAS h8*)(lds + PG8_SB(b, h) + boff + n * 2048 + k * 1024); } while (0)
#define PG8_MMA(ai, bj, At, Bt) do { __builtin_amdgcn_s_setprio(1); _Pragma("unroll") for (int m = 0; m < 4; ++m) _Pragma("unroll") for (int n = 0; n < 2; ++n) _Pragma("unroll") for (int k = 0; k < 2; ++k) \
        acc[ai][bj][m][n] = __builtin_amdgcn_mfma_f32_16x16x32_f16(Bt[n][k], At[m][k], acc[ai][bj][m][n], 0, 0, 0); __builtin_amdgcn_s_setprio(0); } while (0)
#define PG8_WAIT_V(n) asm volatile("s_waitcnt vmcnt(" #n ")" ::: "memory")
#define PG8_WAIT_L(n) asm volatile("s_waitcnt lgkmcnt(" #n ")" ::: "memory")
#define PG8_BAR __builtin_amdgcn_s_barrier()
#define PG8_SCHED __builtin_amdgcn_sched_barrier(0)
    Unit cur, nxt; int ui = 0;
    if (!S.next(0, cur)) return;
    Acc acc;
#pragma unroll
    for (int a = 0; a < 2; ++a)
#pragma unroll
        for (int b = 0; b < 2; ++b)
#pragma unroll
            for (int m = 0; m < 4; ++m)
#pragma unroll
                for (int n = 0; n < 2; ++n) acc[a][b][m][n] = (f4){0.f, 0.f, 0.f, 0.f};
    h8 At[4][2], B0[2][2], B1[2][2];
    const char* cA = cur.A; const char* cB = cur.B;
    PG8_STAGEB(PG8_SB(0, 0), cB); PG8_STAGE(PG8_SA(0, 0), cA); PG8_STAGEB(PG8_SB(0, 1), cB + hstep); PG8_STAGE(PG8_SA(0, 1), cA + hstep);
    if (wr == 1) PG8_BAR;
    PG8_WAIT_V(4); PG8_BAR;
    PG8_STAGEB(PG8_SB(1, 0), cB + kstep); PG8_STAGE(PG8_SA(1, 0), cA + kstep); PG8_STAGEB(PG8_SB(1, 1), cB + hstep + kstep);
    PG8_WAIT_V(6); PG8_BAR;
    for (;;) {
        const bool has_next = S.next(ui + 1, nxt);
        const char* nA = has_next ? nxt.A : cA; const char* nB = has_next ? nxt.B : cB;
        for (int t = 0; t < nt; t += 2) {
            const bool last = (t == nt - 2);
            const char* a1 = cA + (size_t)(t + 1) * kstep;
            const char* a2 = last ? nA : cA + (size_t)(t + 2) * kstep; const char* b2 = last ? nB : cB + (size_t)(t + 2) * kstep;
            const char* a3 = a2 + kstep; const char* b3 = b2 + kstep;
            PG8_LDB(B0, 0, 0); PG8_SCHED; PG8_LDA(At, 0, 0); PG8_STAGE(PG8_SA(1, 1), a1 + hstep);
            PG8_WAIT_L(8); PG8_BAR; PG8_WAIT_L(0); PG8_MMA(0, 0, At, B0); PG8_BAR; PG8_SCHED;
            PG8_LDB(B1, 0, 1); PG8_STAGEB(PG8_SB(0, 0), b2);
            PG8_BAR; PG8_WAIT_L(0); PG8_MMA(0, 1, At, B1); PG8_BAR;
            PG8_LDA(At, 0, 1); PG8_STAGE(PG8_SA(0, 0), a2);
            PG8_BAR; PG8_WAIT_L(0); PG8_MMA(1, 0, At, B0); PG8_BAR; PG8_SCHED;
            PG8_STAGEB(PG8_SB(0, 1), b2 + hstep);
            PG8_WAIT_V(6); PG8_BAR; PG8_MMA(1, 1, At, B1); PG8_BAR;
            PG8_LDB(B0, 1, 0); PG8_SCHED; PG8_LDA(At, 1, 0); PG8_STAGE(PG8_SA(0, 1), a2 + hstep);
            PG8_WAIT_L(8); PG8_BAR; PG8_WAIT_L(0); PG8_MMA(0, 0, At, B0); PG8_BAR; PG8_SCHED;
            PG8_LDB(B1, 1, 1); PG8_STAGEB(PG8_SB(1, 0), b3);
            PG8_BAR; PG8_WAIT_L(0); PG8_MMA(0, 1, At, B1); PG8_BAR;
            PG8_LDA(At, 1, 1); PG8_STAGE(PG8_SA(1, 0), a3);
            PG8_BAR; PG8_WAIT_L(0); PG8_MMA(1, 0, At, B0); PG8_BAR; PG8_SCHED;
            PG8_STAGEB(PG8_SB(1, 1), b3 + hstep);
            PG8_WAIT_V(6); PG8_BAR; PG8_MMA(1, 1, At, B1); PG8_BAR;
        }
        E(acc, cur, wr, wc, fr, fq);
        if (!has_next) break;
#pragma unroll
        for (int a = 0; a < 2; ++a)
#pragma unroll
            for (int b = 0; b < 2; ++b)
#pragma unroll
                for (int m = 0; m < 4; ++m)
#pragma unroll
                    for (int n = 0; n < 2; ++n) acc[a][b][m][n] = (f4){0.f, 0.f, 0.f, 0.f};
        cur = nxt; cA = nA; cB = nB; ++ui;
    }
    PG8_WAIT_V(0);
    if (wr == 0) PG8_BAR;
    PG8_BAR;
#undef PG8_SA
#undef PG8_SB
#undef PG8_STAGE
#undef PG8_STAGEB
#undef PG8_STAGEV
#undef PG8_LDA
#undef PG8_LDB
#undef PG8_MMA
#undef PG8_WAIT_V
#undef PG8_WAIT_L
#undef PG8_BAR
#undef PG8_SCHED
}
template <class FN> __device__ __forceinline__ void foreach_frag(const Acc& acc, int wr, int wc, int fr, int fq, FN fn) {
#pragma unroll
    for (int ai = 0; ai < 2; ++ai)
#pragma unroll
        for (int m = 0; m < 4; ++m)
        { int row = ai * HALF + wr * 64 + m * 16 + fr; asm volatile("" : "+v"(row));
#pragma unroll
            for (int bj = 0; bj < 2; ++bj)
#pragma unroll
                for (int n = 0; n < 2; ++n) fn(row, bj * HALF + wc * 32 + n * 16 + 4 * fq, acc[ai][bj][m][n]); }
}
template <class FN> __device__ __forceinline__ void foreach_frag8(const Acc& acc, int wr, int wc, int fr, int fq, FN fn) {
#pragma unroll
    for (int ai = 0; ai < 2; ++ai)
#pragma unroll
        for (int m = 0; m < 4; ++m)
        { int row = ai * HALF + wr * 64 + m * 16 + fr; asm volatile("" : "+v"(row));
#pragma unroll
            for (int bj = 0; bj < 2; ++bj) fn(row, bj * HALF + wc * 32 + 8 * fq, acc[ai][bj][m][0], acc[ai][bj][m][1]); }
}
template <class LD, class ST> __device__ __forceinline__ void foreach_frag2(const Acc& acc, int wr, int wc, int fr, int fq, LD ld, ST st) {
#pragma unroll
    for (int ai = 0; ai < 2; ++ai)
#pragma unroll
        for (int mp = 0; mp < 2; ++mp) {
            int row0 = ai * HALF + wr * 64 + mp * 32 + fr; asm volatile("" : "+v"(row0));
            decltype(ld(0, 0)) tmp[2][2][2];
#pragma unroll
            for (int mm = 0; mm < 2; ++mm)
#pragma unroll
                for (int bj = 0; bj < 2; ++bj)
#pragma unroll
                    for (int n = 0; n < 2; ++n) tmp[mm][bj][n] = ld(row0 + 16 * mm, bj * HALF + wc * 32 + n * 16 + 4 * fq);
#pragma unroll
            for (int mm = 0; mm < 2; ++mm)
#pragma unroll
                for (int bj = 0; bj < 2; ++bj)
#pragma unroll
                    for (int n = 0; n < 2; ++n) st(row0 + 16 * mm, bj * HALF + wc * 32 + n * 16 + 4 * fq, acc[ai][bj][2 * mp + mm][n], tmp[mm][bj][n]);
        }
}
template <class FN> __device__ __forceinline__ void foreach_pair(const Acc& acc, int wr, int wc, int fr, int fq, FN fn) {
#pragma unroll
    for (int ai = 0; ai < 2; ++ai)
#pragma unroll
        for (int m = 0; m < 4; ++m)
        { int row = ai * HALF + wr * 64 + m * 16 + fr; asm volatile("" : "+v"(row));
#pragma unroll
            for (int bj = 0; bj < 2; ++bj) fn(row, bj * 64 + wc * 16 + 4 * fq, acc[ai][bj][m][0], acc[ai][bj][m][1]); }
}
}

__device__ __forceinline__ void ph_prologue(const Params& P) {
    const int tid = tid_(), G = gridDim.x, bid = bid_();
    float* cs = (float*)smem;
    float* red = cs + 5 * D;
    for (int i = tid; i < 5 * D; i += NTHREADS) { const int r = i / D, k = i % D; const float v = r < 4 ? pin(I_C)[r * D + k] : pin(I_CCTX)[k]; cs[i] = siluf_(v); }
    __syncthreads();
    const int lane = tid & 63, w = wid_of(tid);
    for (int t = bid; t < 2 * 96; t += G) {
        const int l = t / 96, n0 = (t % 96) * 128;
        const float* W = pin(I_MODW) + (size_t)l * D * (6 * D) + n0 + 2 * lane;
        float a[5][2];
#pragma unroll
        for (int r = 0; r < 5; ++r) { a[r][0] = 0.f; a[r][1] = 0.f; }
#pragma unroll 16
        for (int k = w * 256; k < w * 256 + 256; ++k) {
            const f2 wv = *(const f2*)(W + (size_t)k * (6 * D));
#pragma unroll
            for (int r = 0; r < 5; ++r) { const float c = cs[r * D + k]; a[r][0] += c * wv[0]; a[r][1] += c * wv[1]; }
        }
#pragma unroll
        for (int r = 0; r < 5; ++r) { red[(w * 5 + r) * 128 + 2 * lane] = a[r][0]; red[(w * 5 + r) * 128 + 2 * lane + 1] = a[r][1]; }
        __syncthreads();
        for (int i = tid; i < 5 * 128; i += NTHREADS) {
            const int r = i / 128, n = i % 128; float s = 0.f;
#pragma unroll
            for (int ww = 0; ww < 8; ++ww) s += red[(ww * 5 + r) * 128 + n];
            P.MOD()[((size_t)l * 5 + r) * (6 * D) + n0 + n] = s + pin(I_MODB)[(size_t)l * 6 * D + n0 + n];
        }
        __syncthreads();
    }
}

template <int KT = 1, class CF> __device__ __forceinline__ void convert_tile(half_t* dst, int K, int ld, int tn, int tk, CF colptr, int kmax = 1 << 30) {
    float* st = (float*)smem;
    const int tid = tid_(), n0 = tn * 64, k0 = tk * 64 * KT;
    {
        const int nl = tid & 63, kk = wid_of(tid); bool ok = true; const float* cp = colptr(n0 + nl, ok);
        float v[8 * KT];
#pragma unroll
        for (int i = 0; i < 8 * KT; ++i) { const int k = kk + 8 * i; const bool kin = (k0 + k) < kmax; v[i] = cp[(size_t)(kin ? k0 + k : 0) * ld]; v[i] = (ok && kin) ? v[i] : 0.f; }
#pragma unroll
        for (int i = 0; i < 8 * KT; ++i) st[(kk + 8 * i) * 65 + nl] = v[i];
    }
    __syncthreads();
    {
        const int nl = tid >> 3, kc = (tid & 7) * 8;
#pragma unroll
        for (int j = 0; j < KT; ++j) { h8 v;
#pragma unroll
            for (int i = 0; i < 8; ++i) v[i] = (half_t)st[(64 * j + kc + i) * 65 + nl];
            *(h8*)(dst + (size_t)(n0 + nl) * K + k0 + 64 * j + kc) = v; }
    }
    __syncthreads();
}
template <class CF> __device__ __forceinline__ void convert_wide(half_t* dst, int K, int ld, int tn, int tk, CF colptr4) {
    float* st = (float*)smem;
    const int tid = tid_(), n0 = tn * 256, k0 = tk * 64;
    {
        const int ng = (tid & 63) * 4, kk = wid_of(tid); bool ok = true; const float* cp = colptr4(n0 + ng, ok);
        f4 v[8];
#pragma unroll
        for (int i = 0; i < 8; ++i) { v[i] = *(const f4*)(cp + (size_t)(k0 + kk + 8 * i) * ld); if (!ok) v[i] = (f4){0.f, 0.f, 0.f, 0.f}; }
#pragma unroll
        for (int i = 0; i < 8; ++i) { const int k = kk + 8 * i; *(f4*)(st + k * 260 + (ng ^ (8 * ((k >> 3) & 3)))) = v[i]; }
    }
    __syncthreads();
#pragma unroll
    for (int j = 0; j < 4; ++j) { const int pidx = tid + NTHREADS * j, nl = pidx >> 3, kc = (pidx & 7) * 8, nsw = nl ^ (8 * ((kc >> 3) & 3)); h8 v;
#pragma unroll
        for (int i = 0; i < 8; ++i) v[i] = (half_t)st[(kc + i) * 260 + nsw];
        *(h8*)(dst + (size_t)(n0 + nl) * K + k0 + kc) = v; }
    __syncthreads();
}
__device__ __forceinline__ void ph_setup(const Params& P, int l_in) {
    const int l = l_in;
    const int G = gridDim.x, bid = bid_(), tid = tid_();
    constexpr int T_WIN = (INPAD / 256) * (D / 64), T_PA = (D / 64) * (ADIM / 64), T_PB = T_PA, T_PC = (D / 64) * (CDIM / 64), T_WO = (D / 256) * (D / 64);
    constexpr int T_LW = 2 * (ADIM / 64), T_LA = T_LW, T_LG = (ADIM / 64) * 2, T_LL = 2 * (BKEY / 64);
    constexpr int T_W13 = NE * (2 * DE / 256) * (D / 64), T_W2 = NE * (D / 256) * (DE / 64), T_GLU = (2 * CDIM / 64) * (CDIM / 64);
    constexpr int T_ALL = T_WIN + T_PA + T_PB + T_PC + T_WO + T_GLU + T_LW + T_LA + T_LG + T_LL;
    const bool s5blk = (G == 256) && bid < 32;
    const int t_first = (G != 256) ? bid : (s5blk ? 224 + (bid % 24) + 248 * (bid / 24) : bid - 32), t_step = (G != 256) ? G : 248;
    for (int tq = t_first, qi = bid; tq < T_ALL; ) {
        const int t = tq;
        if (s5blk) { qi += 32; tq = 248 * (qi / 24) + 224 + (qi % 24); } else tq += t_step;
        int r = t, l = l_in; asm volatile("" : "+s"(l));

        if (r < T_WIN) { const float* src = pin(I_WIN) + (size_t)l * D * INSRC;
            convert_wide(P.WinT(), D, INSRC, r / (D / 64), r % (D / 64), [&](int n, bool& ok) -> const float* { ok = !(n >= 5536 && n < 5632); return src + (n < 5536 ? n : (n < 5632 ? 0 : n - 96)); }); continue; } r -= T_WIN;
        if (r < T_PA) { const float* src = pin(I_PA) + (size_t)l * ADIM * D; convert_tile(P.PaT(), ADIM, D, r / (ADIM / 64), r % (ADIM / 64), [&](int n, bool&) -> const float* { return src + n; }); continue; } r -= T_PA;
        if (r < T_PB) { const float* src = pin(I_PB) + (size_t)l * BDIM * D; convert_tile(P.PbT(), BDIM, D, r / (BDIM / 64), r % (BDIM / 64), [&](int n, bool&) -> const float* { return src + n; }); continue; } r -= T_PB;
        if (r < T_PC) { const float* src = pin(I_PC) + (size_t)l * CDIM * D; convert_tile(P.PcT(), CDIM, D, r / (CDIM / 64), r % (CDIM / 64), [&](int n, bool&) -> const float* { return src + n; }); continue; } r -= T_PC;
        if (r < T_LW) { const int d = r / (ADIM / 64); const float* src = pin(I_RKW2) + (size_t)(l * 2 + d) * 64 * ADIM; convert_tile(P.LW2T() + (size_t)d * ADIM * 64, 64, ADIM, r % (ADIM / 64), 0, [&](int n, bool&) -> const float* { return src + n; }); continue; } r -= T_LW;
        if (r < T_LA) { const int d = r / (ADIM / 64); const float* src = pin(I_RKA2) + (size_t)(l * 2 + d) * 64 * ADIM; convert_tile(P.LA2T() + (size_t)d * ADIM * 64, 64, ADIM, r % (ADIM / 64), 0, [&](int n, bool&) -> const float* { return src + n; }); continue; } r -= T_LA;
        if (r < T_LG) { const float* src = pin(I_RKG2) + (size_t)l * 128 * ADIM; convert_tile(P.LG2T(), 128, ADIM, r >> 1, r & 1, [&](int n, bool&) -> const float* { return src + n; }); continue; } r -= T_LG;
        if (r < T_LL) { const int d = r / (BKEY / 64); const float* src = pin(I_GLAA2) + (size_t)(l * 2 + d) * 16 * BKEY; convert_tile(P.LGLT() + (size_t)d * BKEY * 64, 64, BKEY, r % (BKEY / 64), 0, [&](int n, bool&) -> const float* { return src + n; }, 16); continue; } r -= T_LL;
        if (r < T_WO) { const float* src = pin(I_WOUT) + (size_t)l * D * D; convert_wide(P.WoT(), D, D, r / (D / 64), r % (D / 64), [&](int n, bool&) -> const float* { return src + n; }); continue; } r -= T_WO;
        { const float* src = pin(I_S5GLU) + (size_t)l * CDIM * 2 * CDIM;
            convert_tile(P.GluT(), CDIM, 2 * CDIM, r / (CDIM / 64), r % (CDIM / 64),
                         [&](int n, bool&) -> const float* { const int j = n >> 5, wi = n & 31; return wi < 16 ? src + 16 * j + wi : src + CDIM + 16 * j + wi - 16; }); }
    }
    float* apr = (float*)smem;
    float* api = apr + 2 * 17 * 64;
    float* bbr = api + 2 * 17 * 64;
    float* bbi = bbr + 2 * 64 * 16;
    float* cre = bbi + 2 * 64 * 16;
    float* cim = cre + 16 * 64;
    float* kern = cim + 16 * 64;
    for (int g = bid; g < CGR; g += G) {
        __syncthreads();
        for (int i = tid; i < 2 * 17 * 64; i += NTHREADS) {
            const int d = i / (17 * 64), tau = (i / 64) % 17, p = i % 64;
            const float lr = pin(I_S5LRE)[((l * 2 + d) * CGR + g) * CP + p], li = pin(I_S5LIM)[((l * 2 + d) * CGR + g) * CP + p];
            const float dt = expf(pin(I_S5LDT)[(l * 2 + d) * CGR + g]);
            const float mag = expf(lr * dt * (float)tau), ang = li * dt * (float)tau;
            apr[i] = mag * cosf(ang); api[i] = mag * sinf(ang);
        }
        for (int i = tid; i < 16 * 64; i += NTHREADS) { cre[i] = pin(I_S5CRE)[((size_t)l * CGR + g) * 16 * 64 + i]; cim[i] = pin(I_S5CIM)[((size_t)l * CGR + g) * 16 * 64 + i]; }
        __syncthreads();
        for (int i = tid; i < 2 * 64 * 16; i += NTHREADS) {
            const int d = i / (64 * 16), p = (i / 16) % 64, c = i % 16;
            const float lr = pin(I_S5LRE)[((l * 2 + d) * CGR + g) * CP + p], li = pin(I_S5LIM)[((l * 2 + d) * CGR + g) * CP + p];
            const float ar = apr[(d * 17 + 1) * 64 + p], ai = api[(d * 17 + 1) * 64 + p], den = lr * lr + li * li;
            const float fr = ((ar - 1.0f) * lr + ai * li) / den, fi = (ai * lr - (ar - 1.0f) * li) / den;
            const float br = pin(I_S5BRE)[(((size_t)l * CGR + g) * CP + p) * 16 + c], bi = pin(I_S5BIM)[(((size_t)l * CGR + g) * CP + p) * 16 + c];
            bbr[i] = fr * br - fi * bi; bbi[i] = fr * bi + fi * br;
        }
        __syncthreads();
        for (int i = tid; i < 2 * 16 * 16 * 16; i += NTHREADS) {
            const int d = i >> 12, tau = (i >> 8) & 15, c = (i >> 4) & 15, c2 = i & 15; float s = 0.f;
            for (int p = 0; p < 64; ++p) {
                const float ar = apr[(d * 17 + tau) * 64 + p], ai = api[(d * 17 + tau) * 64 + p], br = bbr[(d * 64 + p) * 16 + c2], bi = bbi[(d * 64 + p) * 16 + c2];
                const float er = ar * br - ai * bi, ei = ar * bi + ai * br;
                s += cre[c * 64 + p] * er - cim[c * 64 + p] * ei;
            }
            kern[i] = s;
        }
        __syncthreads();
        half_t* Mst = P.MstT() + (size_t)g * 256 * 256; half_t* Mcat = P.McatT() + (size_t)g * 256 * 512;
        for (int i = tid; i < 256 * 256; i += NTHREADS) {
            const int n = i >> 8, k = i & 255, d = n >> 7, q = n & 127, p = q & 63, tau = k >> 4, c2 = k & 15;
            const int pw = d ? tau : 15 - tau;
            const float ar = apr[(d * 17 + pw) * 64 + p], ai = api[(d * 17 + pw) * 64 + p], br = bbr[(d * 64 + p) * 16 + c2], bi = bbi[(d * 64 + p) * 16 + c2];
            Mst[i] = (half_t)(q < 64 ? ar * br - ai * bi : ar * bi + ai * br);
        }
        for (int i = tid; i < 256 * 512; i += NTHREADS) {
            const int n = i >> 9, k = i & 511, tau = n >> 4, c = n & 15; float v;
            if (k < 256) { const int t2 = k >> 4, c2 = k & 15; v = 0.f;
                if (t2 <= tau) v += kern[((0 * 16 + (tau - t2)) * 16 + c) * 16 + c2];
                if (t2 >= tau) v += kern[((1 * 16 + (t2 - tau)) * 16 + c) * 16 + c2];
            } else { const int kk = k - 256, d = kk >> 7, q = kk & 127, p = q & 63, pw = d ? 16 - tau : tau + 1;
                const float ar = apr[(d * 17 + pw) * 64 + p], ai = api[(d * 17 + pw) * 64 + p];
                v = q < 64 ? cre[c * 64 + p] * ar - cim[c * 64 + p] * ai : -(cre[c * 64 + p] * ai + cim[c * 64 + p] * ar);
            }
            Mcat[i] = (half_t)v;
        }
    }
    if (bid == 0 && tid < 64) { P.cnt()[tid] = 0; }
}

__device__ __forceinline__ void ph_moe_convert(const Params& P, int l, int qn, int t_begin, int t_end) {
    constexpr int T_W13 = NE * (2 * DE / 256) * (D / 64);
    int* head = P.cnt() + 32 + qn; int* slot = (int*)(smem + 131072 + 1024);
    const int lim = t_end;
    for (;;) {
        __syncthreads();
        if (tid_() == 0) *slot = t_begin + atomicAdd(head, 2);
        __syncthreads();
        const int t0 = *slot;
        if (t0 >= lim) break;
#pragma unroll 1
        for (int q = 0; q < 2; ++q) { int r = t0 + q; if (r >= lim) break;
            if (r < T_W13) { const int e = r / ((2 * DE / 256) * (D / 64)), rr = r % ((2 * DE / 256) * (D / 64));
                const float* s1 = pin(I_W1) + ((size_t)l * NE + e) * D * DE; const float* s3 = pin(I_W3) + ((size_t)l * NE + e) * D * DE;
                convert_wide(P.W13T() + (size_t)e * 2 * DE * D, D, DE, rr / (D / 64), rr % (D / 64),
                             [&](int n, bool&) -> const float* { const int j = n >> 5, wi = n & 31; return wi < 16 ? s1 + 16 * j + wi : s3 + 16 * j + wi - 16; }); }
            else { r -= T_W13; const int e = r / ((D / 256) * (DE / 64)), rr = r % ((D / 256) * (DE / 64)); const float* src = pin(I_W2) + ((size_t)l * NE + e) * DE * D;
                convert_wide(P.W2T() + (size_t)e * D * DE, DE, D, rr / (DE / 64), rr % (DE / 64), [&](int n, bool&) -> const float* { return src + n; }); } }
    }
}
template <int MODE> __device__ __forceinline__ void ph_rows(const Params& P, int l) {
    const int lane = tid_() & 63, gw = bid_() * 8 + wid_of(tid_()), NW = gridDim.x * 8;
    const int nrows = MODE == 2 ? RL : MT;
    const float* gvec = MODE == 2 ? pin(I_FG) : pin(I_N1G) + (size_t)l * D;
    for (int row = gw; row < nrows; row += NW) {
        float* xr = xrow_ptr(P, row); const float* xs = MODE == 0 ? xsrc_ptr(P, row, 0) : xr; const int mr = modrow_of(row);
        f4 v[8]; float ss = 0.f;
#pragma unroll
        for (int j = 0; j < 8; ++j) v[j] = *(const f4*)(xs + (j * 64 + lane) * 4);
        if (MODE >= 1) {
            const int lp = MODE == 2 ? 1 : l - 1;
            const float* ga2 = P.MOD() + ((size_t)lp * 5 + mr) * (6 * D) + 5 * D;
            const int p0 = P.pos()[row * 2], p1 = P.pos()[row * 2 + 1]; const float w0 = P.wsel()[row * 2], w1 = P.wsel()[row * 2 + 1];
            const half_t* y0 = P.Y() + (size_t)p0 * D; const half_t* y1 = P.Y() + (size_t)p1 * D;
#pragma unroll
            for (int j = 0; j < 8; ++j) {
                const int c = (j * 64 + lane) * 4; const h4 a = *(const h4*)(y0 + c), b = *(const h4*)(y1 + c); const f4 g = *(const f4*)(ga2 + c);
#pragma unroll
                for (int i = 0; i < 4; ++i) v[j][i] += g[i] * (w0 * (float)a[i] + w1 * (float)b[i]);
            }
            if (MODE == 1) {
#pragma unroll
                for (int j = 0; j < 8; ++j) *(f4*)(xr + (j * 64 + lane) * 4) = v[j];
            }
        }
#pragma unroll
        for (int j = 0; j < 8; ++j) ss += (v[j][0] * v[j][0] + v[j][1] * v[j][1]) + (v[j][2] * v[j][2] + v[j][3] * v[j][3]);
        ss = wave_sum(ss);
        const float rstd = rsqrtf(ss * (1.0f / D) + 1e-6f);
        if (MODE == 2) {
            const float* fg = gvec;
#pragma unroll
            for (int j = 0; j < 8; ++j) { const int c = (j * 64 + lane) * 4; const f4 g = *(const f4*)(fg + c); f4 o;
#pragma unroll
                for (int i = 0; i < 4; ++i) o[i] = v[j][i] * rstd * g[i];
                *(f4*)(xr + c) = o; }
        } else {
            const float* ng = gvec; const float* sh = P.MOD() + ((size_t)l * 5 + mr) * (6 * D); const float* sc = sh + D;
            half_t* hr = P.H() + (size_t)row * D;
#pragma unroll
            for (int j = 0; j < 8; ++j) { const int c = (j * 64 + lane) * 4; const f4 g = *(const f4*)(ng + c), s1 = *(const f4*)(sc + c), s0 = *(const f4*)(sh + c); f4 o;
#pragma unroll
                for (int i = 0; i < 4; ++i) o[i] = v[j][i] * rstd * g[i] * (1.0f + s1[i]) + s0[i];
                *(h4*)(hr + c) = to_h4(o); }
        }
    }
}

struct SchedDense {
    pg8::TileOrder T; const char* A; const char* B; size_t tstepA, tstepB;
    __device__ __forceinline__ bool next(int i, pg8::Unit& u) const { int pm, pn; if (!T.tile(i, pm, pn)) return false; u.pm = pm; u.pn = pn; u.A = A + (size_t)pm * tstepA; u.B = B + (size_t)pn * tstepB; return true; }
};
template <int PART> __device__ __forceinline__ void ph_inproj(const Params& P, int c, int G, int lim = 1 << 30, int mrows = MT) {
    constexpr int NT0 = (CONV + NLO) / 256, NT1 = NGT / 256, NTOFF = PART ? NT0 : 0;
    SchedDense S; S.T.init(mrows / 256, PART ? NT1 : NT0, G, c, lim); S.A = (const char*)P.H(); S.B = (const char*)(P.WinT() + (size_t)NTOFF * 256 * D); S.tstepA = (size_t)256 * D * 2; S.tstepB = (size_t)256 * D * 2;
    pg8::gemm_phase<true>(D, S, [&](const pg8::Acc& acc, const pg8::Unit& u, int wr, int wc, int fr, int fq) {
        const int m0 = u.pm * 256, n0 = (u.pn + NTOFF) * 256;
        auto st8 = [](half_t* p, f4 a, f4 b) { const h4 x = to_h4(a), y = to_h4(b); h8 o; for (int i = 0; i < 4; ++i) { o[i] = x[i]; o[4 + i] = y[i]; } *(h8*)p = o; };
        if (PART) pg8::foreach_frag8(acc, wr, wc, fr, fq, [&](int m, int n, f4 a, f4 b) { for (int i = 0; i < 4; ++i) { a[i] = sigmoidf_(a[i]); b[i] = sigmoidf_(b[i]); } st8(P.Pg() + (size_t)(m0 + m) * NGT + (n0 - CONV - NLO) + n, a, b); });
        else if (n0 < CONV) pg8::foreach_frag8(acc, wr, wc, fr, fq, [&](int m, int n, f4 a, f4 b) { st8(P.Pconv() + (size_t)(m0 + m) * CONV + n0 + n, a, b); });
        else pg8::foreach_frag8(acc, wr, wc, fr, fq, [&](int m, int n, f4 a, f4 b) { st8(P.Plo() + (size_t)(m0 + m) * NLO + (n0 - CONV) + n, a, b); });
    });
}

__device__ __forceinline__ void ph_convf(const Params& P, int l) {
    const int tid = tid_();
    const float* cw = pin(I_CONVW) + (size_t)l * 9 * CONV;
    for (int it = bid_(); it < MT / 16; it += gridDim.x) {
        const int row0 = it * 16;
        int rows, cols, gi, gj0, base;
        if (row0 < RL) { const int t = row0 & (SEQ - 1); rows = 64; cols = 64; gi = t >> 6; gj0 = t & 63; base = row0 - t; }
        else { const int t = (row0 - RL) & (CTXL - 1); rows = 1; cols = CTXL; gi = 0; gj0 = t; base = row0 - t; }
        __syncthreads();
#pragma unroll 1
        for (int rnd = 0; rnd < 2; ++rnd) {
            const int c0 = (tid + NTHREADS * rnd) * 4;
            if (c0 < CONV) {
                float wt[3][3][4];
#pragma unroll
                for (int u = 0; u < 3; ++u)
#pragma unroll
                    for (int v = 0; v < 3; ++v) { const f4 a = *(const f4*)(cw + (u * 3 + v) * CONV + c0);
#pragma unroll
                        for (int i = 0; i < 4; ++i) wt[u][v][i] = a[i]; }
                h4 win[3][3];
                const h4 hz = {0, 0, 0, 0};
                auto ldp = [&](int u, int j) -> h4 { const int gr = gi + u - 1; if (gr < 0 || gr >= rows || j < 0 || j >= cols) return hz; return *(const h4*)(P.Pconv() + (size_t)(base + gr * cols + j) * CONV + c0); };
#pragma unroll
                for (int u = 0; u < 3; ++u) { win[u][0] = ldp(u, gj0 - 1); win[u][1] = ldp(u, gj0); }
                const bool is_k = (c0 >= ADIM && c0 < 2 * ADIM);
                f4 kkw = (f4){0.f, 0.f, 0.f, 0.f};
                if (is_k) kkw = *(const f4*)(pin(I_RKKK) + l * ADIM + c0 - ADIM);
#pragma unroll 1
                for (int jb = 0; jb < 16; jb += 4) {
                    h4 nw[3][4];
#pragma unroll
                    for (int e = 0; e < 4; ++e)
#pragma unroll
                        for (int u = 0; u < 3; ++u) nw[u][e] = ldp(u, gj0 + jb + e + 1);
                    f4 ov[4], qv[4];
#pragma unroll
                    for (int e = 0; e < 4; ++e) {
#pragma unroll
                        for (int u = 0; u < 3; ++u) win[u][2] = nw[u][e];
                        f4 o = (f4){0.f, 0.f, 0.f, 0.f};
#pragma unroll
                        for (int u = 0; u < 3; ++u)
#pragma unroll
                            for (int v = 0; v < 3; ++v)
#pragma unroll
                                for (int i = 0; i < 4; ++i) o[i] += (float)win[u][v][i] * wt[u][v][i];
                        ov[e] = o;
                        {
                            f4 q; float sq = 0.f;
#pragma unroll
                            for (int i = 0; i < 4; ++i) { q[i] = o[i] * kkw[i]; sq += q[i] * q[i]; }
                            sq = red16(sq);
                            const float inv = rsqrtf(sq + 1e-12f);
#pragma unroll
                            for (int i = 0; i < 4; ++i) q[i] *= inv;
                            qv[e] = q;
                        }
#pragma unroll
                        for (int u = 0; u < 3; ++u) { win[u][0] = win[u][1]; win[u][1] = win[u][2]; }
                    }
#pragma unroll
                    for (int e = 0; e < 4; ++e) { *(h4*)(P.F() + (size_t)(row0 + jb + e) * CONV + c0) = to_h4(ov[e]);
                        if (is_k) *(h4*)(P.KK() + (size_t)(row0 + jb + e) * ADIM + c0 - ADIM) = to_h4(qv[e]); }
                }
            }
        }
    }
}

__device__ __forceinline__ uint4 tanh8(uint4 x) { h8 v = __builtin_bit_cast(h8, x);
#pragma unroll
    for (int i = 0; i < 8; ++i) v[i] = (half_t)tanhf((float)v[i]);
    return __builtin_bit_cast(uint4, v); }
__device__ __forceinline__ uint4 sigm8(uint4 x) { h8 v = __builtin_bit_cast(h8, x);
#pragma unroll
    for (int i = 0; i < 8; ++i) v[i] = (half_t)sigmoidf_((float)v[i]);
    return __builtin_bit_cast(uint4, v); }
__device__ __forceinline__ void ph_lora(const Params& P, int l, int first, int stride) {
    constexpr int NTM = MT / 128;
    half_t* As = (half_t*)smem; half_t* Bs = As + 128 * GST;
    const int tid = tid_(), lane = tid & 63, w = wid_of(tid), wm = w >> 2, wn = w & 3, pr0 = tid >> 3, pk = (tid & 7) * 8;
    for (int u = first; u < 6 * NTM; u += stride) {
        const int kind = u / NTM, tm = u - kind * NTM, m0 = tm * 128, d = kind & 1, cls = kind >> 1;
        const int ncol = cls == 2 ? BKEY : ADIM, nnt = ncol / 128;
        const half_t* A = P.Plo() + (size_t)m0 * NLO + (cls == 0 ? LO_DW + d * 64 : (cls == 1 ? LO_DA + d * 64 : LO_BG + d * 16));
        const half_t* B = (cls == 0 ? P.LW2T() : (cls == 1 ? P.LA2T() : P.LGLT())) + (size_t)d * ncol * 64;
        const float* bw = pin(I_RKW0); const float* ba = pin(I_RKA0); const float* bg = pin(I_GLAAB);
        const float* bias = (cls == 0 ? bw : (cls == 1 ? ba : bg)) + (l * 2 + d) * ncol;
        half_t* O = (cls == 0 ? P.SW() : (cls == 1 ? P.AA() : P.GG())) + ((size_t)d * MT + m0) * ncol;
        uint4 ra[2], rb[2];
#pragma unroll
        for (int i = 0; i < 2; ++i) { uint4 x = (cls == 2 && pk >= 16) ? zero16() : ld16(A + (size_t)(pr0 + 64 * i) * NLO + pk); if (cls == 0) x = tanh8(x); ra[i] = x; rb[i] = ld16(B + (size_t)(pr0 + 64 * i) * 64 + pk); }
        __syncthreads();
#pragma unroll
        for (int i = 0; i < 2; ++i) *(uint4*)(As + (pr0 + 64 * i) * GST + pk) = ra[i];
        for (int nt = 0; nt < nnt; ++nt) {
            half_t* Bc = Bs + (nt & 1) * 128 * GST;
#pragma unroll
            for (int i = 0; i < 2; ++i) *(uint4*)(Bc + (pr0 + 64 * i) * GST + pk) = rb[i];
            if (nt + 1 < nnt) {
#pragma unroll
                for (int i = 0; i < 2; ++i) rb[i] = ld16(B + (size_t)((nt + 1) * 128 + pr0 + 64 * i) * 64 + pk); }
            const f4 bb0 = *(const f4*)(bias + nt * 128 + 32 * wn + 4 * (lane >> 4)), bb1 = *(const f4*)(bias + nt * 128 + 32 * wn + 16 + 4 * (lane >> 4));
            __syncthreads();
            f4 acc[4][2]; acc_zero(acc);
#pragma unroll
            for (int ks = 0; ks < 2; ++ks) {
                h8 af[4], bf[2];
#pragma unroll
                for (int mi = 0; mi < 4; ++mi) af[mi] = *(const h8*)(As + (64 * wm + 16 * mi + (lane & 15)) * GST + 32 * ks + 8 * (lane >> 4));
#pragma unroll
                for (int ni = 0; ni < 2; ++ni) bf[ni] = *(const h8*)(Bc + (32 * wn + 16 * ni + (lane & 15)) * GST + 32 * ks + 8 * (lane >> 4));
#pragma unroll
                for (int mi = 0; mi < 4; ++mi)
#pragma unroll
                    for (int ni = 0; ni < 2; ++ni) acc[mi][ni] = __builtin_amdgcn_mfma_f32_16x16x32_f16(bf[ni], af[mi], acc[mi][ni], 0, 0, 0);
            }
#pragma unroll
            for (int mi = 0; mi < 4; ++mi)
#pragma unroll
                for (int ni = 0; ni < 2; ++ni) { const f4 bb = ni ? bb1 : bb0; const int m = 64 * wm + 16 * mi + (lane & 15), n = nt * 128 + 32 * wn + 16 * ni + 4 * (lane >> 4); f4 o;
#pragma unroll
                    for (int i = 0; i < 4; ++i) { const float x = acc[mi][ni][i] + bb[i]; o[i] = cls == 2 ? (fminf(x, 0.f) - log1pf(__expf(-fabsf(x)))) * (1.0f / 16.0f) : sigmoidf_(x); }
                    *(h4*)(O + (size_t)m * ncol + n) = to_h4(o); }
        }
    }
    __syncthreads();
}

__device__ __forceinline__ h8 ldfrag(const half_t* base, int stride, int row0, int red0, int lane) { return *(const h8*)(base + (row0 + (lane & 15)) * stride + red0 + 8 * (lane >> 4)); }
__device__ __forceinline__ half_t clamp_h(float x) { return (half_t)__builtin_amdgcn_fmed3f(x, -60000.f, 60000.f); }
__device__ __forceinline__ f4 mma16(h8 x, h8 y, f4 c) { return __builtin_amdgcn_mfma_f32_16x16x32_f16(x, y, c, 0, 0, 0); }
__device__ __forceinline__ void ph_rwkv(const Params& P, int l, int first_item, int stride) {
    constexpr int CH = 32, SK = 72, ST = 40;
    const int tid = tid_(), lane = tid & 63, w = wid_of(tid), q = lane >> 4, i16 = lane & 15;
    half_t* Kt = (half_t*)smem; half_t* Rt = Kt + CH * SK; half_t* Bt = Rt + CH * SK; half_t* Dt = Bt + CH * SK; half_t* Wm = Dt + CH * SK; half_t* HTs = Wm + CH * SK;
    half_t* KtT = HTs + 64 * SK; half_t* DhT = KtT + 64 * ST; half_t* BhTn = DhT + 64 * ST; half_t* VT = BhTn + 64 * ST; half_t* UT = VT + 64 * ST; half_t* G1T = UT + 64 * ST;
    half_t* Akd = G1T + 64 * ST; half_t* Ard = Akd + CH * ST; half_t* Arbn = Ard + CH * ST;
    half_t* Pn0 = Arbn + CH * ST; half_t* Pn1 = Pn0 + CH * ST; half_t* PT0 = Pn1 + CH * ST; half_t* PT1 = PT0 + CH * ST; half_t* Tn0 = PT1 + CH * ST; half_t* Tn1 = Tn0 + CH * ST;
    float* Lc = (float*)(Tn1 + CH * ST);
    float* segt = Lc + CH * 64;
    float* gC = segt + 8 * 64; float* gref = gC + 64; float* bonus = gref + 64; float* Yb = bonus + 128;
    for (int item = first_item; item < 2 * NBATCH * AH; item += stride) {
        const int d = item / (NBATCH * AH), b = (item / AH) % NBATCH, h = item % AH;
        const half_t* SWd = P.SW() + (size_t)d * MT * ADIM + h * 64; const half_t* AAd = P.AA() + (size_t)d * MT * ADIM + h * 64; half_t* Zd = P.Z() + (size_t)d * MT * ADIM + h * 64;
        const half_t* Fh = P.F() + h * 64; const half_t* KKh = P.KK() + h * 64;
        const float* kap = pin(I_RKKA) + l * ADIM + h * 64; const float* rkp = pin(I_RKRK) + l * ADIM + h * 64;
        const float* gnw = pin(I_RKGNW) + l * ADIM + h * 64; const float* gnb = pin(I_RKGNB) + l * ADIM + h * 64;
        const int ck = tid & 63, seg = w;
        const float ka_c = kap[ck], rk_c = rkp[ck];
        f4 accH[2];
        accH[0] = (f4){0.f, 0.f, 0.f, 0.f}; accH[1] = (f4){0.f, 0.f, 0.f, 0.f};
        unsigned pr[4], pk[4], pv[4], pkk[4], psw[4], pa[4];
        auto ldu = [](const half_t* p) -> unsigned { return (unsigned)*(const unsigned short*)p; };
        auto h2f = [](unsigned u) -> float { return (float)__builtin_bit_cast(half_t, (unsigned short)u); };
        auto prefetch = [&](int s0) {
#pragma unroll
            for (int i = 0; i < 4; ++i) { const int row = __builtin_amdgcn_readfirstlane(tokrow(d, b, s0 + 4 * seg + i)); const half_t* f = Fh + (size_t)row * CONV + ck;
                pr[i] = ldu(f); pk[i] = ldu(f + ADIM); pv[i] = ldu(f + 2 * ADIM); pkk[i] = ldu(KKh + (size_t)row * ADIM + ck); psw[i] = ldu(SWd + (size_t)row * ADIM + ck); pa[i] = ldu(AAd + (size_t)row * ADIM + ck); }
        };
        prefetch(0);
        for (int s0 = 0; s0 < TS; s0 += CH) {
            float rr[4], kdv[4], bb[4], kkv[4], vv[4], Lv[4];
            { float run = 0.f;
#pragma unroll
              for (int i = 0; i < 4; ++i) { const float a = h2f(pa[i]), kk = h2f(pkk[i]), k = h2f(pk[i]);
                  rr[i] = h2f(pr[i]); vv[i] = h2f(pv[i]); kkv[i] = kk; kdv[i] = k * (1.0f + (a - 1.0f) * ka_c); bb[i] = kk * a; run += -0.6065306597126334f * h2f(psw[i]); Lv[i] = run; } }
            lds_barrier();
            segt[seg * 64 + ck] = Lv[3];
            if (s0 + CH < TS) prefetch(s0 + CH);
            lds_barrier();
            { float off = 0.f;
#pragma unroll
              for (int sg = 0; sg < 7; ++sg) off += segt[sg * 64 + ck] * (sg < seg ? 1.0f : 0.0f);
#pragma unroll
              for (int i = 0; i < 4; ++i) { Lv[i] += off; Lc[(4 * seg + i) * 64 + ck] = Lv[i]; }
              { const float v0 = rr[0] * kdv[0] * rk_c, v1 = rr[1] * kdv[1] * rk_c, v2 = rr[2] * kdv[2] * rk_c, v3 = rr[3] * kdv[3] * rk_c;
                const bool o1 = lane & 1, o2 = lane & 2;
                const float s01 = (o1 ? v1 : v0) + dpp_f<0xB1>(o1 ? v0 : v1), s23 = (o1 ? v3 : v2) + dpp_f<0xB1>(o1 ? v2 : v3);
                float sv = (o2 ? s23 : s01) + dpp_f<0x4E>(o2 ? s01 : s23);
                sv += dpp_f<0x124>(sv); sv += dpp_f<0x128>(sv);
                if (i16 < 4) bonus[(4 * seg + i16) * 4 + q] = sv; }
            }
            lds_barrier();
            { const float Lref = Lc[15 * 64 + ck], L31 = Lc[31 * 64 + ck];
              if (seg == 0) { gC[ck] = __expf(L31); gref[ck] = __expf(Lref); }
              h4 ktp, dhp, bhp, vtp;
              const float c3 = __expf(L31 - Lref); float eprev = __expf(((seg == 0) ? 0.f : Lc[(4 * seg - 1) * 64 + ck]) - Lref);
#pragma unroll
              for (int i = 0; i < 4; ++i) { const int t = 4 * seg + i; const float Lt = Lv[i];
                  const float ep = eprev, et = __expf(Lt - Lref), er = __builtin_amdgcn_rcpf(et), e3 = c3 * er; eprev = et;
                  const half_t ktv = (half_t)(kkv[i] * ep);
                  Kt[t * SK + ck] = ktv; ktp[i] = ktv; Rt[t * SK + ck] = clamp_h(rr[i] * et); Bt[t * SK + ck] = (half_t)(bb[i] * er); Dt[t * SK + ck] = clamp_h(kdv[i] * er);
                  dhp[i] = (half_t)(kdv[i] * e3); bhp[i] = (half_t)(-bb[i] * e3); vtp[i] = (half_t)vv[i]; }
              *(h4*)(KtT + ck * ST + 4 * seg) = ktp; *(h4*)(DhT + ck * ST + 4 * seg) = dhp; *(h4*)(BhTn + ck * ST + 4 * seg) = bhp; *(h4*)(VT + ck * ST + 4 * seg) = vtp;
            }
            lds_barrier();
#pragma unroll
            for (int x = 0; x < 2; ++x) { const int id = 2 * w + x, kt = id >> 2, vt = id & 3, k0 = kt * 16 + 4 * q; h4 hv;
#pragma unroll
                for (int r = 0; r < 4; ++r) hv[r] = (half_t)(accH[x][r] * gref[k0 + r]);
                *(h4*)(HTs + (vt * 16 + i16) * SK + k0) = hv; }
            for (int rwrep = 0; rwrep < RWKV_REP; ++rwrep) {
            {   const int mat = w >> 1, tt = w & 1, incl = (mat >> 1) & 1;
                const half_t* X = (mat & 1) ? Dt : Bt; const half_t* Yp = (mat & 2) ? Rt : Kt; const float sgn = mat == 2 ? -1.0f : 1.0f;
                half_t* dst = mat == 0 ? Pn0 : (mat == 1 ? Akd : (mat == 2 ? Arbn : Ard));
                const h8 y0 = ldfrag(Yp, SK, tt * 16, 0, lane), y1 = ldfrag(Yp, SK, tt * 16, 32, lane);
                const int t = tt * 16 + i16;
#pragma unroll
                for (int ts = 0; ts < 2; ++ts) {
                    f4 acc = mma16(ldfrag(X, SK, ts * 16, 0, lane), y0, (f4){0.f, 0.f, 0.f, 0.f}); acc = mma16(ldfrag(X, SK, ts * 16, 32, lane), y1, acc);
                    const int sb = ts * 16 + 4 * q; h4 av;
#pragma unroll
                    for (int r = 0; r < 4; ++r) av[r] = (half_t)(sgn * __builtin_amdgcn_fmed3f((sb + r < t + incl) ? acc[r] : 0.f, -60000.f, 60000.f));
                    *(h4*)(dst + t * ST + sb) = av;
                    if (mat == 0) { h4 tv;
#pragma unroll
                        for (int r = 0; r < 4; ++r) { PT0[(sb + r) * ST + t] = av[r]; tv[r] = (half_t)(((sb + r == t) ? 1.0f : 0.f) - (float)av[r]); }
                        *(h4*)(Tn0 + t * ST + sb) = tv; }
                }
            }
            lds_barrier();
            {   half_t* Pc = Pn0; half_t* PTc = PT0; half_t* Pq = Pn1; half_t* PTq = PT1; half_t* Tc = Tn0; half_t* Tq = Tn1;
                const int tl = w & 3, t0 = (tl >> 1) * 16, c0 = (tl & 1) * 16;
#pragma unroll
                for (int lev = 0; lev < 5; ++lev) {
                    if (w >= 4) {
                        if (lev < 4) {
                            f4 acc = mma16(ldfrag(Pc, ST, t0, 0, lane), ldfrag(PTc, ST, c0, 0, lane), (f4){0.f, 0.f, 0.f, 0.f});
                            const int tb = t0 + 4 * q, sc = c0 + i16; h4 pv4;
#pragma unroll
                            for (int r = 0; r < 4; ++r) { pv4[r] = (half_t)acc[r]; Pq[(tb + r) * ST + sc] = pv4[r]; }
                            *(h4*)(PTq + sc * ST + tb) = pv4;
                        }
                    } else if (lev > 0) {
                        f4 acc = mma16(ldfrag(Tc, ST, t0, 0, lane), ldfrag(PTc, ST, c0, 0, lane), (f4){0.f, 0.f, 0.f, 0.f});
                        const int tb = t0 + 4 * q, sc = c0 + i16;
#pragma unroll
                        for (int r = 0; r < 4; ++r) Tq[(tb + r) * ST + sc] = (half_t)(acc[r] + (float)Tc[(tb + r) * ST + sc]);
                    }
                    lds_barrier();
                    if (lev < 4) { half_t* tp = Pc; Pc = Pq; Pq = tp; tp = PTc; PTc = PTq; PTq = tp; }
                    if (lev > 0) { half_t* tp = Tc; Tc = Tq; Tq = tp; }
                }
                {   const int kt = w >> 1, tt = w & 1;
                    f4 acc = mma16(ldfrag(KtT, ST, kt * 16, 0, lane), ldfrag(Tc, ST, tt * 16, 0, lane), (f4){0.f, 0.f, 0.f, 0.f});
                    h4 wv;
#pragma unroll
                    for (int r = 0; r < 4; ++r) wv[r] = (half_t)__builtin_amdgcn_fmed3f(acc[r], -60000.f, 60000.f);
                    *(h4*)(Wm + (tt * 16 + i16) * SK + kt * 16 + 4 * q) = wv;
                    const int t2 = w >> 2, vt = w & 3;
                    f4 acc2 = mma16(ldfrag(Akd, ST, t2 * 16, 0, lane), ldfrag(VT, ST, vt * 16, 0, lane), (f4){0.f, 0.f, 0.f, 0.f});
                    h4 gv;
#pragma unroll
                    for (int r = 0; r < 4; ++r) gv[r] = (half_t)__builtin_amdgcn_fmed3f(acc2[r], -60000.f, 60000.f);
                    *(h4*)(G1T + (vt * 16 + i16) * ST + t2 * 16 + 4 * q) = gv;
                }
                lds_barrier();
                {   const int t2 = w >> 2, vt = w & 3;
                    f4 acc = mma16(ldfrag(Tc, ST, t2 * 16, 0, lane), ldfrag(G1T, ST, vt * 16, 0, lane), (f4){0.f, 0.f, 0.f, 0.f});
#pragma unroll
                    for (int ks = 0; ks < 2; ++ks) acc = mma16(ldfrag(Wm, SK, t2 * 16, ks * 32, lane), ldfrag(HTs, SK, vt * 16, ks * 32, lane), acc);
                    h4 uv;
#pragma unroll
                    for (int r = 0; r < 4; ++r) uv[r] = (half_t)__builtin_amdgcn_fmed3f(acc[r], -60000.f, 60000.f);
                    *(h4*)(UT + (vt * 16 + i16) * ST + t2 * 16 + 4 * q) = uv;
                }
            }
            lds_barrier();
            }
            {   const int vt = w >> 1, tt = w & 1;
                f4 acc = (f4){0.f, 0.f, 0.f, 0.f};
#pragma unroll
                for (int ks = 0; ks < 2; ++ks) acc = mma16(ldfrag(HTs, SK, vt * 16, ks * 32, lane), ldfrag(Rt, SK, tt * 16, ks * 32, lane), acc);
                acc = mma16(ldfrag(VT, ST, vt * 16, 0, lane), ldfrag(Ard, ST, tt * 16, 0, lane), acc);
                acc = mma16(ldfrag(UT, ST, vt * 16, 0, lane), ldfrag(Arbn, ST, tt * 16, 0, lane), acc);
                *(f4*)(Yb + (tt * 16 + i16) * 68 + vt * 16 + 4 * q) = acc;
#pragma unroll
                for (int x = 0; x < 2; ++x) { const int id = 2 * w + x, kt = id >> 2, v2 = id & 3, k0 = kt * 16 + 4 * q;
#pragma unroll
                    for (int r = 0; r < 4; ++r) accH[x][r] *= gC[k0 + r];
                    accH[x] = mma16(ldfrag(DhT, ST, kt * 16, 0, lane), ldfrag(VT, ST, v2 * 16, 0, lane), accH[x]);
                    accH[x] = mma16(ldfrag(BhTn, ST, kt * 16, 0, lane), ldfrag(UT, ST, v2 * 16, 0, lane), accH[x]); }
            }
            lds_barrier();
            {   const int t = tid >> 4, c = 4 * (tid & 15), row = tokrow(d, b, s0 + t);
                const f4 y = *(const f4*)(Yb + t * 68 + c); const f4 gw = *(const f4*)(gnw + c), gb = *(const f4*)(gnb + c);
                float sm = (y[0] + y[1]) + (y[2] + y[3]); sm = red16(sm);
                const float mu = sm * (1.0f / 64.0f); float sq = 0.f;
#pragma unroll
                for (int i = 0; i < 4; ++i) { const float dd = y[i] - mu; sq += dd * dd; }
                sq = red16(sq);
                const f4 bp = *(const f4*)(bonus + 4 * t); const float rs = rsqrtf(sq * (1.0f / 64.0f) + 64e-5f), bo = (bp[0] + bp[1]) + (bp[2] + bp[3]); h4 o;
#pragma unroll
                for (int i = 0; i < 4; ++i) o[i] = (half_t)((y[i] - mu) * rs * gw[i] + gb[i] + bo * (float)VT[(c + i) * ST + t]);
                *(h4*)(Zd + (size_t)row * ADIM + c) = o;
            }
        }
        lds_barrier();
    }
}

__device__ __forceinline__ void ph_gla_a(const Params& P, int first, int stride) {
    constexpr int QS = 104, TSR = 72;
    half_t* Q2s = (half_t*)smem; half_t* K2s = Q2s + 64 * QS; half_t* K3T = K2s + 64 * QS; half_t* VT = K3T + 96 * TSR; half_t* Ps = VT + 192 * TSR;
    float* cgf = (float*)(Ps + 64 * TSR); float* segt = cgf + 64 * 96;
    const int tid = tid_(), lane = tid & 63, w = wid_of(tid);
    for (int task = first; task < GLT; task += stride) {
        const int n = task % 68, c = task / 68, h = c & 3, b = (c >> 2) & 3, d = c >> 4, s0 = n * 64;
        const half_t* GGd = P.GG() + (size_t)d * MT * BKEY + h * BHK; half_t* Od = P.O() + (size_t)d * MT * BDIM + h * BHV;
        const half_t* Fq = P.F() + 2304 + h * BHK; const half_t* Fv = P.F() + 3072 + h * BHV;
        lds_barrier();
        h8 qv[2], kv[2];
#pragma unroll
        for (int j = 0; j < 2; ++j) { const int p = tid + NTHREADS * j;
            if (p < 768) { const int i = p / 12, kc = (p % 12) * 8, row = tokrow(d, b, s0 + i);
                qv[j] = *(const h8*)(Fq + (size_t)row * CONV + kc); kv[j] = *(const h8*)(Fq + (size_t)row * CONV + BKEY + kc);
                const h8 g = *(const h8*)(GGd + (size_t)row * BKEY + kc);
#pragma unroll
                for (int e = 0; e < 8; ++e) cgf[i * 96 + kc + e] = (float)g[e]; } }
#pragma unroll
        for (int j = 0; j < 3; ++j) { const int p = tid + NTHREADS * j, i = p / 24, vc = (p % 24) * 8, row = tokrow(d, b, s0 + i);
            const h8 v = *(const h8*)(Fv + (size_t)row * CONV + vc);
#pragma unroll
            for (int e = 0; e < 8; ++e) VT[(vc + e) * TSR + i] = v[e]; }
        lds_barrier();
        { float loc[16]; const int ck = tid % 96, cseg = tid / 96;
          if (tid < 384) { float run = 0.f;
#pragma unroll
              for (int i = 0; i < 16; ++i) { run += cgf[(cseg * 16 + i) * 96 + ck]; loc[i] = run; }
              segt[cseg * 96 + ck] = run; }
          lds_barrier();
          if (tid < 384) { float off = 0.f;
#pragma unroll
              for (int sg = 0; sg < 4; ++sg) off += (sg < cseg) ? segt[sg * 96 + ck] : 0.f;
#pragma unroll
              for (int i = 0; i < 16; ++i) cgf[(cseg * 16 + i) * 96 + ck] = loc[i] + off; }
        }
        lds_barrier();
#pragma unroll
        for (int j = 0; j < 2; ++j) { const int p = tid + NTHREADS * j;
            if (p < 768) { const int i = p / 12, kc = (p % 12) * 8; h8 q1, q2, k2;
#pragma unroll
                for (int e = 0; e < 8; ++e) { const float cg = cgf[i * 96 + kc + e], rf = cgf[31 * 96 + kc + e], tt = cgf[63 * 96 + kc + e];
                    const float qf = (float)qv[j][e] * 0.10206207261596575f, kf = (float)kv[j][e];
                    q1[e] = clamp_h(qf * __expf(cg)); q2[e] = clamp_h(qf * __expf(cg - rf)); k2[e] = clamp_h(kf * __expf(rf - cg)); K3T[(kc + e) * TSR + i] = clamp_h(kf * __expf(tt - cg)); }
                *(h8*)(P.GQ() + ((size_t)task * 64 + i) * BHK + kc) = q1; *(h8*)(Q2s + i * QS + kc) = q2; *(h8*)(K2s + i * QS + kc) = k2; } }
        if (tid < 96) P.GE()[(size_t)task * BHK + tid] = __expf(cgf[63 * 96 + tid]);
        lds_barrier();
#pragma unroll
        for (int x = 0; x < 2; ++x) {
            const int id = w * 2 + x, it = id >> 2, jt = id & 3; f4 a = (f4){0.f, 0.f, 0.f, 0.f};
            if (jt <= it) {
#pragma unroll
                for (int ks = 0; ks < 3; ++ks) a = mma16(ldfrag(K2s, QS, jt * 16, ks * 32, lane), ldfrag(Q2s, QS, it * 16, ks * 32, lane), a);
            }
            const int i = it * 16 + (lane & 15), j = jt * 16 + 4 * (lane >> 4); h4 pv;
#pragma unroll
            for (int r = 0; r < 4; ++r) pv[r] = (j + r <= i) ? clamp_h(a[r]) : (half_t)0.f;
            *(h4*)(Ps + i * TSR + j) = pv;
        }
        lds_barrier();
        {   const int it = w & 3, i = it * 16 + (lane & 15), row = tokrow(d, b, s0 + i);
            const h8 p0 = ldfrag(Ps, TSR, it * 16, 0, lane), p1 = ldfrag(Ps, TSR, it * 16, 32, lane);
#pragma unroll
            for (int x = 0; x < 6; ++x) { const int vt = (w >> 2) * 6 + x;
                f4 a = mma16(ldfrag(VT, TSR, vt * 16, 0, lane), p0, (f4){0.f, 0.f, 0.f, 0.f}); a = mma16(ldfrag(VT, TSR, vt * 16, 32, lane), p1, a);
                *(h4*)(Od + (size_t)row * BDIM + vt * 16 + 4 * (lane >> 4)) = to_h4(a); }
        }
        {   half_t* gs = P.GS() + (size_t)task * BHV * BHK;
#pragma unroll
            for (int x = 0; x < 9; ++x) { const int id = w * 9 + x, kt = id / 12, vt = id - kt * 12;
                f4 a = mma16(ldfrag(K3T, TSR, kt * 16, 0, lane), ldfrag(VT, TSR, vt * 16, 0, lane), (f4){0.f, 0.f, 0.f, 0.f});
                a = mma16(ldfrag(K3T, TSR, kt * 16, 32, lane), ldfrag(VT, TSR, vt * 16, 32, lane), a);
                *(h4*)(gs + (size_t)(vt * 16 + (lane & 15)) * BHK + kt * 16 + 4 * (lane >> 4)) = to_h4(a); }
        }
    }
    __syncthreads();
}
__device__ __forceinline__ void ph_gla_b(const Params& P, int first, int stride) {
    constexpr int NBLK = 32 * (BHV * BHK / 8) / NTHREADS;
    for (int blk = first; blk < NBLK; blk += stride) {
        const int gid = blk * NTHREADS + tid_(), c = gid / (BHV * BHK / 8), e = gid - c * (BHV * BHK / 8), v = e / 12, kc = (e - v * 12) * 8;
        half_t* base = P.GS() + ((size_t)c * 68 * BHV + v) * BHK + kc; const float* eb = P.GE() + (size_t)c * 68 * BHK + kc;
        float S[8];
#pragma unroll
        for (int j = 0; j < 8; ++j) S[j] = 0.f;
        for (int n0 = 0; n0 < 68; n0 += 4) {
            h8 U[4]; f4 e0[4], e1[4];
#pragma unroll
            for (int u = 0; u < 4; ++u) { U[u] = *(const h8*)(base + (size_t)(n0 + u) * BHV * BHK); e0[u] = *(const f4*)(eb + (n0 + u) * BHK); e1[u] = *(const f4*)(eb + (n0 + u) * BHK + 4); }
#pragma unroll
            for (int u = 0; u < 4; ++u) { h8 o;
#pragma unroll
                for (int j = 0; j < 8; ++j) o[j] = clamp_h(S[j]);
                *(h8*)(base + (size_t)(n0 + u) * BHV * BHK) = o;
#pragma unroll
                for (int j = 0; j < 4; ++j) { S[j] = e0[u][j] * S[j] + (float)U[u][j]; S[4 + j] = e1[u][j] * S[4 + j] + (float)U[u][4 + j]; } }
        }
    }
}
__device__ __forceinline__ void ph_gla_c(const Params& P, int l, int first, int stride, bool latent_only) {
    const int tid = tid_(), lane = tid & 63, w = wid_of(tid), q = lane >> 4, i16 = lane & 15;
    const float* ng = pin(I_GLANG) + l * BHV;
    for (int u = first; u < NBATCH * BH * 68 / 2; u += stride) {
        const int t = 2 * u + (w >> 2), m = t % 68, h = (t / 68) & 3, b = t / (68 * 4), it = w & 3, j = it * 16 + i16;
        if (latent_only && m < 4) continue;
        const int row = (m < 4) ? RL + b * CTXL + 64 * m + j : b * SEQ + 64 * (m - 4) + j;
        const int task0 = ((0 * 4 + b) * 4 + h) * 68 + m, task1 = ((1 * 4 + b) * 4 + h) * 68 + (m < 4 ? 3 - m : 71 - m);
        h8 y0[3], y1[3];
        { const half_t* q0 = P.GQ() + ((size_t)task0 * 64 + j) * BHK + 8 * q; const half_t* q1 = P.GQ() + ((size_t)task1 * 64 + (63 - j)) * BHK + 8 * q;
#pragma unroll
          for (int ks = 0; ks < 3; ++ks) { y0[ks] = *(const h8*)(q0 + 32 * ks); y1[ks] = *(const h8*)(q1 + 32 * ks); } }
        const half_t* s0p = P.GS() + ((size_t)task0 * BHV + i16) * BHK + 8 * q; const half_t* s1p = P.GS() + ((size_t)task1 * BHV + i16) * BHK + 8 * q;
        const half_t* o0 = P.O() + (size_t)row * BDIM + h * BHV + 4 * q; const half_t* o1 = o0 + (size_t)MT * BDIM;
        f4 o[12]; float ss = 0.f;
#pragma unroll
        for (int vt = 0; vt < 12; ++vt) {
            f4 a = (f4){0.f, 0.f, 0.f, 0.f};
#pragma unroll
            for (int ks = 0; ks < 3; ++ks) { a = mma16(*(const h8*)(s0p + (size_t)vt * 16 * BHK + 32 * ks), y0[ks], a); a = mma16(*(const h8*)(s1p + (size_t)vt * 16 * BHK + 32 * ks), y1[ks], a); }
            const h4 i0 = *(const h4*)(o0 + vt * 16), i1 = *(const h4*)(o1 + vt * 16);
#pragma unroll
            for (int r = 0; r < 4; ++r) { a[r] += (float)i0[r] + (float)i1[r]; ss += a[r] * a[r]; }
            o[vt] = a;
        }
        ss += __shfl_xor(ss, 16); ss += __shfl_xor(ss, 32);
        const float rs = rsqrtf(ss * (1.0f / BHV) + 1e-6f);
        const half_t* ogp = P.Plo() + (size_t)row * NLO + LO_OG + h * BHV + 4 * q; half_t* yb = P.YB() + (size_t)row * YCP + h * BHV + 4 * q;
#pragma unroll
        for (int vt = 0; vt < 12; ++vt) { const h4 og = *(const h4*)(ogp + vt * 16); const f4 g = *(const f4*)(ng + vt * 16 + 4 * q); f4 r4;
#pragma unroll
            for (int r = 0; r < 4; ++r) r4[r] = o[vt][r] * rs * g[r] * siluf_((float)og[r]);
            *(h4*)(yb + vt * 16) = to_h4(r4); }
    }
}

template <class FN> __device__ __forceinline__ void acc_foreach_pair(const f4 (&acc)[4][2], FN fn) {
    const int lane = tid_() & 63, w = wid_of(tid_()), wm = w >> 2, wn = w & 3;
#pragma unroll
    for (int mi = 0; mi < 4; ++mi) fn(64 * wm + 16 * mi + (lane & 15), 16 * wn + 4 * (lane >> 4), acc[mi][0], acc[mi][1]);
}
__device__ __forceinline__ float gelu_tanh(float x) { const float u = 0.7978845608028654f * (x + 0.044715f * x * x * x); return 0.5f * x * (1.0f + tanhf(u)); }

__device__ __forceinline__ uint4 s5_u_piece(const Params& P, int g, int m, int k) {
    if (m >= S5ROWS) return zero16();
    const int b = m / 272, n = m - b * 272, row0 = s5_block_row0(b, n);
    return ld16(P.Plo() + (size_t)(row0 + (k >> 4)) * NLO + LO_U + g * 16 + (k & 15));
}
__device__ __forceinline__ void ph_s5g2(const Params& P, int first, int stride) {
    for (int u = first; u < CGR * 9 * 2; u += stride) {
        const int g = u / 18, tm = (u % 18) >> 1, tn = u & 1;
        const half_t* B = P.MstT() + (size_t)g * 256 * 256 + (size_t)tn * 128 * 256;
        f4 acc[4][2]; acc_zero(acc);
        gemm_tile(4, [&](int r, int k) { return s5_u_piece(P, g, tm * 128 + r, k); }, [&](int r, int k) { return ld16(B + r * 256 + k); }, acc);
        acc_foreach(acc, [&](int m, int n, f4 v) { const int mm = tm * 128 + m; if (mm < S5ROWS) *(f4*)(P.Sloc() + ((size_t)g * S5ROWS + mm) * 256 + tn * 128 + n) = v; });
    }
}
__device__ __forceinline__ void ph_s5scan(const Params& P, int l, int first, int stride) {
    for (int blk = first; blk < 32; blk += stride) {
        const int gid = blk * NTHREADS + tid_(), p = gid & 63, d = (gid >> 6) & 1, b = (gid >> 7) & 3, g = gid >> 9;
        const float lr = pin(I_S5LRE)[((l * 2 + d) * CGR + g) * CP + p], li = pin(I_S5LIM)[((l * 2 + d) * CGR + g) * CP + p];
        const float dt = expf(pin(I_S5LDT)[(l * 2 + d) * CGR + g]);
        const float mag = expf(lr * dt * 16.0f), ang = li * dt * 16.0f, ar = mag * cosf(ang), ai = mag * sinf(ang);
        float xr = 0.f, xi = 0.f;
        for (int n0 = 0; n0 < 272; n0 += 16) {
            float sr[16], si[16]; size_t oo[16];
#pragma unroll
            for (int u = 0; u < 16; ++u) { const int ns = n0 + u, nb = d == 0 ? ns : (ns < 16 ? 15 - ns : 287 - ns);
                oo[u] = ((size_t)g * S5ROWS + b * 272 + nb) * 256 + d * 128 + p; sr[u] = P.Sloc()[oo[u]]; si[u] = P.Sloc()[oo[u] + 64]; }
#pragma unroll
            for (int u = 0; u < 16; ++u) { P.XinH()[oo[u]] = (half_t)xr; P.XinH()[oo[u] + 64] = (half_t)xi;
                const float nr = ar * xr - ai * xi + sr[u], ni = ar * xi + ai * xr + si[u]; xr = nr; xi = ni; }
        }
    }
}
__device__ __forceinline__ void ph_s5g1(const Params& P, int l, int first, int stride) {
    const float* s5d = pin(I_S5D) + l * CDIM;
    for (int u = first; u < CGR * 9 * 2; u += stride) {
        const int g = u / 18, tm = (u % 18) >> 1, tn = u & 1;
        const half_t* B = P.McatT() + (size_t)g * 256 * 512 + (size_t)tn * 128 * 512;
        f4 acc[4][2]; acc_zero(acc);
        gemm_tile(8, [&](int r, int k) -> uint4 { const int m = tm * 128 + r; if (k < 256) return s5_u_piece(P, g, m, k); if (m >= S5ROWS) return zero16();
                         return ld16(P.XinH() + ((size_t)g * S5ROWS + m) * 256 + (k - 256)); },
                  [&](int r, int k) { return ld16(B + r * 512 + k); }, acc);
        struct UD { h4 u; f4 d; };
        acc_foreach2(acc, [&](int m, int n) { UD r; const int mm = tm * 128 + m < S5ROWS ? tm * 128 + m : S5ROWS - 1;
            const int nn = tn * 128 + n, tau = nn >> 4, c = nn & 15, b = mm / 272, nb = mm - b * 272, row = s5_block_row0(b, nb) + tau, ch = g * 16 + c;
            r.u = *(const h4*)(P.Plo() + (size_t)row * NLO + LO_U + ch); r.d = *(const f4*)(s5d + ch); return r; },
          [&](int m, int n, f4 v, UD r) { const int mm = tm * 128 + m; if (mm >= S5ROWS) return;
            const int nn = tn * 128 + n, tau = nn >> 4, c = nn & 15, b = mm / 272, nb = mm - b * 272, row = s5_block_row0(b, nb) + tau, ch = g * 16 + c; f4 o;
#pragma unroll
            for (int i = 0; i < 4; ++i) o[i] = gelu_tanh(v[i] + r.d[i] * (float)r.u[i]);
            *(h4*)(P.TC() + (size_t)row * CDIM + ch) = to_h4(o); });
    }
}
__device__ __forceinline__ void ph_glu(const Params& P, int mrows) {
    SchedDense S; S.T.init(mrows / 256, (2 * CDIM) / 256, gridDim.x, bid_()); S.A = (const char*)P.TC(); S.B = (const char*)P.GluT(); S.tstepA = (size_t)256 * CDIM * 2; S.tstepB = (size_t)256 * CDIM * 2;
    pg8::gemm_phase(CDIM, S, [&](const pg8::Acc& acc, const pg8::Unit& u, int wr, int wc, int fr, int fq) {
        pg8::foreach_pair(acc, wr, wc, fr, fq, [&](int m, int hc, f4 a, f4 g) { f4 o;
#pragma unroll
            for (int i = 0; i < 4; ++i) o[i] = a[i] * sigmoidf_(g[i]);
            *(h4*)(P.YC() + (size_t)(u.pm * 256 + m) * CDIM + u.pn * 128 + hc) = to_h4(o); });
    });
}

__device__ __forceinline__ void ph_comb(const Params& P, int l, int mrows) {
    const int tid = tid_();
    for (int u = bid_(); u < (mrows / 128) * 6; u += gridDim.x) {
        const int tm = u / 6, tn = u % 6, m0 = tm * 128, n0 = tn * 128;
        const half_t* A = P.Plo() + (size_t)m0 * NLO + LO_DG; const half_t* B = P.LG2T() + (size_t)n0 * 128;
        f4 acc[4][2]; acc_zero(acc);
        gemm_tile(2, [&](int rr, int k) { return sigm8(ld16(A + (size_t)rr * NLO + k)); }, [&](int rr, int k) { return ld16(B + rr * 128 + k); }, acc);
        struct ZZ { h4 a, b; };
        acc_foreach2(acc, [&](int m, int n) { ZZ z; const size_t o = (size_t)(m0 + m) * ADIM + n0 + n; z.a = *(const h4*)(P.Z() + o); z.b = *(const h4*)(P.Z() + (size_t)MT * ADIM + o); return z; },
          [&](int m, int n, f4 v, ZZ z) { const size_t o = (size_t)(m0 + m) * ADIM + n0 + n; f4 r;
#pragma unroll
            for (int i = 0; i < 4; ++i) r[i] = ((float)z.a[i] + (float)z.b[i]) * v[i];
            *(h4*)(P.YA() + o) = to_h4(r); });
    }
}

struct SchedMerge1 {
    pg8::TileOrder T; const char *a, *b; int nb, br0, K;
    __device__ __forceinline__ bool next(int i, pg8::Unit& u) const { const int t = i / nb, br = i - nb * t; int pm, pn; if (!T.tile(t, pm, pn)) return false; u.pm = pm; u.pn = pn * 4 + br0 + br;
        u.A = a + ((size_t)br * MT + (size_t)pm * 256) * K * 2; u.B = b + ((size_t)br * D + (size_t)pn * 256) * K * 2; return true; }
};
template <class S_> __device__ __forceinline__ void merge1_call(const Params& P, const S_& S, int K) {
    pg8::gemm_phase(K, S, [&](const pg8::Acc& acc, const pg8::Unit& u, int wr, int wc, int fr, int fq) {
        const int br = u.pn & 3, m0 = u.pm * 256, n0 = (u.pn >> 2) * 256;
        struct GO { h4 g, o; };
        pg8::foreach_frag2(acc, wr, wc, fr, fq,
            [&](int m, int n) { GO r; r.g = *(const h4*)(P.Pg() + (size_t)(m0 + m) * NGT + br * D + n0 + n); r.o = (h4){0, 0, 0, 0}; if (br != 0) r.o = *(const h4*)(P.U() + (size_t)(m0 + m) * D + n0 + n); return r; },
            [&](int m, int n, f4 v, GO r) { f4 x;
#pragma unroll
                for (int i = 0; i < 4; ++i) x[i] = (float)r.o[i] + (float)r.g[i] * v[i];
                *(h4*)(P.U() + (size_t)(m0 + m) * D + n0 + n) = to_h4(x); });
    });
}
__device__ __forceinline__ void ph_merge1(const Params& P, int mrows_all) {
    const int mrows = RL;
    if (mrows_all > RL) {
        for (int u = bid_(); u < (RC / 128) * (D / 128); u += gridDim.x) {
            const int tm = u >> 4, tn = u & 15, m0 = RL + tm * 128, n0 = tn * 128;
            f4 tot[4][2]; acc_zero(tot);
#pragma unroll 1
            for (int br = 0; br < 3; ++br) {
                const int K = br == 2 ? CDIM : YCP;
                const half_t* A = (br == 0 ? P.YA() : (br == 1 ? P.YB() : P.YC())) + (size_t)m0 * K;
                const half_t* B = (br == 0 ? P.PaT() : (br == 1 ? P.PbT() : P.PcT())) + (size_t)n0 * K;
                f4 acc[4][2]; acc_zero(acc);
                gemm_tile(K / 64, [&](int r, int k) { return ld16(A + (size_t)r * K + k); }, [&](int r, int k) { return ld16(B + (size_t)r * K + k); }, acc);
                const int lane = tid_() & 63, w = wid_of(tid_()), wm = w >> 2, wn = w & 3;
                h4 gt[4][2];
#pragma unroll
                for (int mi = 0; mi < 4; ++mi)
#pragma unroll
                    for (int ni = 0; ni < 2; ++ni) gt[mi][ni] = *(const h4*)(P.Pg() + (size_t)(m0 + 64 * wm + 16 * mi + (lane & 15)) * NGT + br * D + n0 + 32 * wn + 16 * ni + 4 * (lane >> 4));
#pragma unroll
                for (int mi = 0; mi < 4; ++mi)
#pragma unroll
                    for (int ni = 0; ni < 2; ++ni)
#pragma unroll
                        for (int i = 0; i < 4; ++i) tot[mi][ni][i] += (float)gt[mi][ni][i] * acc[mi][ni][i];
            }
            acc_foreach(tot, [&](int m, int n, f4 v) { *(h4*)(P.U() + (size_t)(m0 + m) * D + n0 + n) = to_h4(v); });
        }
        __syncthreads();
    }
    SchedMerge1 S; S.T.init(mrows / 256, D / 256, gridDim.x, bid_()); S.a = (const char*)P.YA(); S.b = (const char*)P.PaT(); S.nb = 2; S.br0 = 0; S.K = YCP;
    merge1_call(P, S, YCP);
    SchedMerge1 S2; S2.T.init(mrows / 256, D / 256, gridDim.x, bid_()); S2.a = (const char*)P.YC(); S2.b = (const char*)P.PcT(); S2.nb = 1; S2.br0 = 2; S2.K = CDIM;
    merge1_call(P, S2, CDIM);
}
__device__ __forceinline__ void ph_merge2(const Params& P, int l, int mrows_all) {
    const int mrows = RL;
    if (mrows_all > RL) {
        for (int u = bid_(); u < (RC / 128) * (D / 128); u += gridDim.x) {
            const int tm = u >> 4, tn = u & 15, m0 = RL + tm * 128, n0 = tn * 128;
            const half_t* A = P.U() + (size_t)m0 * D; const half_t* B = P.WoT() + (size_t)n0 * D;
            f4 acc[4][2]; acc_zero(acc);
            gemm_tile(D / 64, [&](int r, int k) { return ld16(A + (size_t)r * D + k); }, [&](int r, int k) { return ld16(B + (size_t)r * D + k); }, acc);
            const float* gap = P.MOD() + ((size_t)l * 5 + 4) * (6 * D) + 2 * D + n0;
            struct XG { f4 x, g; };
            acc_foreach2(acc, [&](int m, int n) { XG r; r.x = *(const f4*)(xsrc_ptr(P, m0 + m, l) + n0 + n); r.g = *(const f4*)(gap + n); return r; },
                [&](int m, int n, f4 v, XG r) {
#pragma unroll
                    for (int i = 0; i < 4; ++i) r.x[i] += r.g[i] * v[i];
                    *(f4*)(xrow_ptr(P, m0 + m) + n0 + n) = r.x; });
        }
        __syncthreads();
    }
    SchedDense S; S.T.init(mrows / 256, D / 256, gridDim.x, bid_()); S.A = (const char*)P.U(); S.B = (const char*)P.WoT(); S.tstepA = (size_t)256 * D * 2; S.tstepB = (size_t)256 * D * 2;
    pg8::gemm_phase(D, S, [&](const pg8::Acc& acc, const pg8::Unit& u, int wr, int wc, int fr, int fq) {
        const int m0 = u.pm * 256, n0 = u.pn * 256;
        const float* gap = P.MOD() + ((size_t)l * 5 + modrow_of(m0)) * (6 * D) + 2 * D + n0;
        struct XG { f4 x, g; };
        pg8::foreach_frag2(acc, wr, wc, fr, fq,
            [&](int m, int n) { XG r; r.x = *(const f4*)(xsrc_ptr(P, m0 + m, l) + n0 + n); r.g = *(const f4*)(gap + n); return r; },
            [&](int m, int n, f4 v, XG r) {
#pragma unroll
                for (int i = 0; i < 4; ++i) r.x[i] += r.g[i] * v[i];
                *(f4*)(xrow_ptr(P, m0 + m) + n0 + n) = r.x; });
    });
}

__device__ __forceinline__ void ph_route(const Params& P, int l, int mrows) {
    const int tid = tid_(), lane = tid & 63, gw = bid_() * 8 + wid_of(tid), NW = gridDim.x * 8;
    float* rwT = (float*)smem;
    { const float* rwp = pin(I_RW); for (int i = tid; i < D * NE; i += NTHREADS) rwT[(i & 15) * D + (i >> 4)] = rwp[i]; }
    const float* rbias = pin(I_RB); const float* n2g = pin(I_N2G) + (size_t)l * D;
    __syncthreads();
    for (int row = gw; row < mrows; row += NW) {
        const float* xr = xrow_ptr(P, row); const int mr = modrow_of(row);
        const float* ng = n2g; const float* sh = P.MOD() + ((size_t)l * 5 + mr) * (6 * D) + 3 * D; const float* sc = sh + D;
        f4 v[8]; float ss = 0.f;
#pragma unroll
        for (int j = 0; j < 8; ++j) { v[j] = *(const f4*)(xr + (j * 64 + lane) * 4); ss += (v[j][0] * v[j][0] + v[j][1] * v[j][1]) + (v[j][2] * v[j][2] + v[j][3] * v[j][3]); }
        ss = wave_sum(ss);
        const float rstd = rsqrtf(ss * (1.0f / D) + 1e-6f);
        float lg[NE];
#pragma unroll
        for (int e = 0; e < NE; ++e) lg[e] = 0.f;
        half_t* hr = P.H() + (size_t)row * D;
#pragma unroll
        for (int j = 0; j < 8; ++j) { const int c = (j * 64 + lane) * 4; const f4 g = *(const f4*)(ng + c), s1 = *(const f4*)(sc + c), s0 = *(const f4*)(sh + c); f4 o;
#pragma unroll
            for (int i = 0; i < 4; ++i) o[i] = v[j][i] * rstd * g[i] * (1.0f + s1[i]) + s0[i];
#pragma unroll
            for (int e = 0; e < NE; ++e) { const f4 wv = *(const f4*)(rwT + e * D + c); lg[e] += (o[0] * wv[0] + o[1] * wv[1]) + (o[2] * wv[2] + o[3] * wv[3]); }
            *(h4*)(hr + c) = to_h4(o); asm volatile("" ::: "memory"); }
#pragma unroll
        for (int e = 0; e < NE; ++e) lg[e] = wave_sum(lg[e]);
        float sc16[NE], bi[NE];
#pragma unroll
        for (int e = 0; e < NE; ++e) { sc16[e] = sigmoidf_(lg[e]); bi[e] = sc16[e] + rbias[e]; }
        int gsel = 0; float gbest = -1e30f;
#pragma unroll
        for (int g = 0; g < 4; ++g) { float m1 = -1e30f, m2 = -1e30f;
#pragma unroll
            for (int i = 0; i < 4; ++i) { const float x = bi[4 * g + i]; if (x > m1) { m2 = m1; m1 = x; } else if (x > m2) m2 = x; }
            const float s = m1 + m2; if (s > gbest) { gbest = s; gsel = g; } }
        int i0 = 0, i1 = 0; float b0 = -1e30f, b1 = -1e30f, s0v = 0.f, s1v = 0.f;
#pragma unroll
        for (int e = 0; e < NE; ++e) { const bool in = (e >> 2) == gsel; const float x = bi[e];
            if (in && x > b0) { b1 = b0; i1 = i0; s1v = s0v; b0 = x; i0 = e; s0v = sc16[e]; } else if (in && x > b1) { b1 = x; i1 = e; s1v = sc16[e]; } }
        if (lane == 0) { const float inv = 1.0f / (s0v + s1v);
            P.wsel()[row * 2] = s0v * inv; P.wsel()[row * 2 + 1] = s1v * inv; P.pos()[row * 2] = i0; P.pos()[row * 2 + 1] = i1;
            atomicAdd(&P.cnt()[i0], 1); atomicAdd(&P.cnt()[i1], 1); }
    }
}
__device__ __forceinline__ void seg_starts(const Params& P, int (&st)[NE + 1]) {
    int a = 0;
#pragma unroll
    for (int e = 0; e < NE; ++e) { st[e] = a; a += (P.cnt()[e] + 255) & ~255; }
    st[NE] = a;
}
__device__ __forceinline__ void ph_slot(const Params& P, int mrows) {
    int st[NE + 1]; seg_starts(P, st);
    const int tid = tid_(), lane = tid & 63, gw = bid_() * 8 + wid_of(tid), NW = gridDim.x * 8;
    for (int base = gw * 16; base < mrows; base += NW * 16) {
        int s0 = 0, s1 = 0;
        if (lane < 16) { const int row = base + lane; const int e0 = P.pos()[row * 2], e1 = P.pos()[row * 2 + 1]; int b0 = 0, b1 = 0;
#pragma unroll
            for (int q = 0; q < NE; ++q) { b0 = (q == e0) ? st[q] : b0; b1 = (q == e1) ? st[q] : b1; }
            s0 = b0 + atomicAdd(&P.cursor()[e0], 1); s1 = b1 + atomicAdd(&P.cursor()[e1], 1);
            P.pos()[row * 2] = s0; P.pos()[row * 2 + 1] = s1; }
#pragma unroll 4
        for (int r = 0; r < 16; ++r) {
            const int d0s = __shfl(s0, r), d1s = __shfl(s1, r);
            const uint4* src = (const uint4*)(P.H() + (size_t)(base + r) * D);
            uint4* d0 = (uint4*)(P.Hs() + (size_t)d0s * D); uint4* d1 = (uint4*)(P.Hs() + (size_t)d1s * D);
            const uint4 c0 = src[lane], c1 = src[64 + lane], c2 = src[128 + lane], c3 = src[192 + lane];
            d0[lane] = c0; d0[64 + lane] = c1; d0[128 + lane] = c2; d0[192 + lane] = c3;
            d1[lane] = c0; d1[64 + lane] = c1; d1[128 + lane] = c2; d1[192 + lane] = c3;
        }
    }
}
struct SchedMoe {
    pg8::TileOrder T; const char* A; const char* B; size_t tstepA, tstepB, estepB; int st[NE + 1];
    __device__ __forceinline__ bool next(int i, pg8::Unit& u) const { int pm, pn; if (!T.tile(i, pm, pn)) return false; u.pm = pm; u.pn = pn; const int s0 = pm * 256; int e = 0;
#pragma unroll
        for (int q = 1; q < NE; ++q) e = (s0 >= st[q]) ? q : e;
        u.A = A + (size_t)pm * tstepA; u.B = B + (size_t)e * estepB + (size_t)pn * tstepB; return true; }
};
__device__ __forceinline__ void ph_up(const Params& P) {
    SchedMoe S; seg_starts(P, S.st); S.T.init(S.st[NE] >> 8, (2 * DE) / 256, gridDim.x, bid_());
    S.A = (const char*)P.Hs(); S.B = (const char*)P.W13T(); S.tstepA = (size_t)256 * D * 2; S.tstepB = (size_t)256 * D * 2; S.estepB = (size_t)2 * DE * D * 2;
    pg8::gemm_phase(D, S, [&](const pg8::Acc& acc, const pg8::Unit& u, int wr, int wc, int fr, int fq) {
        pg8::foreach_pair(acc, wr, wc, fr, fq, [&](int m, int hc, f4 a, f4 g) { f4 o;
#pragma unroll
            for (int i = 0; i < 4; ++i) o[i] = siluf_(a[i]) * g[i];
            *(h4*)(P.Hg() + (size_t)(u.pm * 256 + m) * DE + u.pn * 128 + hc) = to_h4(o); });
    });
}
__device__ __forceinline__ void ph_down(const Params& P) {
    SchedMoe S; seg_starts(P, S.st); S.T.init(S.st[NE] >> 8, D / 256, gridDim.x, bid_());
    S.A = (const char*)P.Hg(); S.B = (const char*)P.W2T(); S.tstepA = (size_t)256 * DE * 2; S.tstepB = (size_t)256 * DE * 2; S.estepB = (size_t)D * DE * 2;
    pg8::gemm_phase<true>(DE, S, [&](const pg8::Acc& acc, const pg8::Unit& u, int wr, int wc, int fr, int fq) {
        pg8::foreach_frag8(acc, wr, wc, fr, fq, [&](int m, int n, f4 a, f4 b) { const h4 x = to_h4(a), y = to_h4(b); h8 o;
#pragma unroll
            for (int i = 0; i < 4; ++i) { o[i] = x[i]; o[4 + i] = y[i]; }
            *(h8*)(P.Y() + (size_t)(u.pm * 256 + m) * D + u.pn * 256 + n) = o; });
    });
}

#ifndef PROBE_BAR
#define PROBE_BAR 1
#endif
#define XBAR(b) REP(PROBE_BAR, xcd_barrier(b);)
template <int l> __device__ __forceinline__ void layer_body(const Params& P, const XcdBarrier& bar, const int bid, const int G) {
    constexpr int MR = (l == DEPTH - 1) ? RL : MT;

    if (l == 0) { ph_prologue(P); REP(PROBE_SETUP, ph_setup(P, 0); XBAR(bar);) ph_rows<0>(P, 0); }
    else { ph_setup(P, l); ph_rows<1>(P, l); }
    XBAR(bar);
    REP(PROBE_INPROJ, ph_inproj<0>(P, bid, G); XBAR(bar);)
    REP(PROBE_CONVF, REP(PROBE_CONV1, ph_convf(P, l);) ph_lora(P, l, bid, G); REP(PROBE_S5G2, ph_s5g2(P, bid, G);) XBAR(bar);)
    REP(PROBE_SCANS,
    if (G >= 224) { if (bid < 96) { REP(PROBE_RWKV, ph_rwkv(P, l, bid, 1 << 30);) ph_inproj<1>(P, bid, 96, 96 * GATE_KU, MR); }
                    else if (bid >= G - NCONV) { ph_moe_convert(P, l, 2, 0, MOE_A); ph_inproj<1>(P, 96 * GATE_KU + bid - (G - NCONV), NCONV, 96 * GATE_KU + NCONV * CONV_GU, MR); }
                    else { ph_s5scan(P, l, bid - 96, G - 96 - NCONV); ph_gla_a(P, bid - 96, G - 96 - NCONV); ph_inproj<1>(P, 96 * GATE_KU + NCONV * CONV_GU + bid - 96, G - 96 - NCONV, 1 << 30, MR); } }
    else { ph_rwkv(P, l, bid, G); ph_s5scan(P, l, bid, G); ph_gla_a(P, bid, G); ph_inproj<1>(P, bid, G, 1 << 30, MR); ph_moe_convert(P, l, 2, 0, MOE_A); }
    XBAR(bar);)
    ph_gla_b(P, bid, G); ph_s5g1(P, l, bid, G); ph_comb(P, l, MR); ph_moe_convert(P, l, 0, MOE_A, MOE_A + (6144 - MOE_A) / 2);
    XBAR(bar);
    REP(PROBE_P6, ph_gla_c(P, l, bid, G, l == DEPTH - 1); ph_glu(P, MR);) ph_moe_convert(P, l, 1, MOE_A + (6144 - MOE_A) / 2, 6144); XBAR(bar);
    REP(PROBE_MERGE1, ph_merge1(P, MR); XBAR(bar);)
    ph_merge2(P, l, MR);
    XBAR(bar);
    ph_route(P, l, MR);
    XBAR(bar);
    ph_slot(P, MR);
    XBAR(bar);
    REP(PROBE_MOE, ph_up(P); XBAR(bar); ph_down(P); XBAR(bar);)
    }
__global__ void __launch_bounds__(NTHREADS, 2) k_fused(Params P) {
    const int bid = blockIdx.x, G = gridDim.x;
    volatile LAS unsigned* xbw = (volatile LAS unsigned*)(LAS unsigned char*)(smem + LDS_BYTES - 16);
    if (threadIdx.x == 0) { xbw[0] = 0u; xbw[1] = 0u; xbw[2] = 0u; xbw[3] = 0u; }
    __syncthreads();
    const XcdBarrier bar = xcd_barrier_post(P.bar(), xbw);
    layer_body<0>(P, bar, bid, G);
    layer_body<1>(P, bar, bid, G);
    ph_rows<2>(P, 1);
}

extern "C" void kernel_launch(void* const* d_in, const int* in_sizes, int n_in, void* d_out, int out_size, void* d_ws, size_t ws_size, hipStream_t stream) {
    static int grid = 0;
    if (grid == 0) { int dev = 0, cus = 0; (void)hipGetDevice(&dev); (void)hipDeviceGetAttribute(&cus, hipDeviceAttributeMultiprocessorCount, dev); grid = cus > 0 ? cus : 256;
        (void)hipFuncSetAttribute((const void*)k_fused, hipFuncAttributeMaxDynamicSharedMemorySize, LDS_BYTES); }
    Params P{};
    for (int i = 0; i < 42; ++i) P.in[i] = (const float*)d_in[i];
    P.out = (float*)d_out;
    P.ws = (unsigned char*)d_ws;
    if (WS_TOTAL > ws_size || n_in != 42 || out_size != RL * D) { fprintf(stderr, "kernel_launch: workspace %zu < %zu or bad shapes\n", ws_size, (size_t)WS_TOTAL); return; }
    (void)hipMemsetAsync(P.ws + OFF_bar, 0, XCD_BAR_WORDS * sizeof(unsigned), stream);
    hipLaunchKernelGGL(k_fused, dim3(grid), dim3(NTHREADS), LDS_BYTES, stream, P);
}
```

```cpp
#include <hip/hip_runtime.h>
#include <stdint.h>
#include <stdio.h>

typedef _Float16 half_t;
typedef _Float16 h8 __attribute__((ext_vector_type(8)));
typedef _Float16 h4 __attribute__((ext_vector_type(4)));
typedef _Float16 h2 __attribute__((ext_vector_type(2)));
typedef float f4 __attribute__((ext_vector_type(4)));
typedef float f2 __attribute__((ext_vector_type(2)));

constexpr int D = 2048, NBATCH = 4, SEQ = 4096, CTXL = 256, DEPTH = 2;
constexpr int RL = NBATCH * SEQ, RC = NBATCH * CTXL, MT = RL + RC;
constexpr int TS = SEQ + CTXL;
constexpr int ADIM = 768, AH = 12, BDIM = 768, BKEY = 384, BH = 4, BHK = 96, BHV = 192, CDIM = 512, CGR = 32, CP = 64;
constexpr int CONV = 3840, NLO = 1792, NGT = 6144, INSRC = 11680, INPAD = 11776;
constexpr int LO_DW = 0, LO_DA = 128, LO_DG = 256, LO_BG = 384, LO_OG = 416, LO_U = 1184;
constexpr int NE = 16, DE = 1024;
constexpr int SLOTS = 38912;
constexpr int YCP = 768;
constexpr int S5ROWS = NBATCH * (TS / 16);
constexpr int NTHREADS = 512;
#ifndef PROBE_SETUP
#define PROBE_SETUP 1
#endif
#ifndef PROBE_SCAN
#define PROBE_SCAN 1
#endif
#ifndef PROBE_INPROJ
#define PROBE_INPROJ 1
#endif
#ifndef PROBE_CONVF
#define PROBE_CONVF 1
#endif
#ifndef PROBE_MOE
#define PROBE_MOE 1
#endif
#ifndef PROBE_MERGE1
#define PROBE_MERGE1 1
#endif
#ifndef PROBE_GLA
#define PROBE_GLA 1
#endif
#ifndef PROBE_RWKV
#define PROBE_RWKV 1
#endif
#ifndef GATE_KU
#define GATE_KU 1
#endif
#ifndef PROBE_SCANS
#define PROBE_SCANS 1
#endif
#ifndef RWKV_REP
#define RWKV_REP 1
#endif
#ifndef PROBE_CONV1
#define PROBE_CONV1 1
#endif
#ifndef PROBE_S5G2
#define PROBE_S5G2 1
#endif
#ifndef NCONV
#define NCONV 16
#define CONV_GU 6
#define MOE_A 2048
#endif
#ifndef PROBE_P6
#define PROBE_P6 1
#endif
#define REP_1(...) __VA_ARGS__
#define REP_2(...) __VA_ARGS__ __VA_ARGS__
#define REP_3(...) __VA_ARGS__ __VA_ARGS__ __VA_ARGS__
#define REP_CAT(a, b) a##b
#define REP_X(n, ...) REP_CAT(REP_, n)(__VA_ARGS__)
#define REP(n, ...) REP_X(n, __VA_ARGS__)
#ifndef PROBE_COMB
#define PROBE_COMB 1
#endif
constexpr int LDS_BYTES = 139264;

constexpr size_t al_(size_t x) { return (x + 255) & ~(size_t)255; }
constexpr size_t OFF_bar = 0;
constexpr size_t OFF_cnt = OFF_bar + al_(16384);
constexpr size_t OFF_blkcnt = OFF_cnt + al_(256);
constexpr size_t OFF_MOD = OFF_blkcnt + al_(1024 * NE * 4);
constexpr size_t OFF_Xc = OFF_MOD + al_((size_t)2 * 5 * 6 * D * 4);
constexpr size_t OFF_pos = OFF_Xc + al_((size_t)RC * D * 4);
constexpr size_t OFF_wsel = OFF_pos + al_((size_t)MT * 2 * 4);
constexpr size_t OFF_WinT = OFF_wsel + al_((size_t)MT * 2 * 4);
constexpr size_t OFF_PaT = OFF_WinT + al_((size_t)INPAD * D * 2);
constexpr size_t OFF_WoT = OFF_PaT + al_((size_t)3 * D * YCP * 2);
constexpr size_t OFF_W13T = OFF_WoT + al_((size_t)D * D * 2);
constexpr size_t OFF_W2T = OFF_W13T + al_((size_t)NE * 2 * DE * D * 2);
constexpr size_t OFF_GluT = OFF_W2T + al_((size_t)NE * D * DE * 2);
constexpr size_t OFF_MstT = OFF_GluT + al_((size_t)2 * CDIM * CDIM * 2);
constexpr size_t OFF_McatT = OFF_MstT + al_((size_t)CGR * 256 * 256 * 2);
constexpr size_t OFF_LW2T = OFF_McatT + al_((size_t)CGR * 256 * 512 * 2);
constexpr size_t OFF_LA2T = OFF_LW2T + al_((size_t)2 * ADIM * 64 * 2);
constexpr size_t OFF_LG2T = OFF_LA2T + al_((size_t)2 * ADIM * 64 * 2);
constexpr size_t OFF_LGLT = OFF_LG2T + al_((size_t)ADIM * 128 * 2);
constexpr size_t OFF_XinH = OFF_LGLT + al_((size_t)2 * BKEY * 64 * 2);
constexpr size_t OFF_H = OFF_XinH + al_((size_t)CGR * S5ROWS * 256 * 2);
constexpr size_t OFF_Pconv = OFF_H + al_((size_t)MT * D * 2);
constexpr size_t OFF_Plo = OFF_Pconv + al_((size_t)MT * CONV * 2);
constexpr size_t OFF_Pg = OFF_Plo + al_((size_t)MT * NLO * 2);
constexpr size_t OFF_F = OFF_Pg + al_((size_t)MT * NGT * 2);
constexpr size_t OFF_KK = OFF_F + al_((size_t)MT * CONV * 2);
constexpr int GLT = 2 * NBATCH * BH * (TS / 64);
constexpr size_t OFF_GS = OFF_KK + al_((size_t)MT * (ADIM * 5 + BKEY * 2) * 2);
constexpr size_t OFF_GQ = OFF_GS + al_((size_t)GLT * BHV * BHK * 2);
constexpr size_t OFF_GE = OFF_GQ + al_((size_t)GLT * 64 * BHK * 2);
constexpr size_t OFF_Sloc = OFF_GE + al_((size_t)GLT * BHK * 4);
constexpr size_t WS_TOTAL = OFF_Sloc + al_((size_t)CGR * S5ROWS * 256 * 4);
static_assert(WS_TOTAL <= (size_t)1416134720, "workspace must fit the guaranteed size (sum of the input bytes)");
static_assert((size_t)SLOTS * D * 2 <= (size_t)MT * (ADIM * 5 + BKEY * 2) * 2, "Hs must fit the feature region");
static_assert((size_t)SLOTS * D * 2 <= (size_t)MT * NGT * 2 && (size_t)SLOTS * DE * 2 <= (size_t)MT * CONV * 2, "Y / Hg must fit");
constexpr size_t OFF_Z = OFF_Pconv, OFF_O = OFF_Pconv + (size_t)2 * MT * ADIM * 2, OFF_Hg = OFF_Pconv, OFF_Y = OFF_Pg;
constexpr size_t OFF_YA = OFF_F, OFF_YB = OFF_YA + (size_t)MT * YCP * 2, OFF_YC = OFF_YB + (size_t)MT * YCP * 2, OFF_TC = OFF_YC + (size_t)MT * CDIM * 2;
constexpr size_t OFF_SW = OFF_KK + (size_t)MT * ADIM * 2, OFF_AA = OFF_SW + (size_t)2 * MT * ADIM * 2, OFF_GG = OFF_AA + (size_t)2 * MT * ADIM * 2, OFF_U = OFF_KK, OFF_Hs = OFF_KK;
constexpr size_t OFF_PbT = OFF_PaT + (size_t)D * YCP * 2, OFF_PcT = OFF_PbT + (size_t)D * YCP * 2;
#define GAS __attribute__((address_space(1)))
struct Params {
    const float* in[42];
    float* out;
    unsigned char* ws;
#define WSP(type, name) __device__ __forceinline__ type* name() const { GAS unsigned char* w = (GAS unsigned char*)ws; asm volatile("" : "+s"(w)); return (type*)(GAS type*)(w + OFF_##name); }
    WSP(unsigned, bar) WSP(int, cnt) WSP(int, blkcnt) WSP(float, MOD) WSP(float, Xc) WSP(int, pos) WSP(float, wsel) WSP(float, Sloc)
    WSP(half_t, WinT) WSP(half_t, PaT) WSP(half_t, PbT) WSP(half_t, PcT) WSP(half_t, WoT) WSP(half_t, W13T) WSP(half_t, W2T) WSP(half_t, GluT) WSP(half_t, MstT) WSP(half_t, McatT)
    WSP(half_t, LW2T) WSP(half_t, LA2T) WSP(half_t, LG2T) WSP(half_t, LGLT) WSP(half_t, XinH) WSP(half_t, H) WSP(half_t, Pconv) WSP(half_t, Plo) WSP(half_t, Pg) WSP(half_t, F)
    WSP(half_t, KK) WSP(half_t, SW) WSP(half_t, AA) WSP(half_t, GG) WSP(half_t, Z) WSP(half_t, O) WSP(half_t, TC) WSP(half_t, YA) WSP(half_t, YB) WSP(half_t, YC) WSP(half_t, U)
    WSP(half_t, Hg) WSP(half_t, Y) WSP(half_t, Hs) WSP(half_t, GS) WSP(half_t, GQ) WSP(float, GE)
#undef WSP
};
enum { I_X = 0, I_C, I_CTX, I_CCTX, I_MODW, I_MODB, I_N1G, I_N2G, I_WIN, I_CONVW, I_RKW0, I_RKW2, I_RKA0, I_RKA2, I_RKG2, I_RKKK, I_RKKA, I_RKRK, I_RKGNW, I_RKGNB,
       I_GLAA2, I_GLAAB, I_GLANG, I_S5LRE, I_S5LIM, I_S5LDT, I_S5BRE, I_S5BIM, I_S5CRE, I_S5CIM, I_S5D, I_S5GLU, I_PA, I_PB, I_PC, I_WOUT, I_RW, I_RB, I_W1, I_W3, I_W2, I_FG };

extern __shared__ __attribute__((aligned(16))) unsigned char smem[];

__device__ __forceinline__ float sigmoidf_(float x) { return 1.0f / (1.0f + __expf(-x)); }
__device__ __forceinline__ float siluf_(float x) { return x * sigmoidf_(x); }
__device__ __forceinline__ float wave_sum(float v) {
#pragma unroll
    for (int o = 1; o < 64; o <<= 1) v += __shfl_xor(v, o);
    return v;
}
template <int CTRL> __device__ __forceinline__ float dpp_f(float x) {
    return __builtin_bit_cast(float, __builtin_amdgcn_update_dpp(0, __builtin_bit_cast(int, x), CTRL, 0xf, 0xf, true));
}
__device__ __forceinline__ float red8(float x) { x += dpp_f<0xB1>(x); x += dpp_f<0x4E>(x); x += dpp_f<0x141>(x); return x; }
__device__ __forceinline__ float wave_sum_fast(float x);
__device__ __forceinline__ float red16(float x) { x = red8(x); x += dpp_f<0x140>(x); return x; }
__device__ __forceinline__ void lds_barrier() { asm volatile("s_waitcnt lgkmcnt(0)" ::: "memory"); __builtin_amdgcn_s_barrier(); asm volatile("" ::: "memory"); }
__device__ __forceinline__ float wave_sum_fast(float x) { x = red16(x); const int xi = __builtin_bit_cast(int, x);
    const float a = __builtin_bit_cast(float, __builtin_amdgcn_readlane(xi, 0)), b = __builtin_bit_cast(float, __builtin_amdgcn_readlane(xi, 16));
    const float c = __builtin_bit_cast(float, __builtin_amdgcn_readlane(xi, 32)), d = __builtin_bit_cast(float, __builtin_amdgcn_readlane(xi, 48)); return (a + b) + (c + d); }
__device__ __forceinline__ int modrow_of(int row) { return row < RL ? (row >> 12) : 4; }
__device__ __forceinline__ float* xrow_ptr(const Params& P, int row) { return row < RL ? P.out + (size_t)row * D : P.Xc() + (size_t)(row - RL) * D; }
__device__ __forceinline__ const float* pin(int i);
__device__ __forceinline__ const float* xsrc_ptr(const Params& P, int row, int l) {
    if (l == 0) return row < RL ? pin(I_X) + (size_t)row * D : pin(I_CTX) + (size_t)(row - RL) * D;
    return xrow_ptr(P, row);
}
__device__ __forceinline__ int tokrow(int d, int b, int s) {
    if (s < CTXL) return RL + b * CTXL + (d ? (CTXL - 1 - s) : s);
    const int t = s - CTXL; return b * SEQ + (d ? (SEQ - 1 - t) : t);
}
__device__ __forceinline__ int s5_block_row0(int b, int n) { return n < 16 ? RL + b * CTXL + n * 16 : b * SEQ + (n - 16) * 16; }
__device__ __forceinline__ h4 to_h4(f4 v) { h4 r; r[0] = (half_t)v[0]; r[1] = (half_t)v[1]; r[2] = (half_t)v[2]; r[3] = (half_t)v[3]; return r; }

__device__ __forceinline__ int tid_() { int t = threadIdx.x; asm volatile("" : "+v"(t)); return t; }
__device__ __forceinline__ const float* pin(int i) { asm volatile("" : "+s"(i)); const float* p = ((const float* const __attribute__((address_space(4)))*)__builtin_amdgcn_kernarg_segment_ptr())[i];
    return (const float*)(const GAS float*)p; }
__device__ __forceinline__ int wid_of(int tid) { return __builtin_amdgcn_readfirstlane(tid >> 6); }
__device__ __forceinline__ int bid_() { int b = blockIdx.x; asm volatile("" : "+s"(b)); return b; }
#define XB_TMO      128
#define XB_XCNT(j)  (256  + 64 * (j))
#define XB_XSUB(j)  (1280 + 64 * (j))
#define XB_XGEN(j)  (2304 + 64 * (j))
#define XB_TOP      3328
#define XB_TOPGEN   3392
#define XCD_BAR_WORDS 3456
#define XB_SPIN_CAP (1u << 22)
#define LAS __attribute__((address_space(3)))

__device__ __forceinline__ unsigned xb_ld(unsigned* p)              { return __hip_atomic_load(p, __ATOMIC_RELAXED, __HIP_MEMORY_SCOPE_AGENT); }
__device__ __forceinline__ unsigned xb_add(unsigned* p, unsigned v) { return __hip_atomic_fetch_add(p, v, __ATOMIC_RELAXED, __HIP_MEMORY_SCOPE_AGENT); }
__device__ __forceinline__ unsigned xb_xcc_id() { return (unsigned)__builtin_amdgcn_s_getreg((3 << 11) | 20) & 0xFu; }
#define XB_SPIN(cond, bar) do { unsigned _sp = 0; while (cond) { __builtin_amdgcn_s_sleep(1); \
    if ((++_sp & 255u) == 0u) { if (xb_ld(&(bar)[XB_TMO])) break; if (_sp > XB_SPIN_CAP) { atomicAdd(&(bar)[XB_TMO], 1u); break; } } } } while (0)

struct XcdBarrier {
    unsigned* bar; unsigned x;
    volatile LAS unsigned* st;
};

__device__ __forceinline__ XcdBarrier xcd_barrier_post(unsigned* bar, volatile LAS unsigned* st) {
    XcdBarrier b; b.bar = bar; b.x = xb_xcc_id(); b.st = st;
    if (threadIdx.x == 0) (void)xb_add(&bar[XB_XCNT(b.x)], 1u);
    return b;
}
__device__ __forceinline__ void xcd_barrier_complete(unsigned* bar, unsigned x, unsigned& nloc, unsigned& nx) {
    asm volatile("" : "+s"(x));
    const unsigned G = gridDim.x * gridDim.y * gridDim.z;
    unsigned sum, cnt, mine, sp = 0u;
    for (;;) {
        sum = 0u; cnt = 0u; mine = 0u;
#pragma unroll
        for (unsigned j = 0; j < 16; ++j) { const unsigned c = xb_ld(&bar[XB_XCNT(j)]); sum += c; cnt += (c > 0u) ? 1u : 0u; mine = (j == x) ? c : mine; }
        if (sum == G) break;
        __builtin_amdgcn_s_sleep(1);
        if ((++sp & 255u) == 0u) { if (xb_ld(&bar[XB_TMO])) break; if (sp > XB_SPIN_CAP) { atomicAdd(&bar[XB_TMO], 1u); break; } }
    }
    nloc = mine > 0u ? mine : 1u; nx = cnt > 0u ? cnt : 1u;
}

__device__ __forceinline__ void xcd_barrier(const XcdBarrier& b) {
    asm volatile("s_waitcnt vmcnt(0)" ::: "memory");
    __syncthreads();
    if (threadIdx.x == 0) {
        __attribute__((address_space(1))) unsigned* gbar = (__attribute__((address_space(1))) unsigned*)b.bar; asm volatile("" : "+s"(gbar));
        unsigned* bar = (unsigned*)gbar;
        __builtin_amdgcn_s_waitcnt(0);
        unsigned nloc = b.st[0], nx = b.st[1];
        if (nloc == 0u) { xcd_barrier_complete(bar, b.x, nloc, nx); b.st[0] = nloc; b.st[1] = nx; }
        const unsigned old = xb_add(&bar[XB_XSUB(b.x)], 1u);
        const unsigned gen = old / nloc;
        if (old + 1u == (gen + 1u) * nloc) {
            __builtin_amdgcn_fence(__ATOMIC_RELEASE, "agent");
            asm volatile("s_waitcnt vmcnt(0)" ::: "memory");
            const unsigned og = xb_add(&bar[XB_TOP], 1u);
            const unsigned tg = og / nx;
            if (og + 1u == (tg + 1u) * nx) xb_add(&bar[XB_TOPGEN], 1u);
            else XB_SPIN(xb_ld(&bar[XB_TOPGEN]) == tg, bar);
            __builtin_amdgcn_fence(__ATOMIC_ACQUIRE, "agent");
            xb_add(&bar[XB_XGEN(b.x)], 1u);
            asm volatile("s_waitcnt vmcnt(0)" ::: "memory");
        } else {
            XB_SPIN(xb_ld(&bar[XB_XGEN(b.x)]) == gen, bar);
            __builtin_amdgcn_fence(__ATOMIC_ACQUIRE, "agent");
            asm volatile("s_waitcnt vmcnt(0)" ::: "memory");
        }
    }
    __syncthreads();
}


constexpr int GST = 72;
constexpr int GEMM_LDS = 2 * 2 * 128 * GST * 2;
template <class AF, class BF>
__device__ __forceinline__ void gemm_tile(int nk, AF afn, BF bfn, f4 (&acc)[4][2]) {
    half_t* As = (half_t*)smem; half_t* Bs = As + 2 * 128 * GST;
    const int tid = tid_(), lane = tid & 63, w = wid_of(tid), wm = w >> 2, wn = w & 3;
    const int pr0 = tid >> 3, pk = (tid & 7) * 8;
    uint4 ra[2], rb[2];
#pragma unroll
    for (int i = 0; i < 2; ++i) { ra[i] = afn(pr0 + 64 * i, pk); rb[i] = bfn(pr0 + 64 * i, pk); }
    __syncthreads();
#pragma unroll
    for (int i = 0; i < 2; ++i) { *(uint4*)(As + (pr0 + 64 * i) * GST + pk) = ra[i]; *(uint4*)(Bs + (pr0 + 64 * i) * GST + pk) = rb[i]; }
    __syncthreads();
    for (int kt = 0; kt < nk; ++kt) {
        const int cur = kt & 1;
        if (kt + 1 < nk) {
#pragma unroll
            for (int i = 0; i < 2; ++i) { ra[i] = afn(pr0 + 64 * i, (kt + 1) * 64 + pk); rb[i] = bfn(pr0 + 64 * i, (kt + 1) * 64 + pk); }
        }
        const half_t* Ac = As + cur * 128 * GST; const half_t* Bc = Bs + cur * 128 * GST;
#pragma unroll
        for (int ks = 0; ks < 2; ++ks) {
            h8 af[4], bf[2];
#pragma unroll
            for (int mi = 0; mi < 4; ++mi) af[mi] = *(const h8*)(Ac + (64 * wm + 16 * mi + (lane & 15)) * GST + 32 * ks + 8 * (lane >> 4));
#pragma unroll
            for (int ni = 0; ni < 2; ++ni) bf[ni] = *(const h8*)(Bc + (32 * wn + 16 * ni + (lane & 15)) * GST + 32 * ks + 8 * (lane >> 4));
#pragma unroll
            for (int mi = 0; mi < 4; ++mi)
#pragma unroll
                for (int ni = 0; ni < 2; ++ni) acc[mi][ni] = __builtin_amdgcn_mfma_f32_16x16x32_f16(bf[ni], af[mi], acc[mi][ni], 0, 0, 0);
        }
        if (kt + 1 < nk) {
            half_t* An = As + (cur ^ 1) * 128 * GST; half_t* Bn = Bs + (cur ^ 1) * 128 * GST;
#pragma unroll
            for (int i = 0; i < 2; ++i) { *(uint4*)(An + (pr0 + 64 * i) * GST + pk) = ra[i]; *(uint4*)(Bn + (pr0 + 64 * i) * GST + pk) = rb[i]; }
        }
        __syncthreads();
    }
}
__device__ __forceinline__ void acc_zero(f4 (&acc)[4][2]) {
#pragma unroll
    for (int mi = 0; mi < 4; ++mi)
#pragma unroll
        for (int ni = 0; ni < 2; ++ni) acc[mi][ni] = (f4){0.f, 0.f, 0.f, 0.f};
}
template <class FN> __device__ __forceinline__ void acc_foreach(const f4 (&acc)[4][2], FN fn) {
    const int lane = tid_() & 63, w = wid_of(tid_()), wm = w >> 2, wn = w & 3;
#pragma unroll
    for (int mi = 0; mi < 4; ++mi)
#pragma unroll
        for (int ni = 0; ni < 2; ++ni) fn(64 * wm + 16 * mi + (lane & 15), 32 * wn + 16 * ni + 4 * (lane >> 4), acc[mi][ni]);
}
template <class LD, class ST> __device__ __forceinline__ void acc_foreach2(const f4 (&acc)[4][2], LD ld, ST st) {
    const int lane = tid_() & 63, w = wid_of(tid_()), wm = w >> 2, wn = w & 3;
    decltype(ld(0, 0)) tmp[4][2];
#pragma unroll
    for (int mi = 0; mi < 4; ++mi)
#pragma unroll
        for (int ni = 0; ni < 2; ++ni) tmp[mi][ni] = ld(64 * wm + 16 * mi + (lane & 15), 32 * wn + 16 * ni + 4 * (lane >> 4));
#pragma unroll
    for (int mi = 0; mi < 4; ++mi)
#pragma unroll
        for (int ni = 0; ni < 2; ++ni) st(64 * wm + 16 * mi + (lane & 15), 32 * wn + 16 * ni + 4 * (lane >> 4), acc[mi][ni], tmp[mi][ni]);
}
__device__ __forceinline__ uint4 ld16(const half_t* p) { return *(const uint4*)p; }
__device__ __forceinline__ uint4 zero16() { return make_uint4(0u, 0u, 0u, 0u); }

namespace pg8 {
constexpr int BM = 256, BK = 64, HALF = 128, HTB = HALF * BK * 2, STAGE_BYTES = 8 * HTB, NXCD = 8, WGM = 8;
__host__ __device__ __forceinline__ int lds_byte(int r, int c) { const int st = (r >> 4) * 2 + (c >> 5), rr = r & 15, cc = c & 31, ob = rr * 64 + cc * 2; return st * 1024 + (ob ^ (((ob >> 9) & 1) << 5)); }
__host__ __device__ __forceinline__ void stage_rc(int b, int& R, int& C) { const int st = b / 1024, sb = b % 1024, swz = sb ^ (((sb >> 9) & 1) << 5); R = (st >> 1) * 16 + swz / 64; C = (st & 1) * 32 + (swz % 64) / 2; }
__host__ __device__ __forceinline__ int perm32(int rho) { const int n = rho >> 4, i = rho & 15; return 8 * (i >> 2) + 4 * n + (i & 3); }
struct Unit { const char* A; const char* B; int pm, pn; };
struct TileOrder {
    int nM, nN, nwg, G, c, lim;
    __device__ __forceinline__ void init(int nM_, int nN_, int G_, int c_, int lim_ = 1 << 30) { nM = nM_; nN = nN_; nwg = nM * nN; G = G_; c = c_; lim = lim_ < nwg ? lim_ : nwg; }
    __device__ __forceinline__ bool tile(int i, int& pm, int& pn) const {
        const long L = (long)i * G + c; if (L >= lim) return false;
        int wgid = (int)L; { const int q = nwg / NXCD, r = nwg % NXCD, xcd = wgid % NXCD, off = wgid / NXCD; wgid = (xcd < r ? xcd * (q + 1) : r * (q + 1) + (xcd - r) * q) + off; }
        const int nig = WGM * nN, gid = wgid / nig, fm = gid * WGM, gsz = (nM - fm) < WGM ? (nM - fm) : WGM;
        pm = fm + ((wgid % nig) % gsz); pn = (wgid % nig) / gsz; return true;
    }
};
typedef f4 Acc[2][2][4][2];
template <bool PERM = false, class Sched, class Epi>
__device__ __forceinline__ void gemm_phase(const int K, const Sched& S, const Epi& E) {
    LAS unsigned char* lds = (LAS unsigned char*)smem;
    const int tid = tid_(), wid = __builtin_amdgcn_readfirstlane(tid >> 6), lane = tid & 63, wr = wid >> 2, wc = wid & 3, fr = lane & 15, fq = lane >> 4;
    const int nt = K / BK;
    unsigned voff[2], voffB[2];
#pragma unroll
    for (int i = 0; i < 2; ++i) { int R, C; stage_rc(tid * 16 + i * 8192, R, C); const int Rb = PERM ? ((R & ~31) + perm32(R & 31)) : R; voff[i] = (unsigned)(R * K + C) * 2u; voffB[i] = (unsigned)(Rb * K + C) * 2u; }
    const size_t kstep = (size_t)(BK * 2);
    const size_t hstep = (size_t)HALF * K * 2;
    const unsigned ldsw = (unsigned)wid * 1024u;
    const int aoff = lds_byte(wr * 64 + fr, fq * 8), boff = lds_byte(wc * 32 + fr, fq * 8);
#define PG8_SA(b, h) (((b) * 2 + (h)) * HTB)
#define PG8_SB(b, h) ((4 + (b) * 2 + (h)) * HTB)
#define PG8_STAGEV(bufoff, gbase, vo) do { _Pragma("unroll") for (int _i = 0; _i < 2; ++_i) \
        __builtin_amdgcn_global_load_lds((const unsigned*)((const char*)(gbase) + vo[_i]), (LAS unsigned*)(lds + (bufoff) + ldsw + _i * 8192), 16, 0, 0); } while (0)
#define PG8_STAGE(bufoff, gbase) PG8_STAGEV(bufoff, gbase, voff)
#define PG8_STAGEB(bufoff, gbase) PG8_STAGEV(bufoff, gbase, voffB)
#define PG8_LDA(dst, b, h) do { _Pragma("unroll") for (int m = 0; m < 4; ++m) _Pragma("unroll") for (int k = 0; k < 2; ++k) dst[m][k] = *(const LAS h8*)(lds + PG8_SA(b, h) + aoff + m * 2048 + k * 1024); } while (0)
#define PG8_LDB(dst, b, h) do { _Pragma("unroll") for (int n = 0; n < 2; ++n) _Pragma("unroll") for (int k = 0; k < 2; ++k) dst[n][k] = *(const LAS h8*)(lds + PG8_SB(b, h) + boff + n * 2048 + k * 1024); } while (0)
#define PG8_MMA(ai, bj, At, Bt) do { __builtin_amdgcn_s_setprio(1); _Pragma("unroll") for (int m = 0; m < 4; ++m) _Pragma("unroll") for (int n = 0; n < 2; ++n) _Pragma("unroll") for (int k = 0; k < 2; ++k) \
        acc[ai][bj][m][n] = __builtin_amdgcn_mfma_f32_16x16x32_f16(Bt[n][k], At[m][k], acc[ai][bj][m][n], 0, 0, 0); __builtin_amdgcn_s_setprio(0); } while (0)
#define PG8_WAIT_V(n) asm volatile("s_waitcnt vmcnt(" #n ")" ::: "memory")
#define PG8_WAIT_L(n) asm volatile("s_waitcnt lgkmcnt(" #n ")" ::: "memory")
#define PG8_BAR __builtin_amdgcn_s_barrier()
#define PG8_SCHED __builtin_amdgcn_sched_barrier(0)
    Unit cur, nxt; int ui = 0;
    if (!S.next(0, cur)) return;
    Acc acc;
#pragma unroll
    for (int a = 0; a < 2; ++a)
#pragma unroll
        for (int b = 0; b < 2; ++b)
#pragma unroll
            for (int m = 0; m < 4; ++m)
#pragma unroll
                for (int n = 0; n < 2; ++n) acc[a][b][m][n] = (f4){0.f, 0.f, 0.f, 0.f};
    h8 At[4][2], B0[2][2], B1[2][2];
    const char* cA = cur.A; const char* cB = cur.B;
    PG8_STAGEB(PG8_SB(0, 0), cB); PG8_STAGE(PG8_SA(0, 0), cA); PG8_STAGEB(PG8_SB(0, 1), cB + hstep); PG8_STAGE(PG8_SA(0, 1), cA + hstep);
    if (wr == 1) PG8_BAR;
    PG8_WAIT_V(4); PG8_BAR;
    PG8_STAGEB(PG8_SB(1, 0), cB + kstep); PG8_STAGE(PG8_SA(1, 0), cA + kstep); PG8_STAGEB(PG8_SB(1, 1), cB + hstep + kstep);
    PG8_WAIT_V(6); PG8_BAR;
    for (;;) {
        const bool has_next = S.next(ui + 1, nxt);
        const char* nA = has_next ? nxt.A : cA; const char* nB = has_next ? nxt.B : cB;
        for (int t = 0; t < nt; t += 2) {
            const bool last = (t == nt - 2);
            const char* a1 = cA + (size_t)(t + 1) * kstep;
            const char* a2 = last ? nA : cA + (size_t)(t + 2) * kstep; const char* b2 = last ? nB : cB + (size_t)(t + 2) * kstep;
            const char* a3 = a2 + kstep; const char* b3 = b2 + kstep;
            PG8_LDB(B0, 0, 0); PG8_SCHED; PG8_LDA(At, 0, 0); PG8_STAGE(PG8_SA(1, 1), a1 + hstep);
            PG8_WAIT_L(8); PG8_BAR; PG8_WAIT_L(0); PG8_MMA(0, 0, At, B0); PG8_BAR; PG8_SCHED;
            PG8_LDB(B1, 0, 1); PG8_STAGEB(PG8_SB(0, 0), b2);
            PG8_BAR; PG8_WAIT_L(0); PG8_MMA(0, 1, At, B1); PG8_BAR;
            PG8_LDA(At, 0, 1); PG8_STAGE(PG8_SA(0, 0), a2);
            PG8_BAR; PG8_WAIT_L(0); PG8_MMA(1, 0, At, B0); PG8_BAR; PG8_SCHED;
            PG8_STAGEB(PG8_SB(0, 1), b2 + hstep);
            PG8_WAIT_V(6); PG8_BAR; PG8_MMA(1, 1, At, B1); PG8_BAR;
            PG8_LDB(B0, 1, 0); PG8_SCHED; PG8_LDA(At, 1, 0); PG8_STAGE(PG8_SA(0, 1), a2 + hstep);
            PG8_WAIT_L(8); PG8_BAR; PG8_WAIT_L(0); PG8_MMA(0, 0, At, B0); PG8_BAR; PG8_SCHED;
            PG8_LDB(B1, 1, 1); PG8_STAGEB(PG8_SB(1, 0), b3);
            PG8_BAR; PG8_WAIT_L(0); PG8_MMA(0, 1, At, B1); PG8_BAR;
            PG8_LDA(At, 1, 1); PG8_STAGE(PG8_SA(1, 0), a3);
            PG8_BAR; PG8_WAIT_L(0); PG8_MMA(1, 0, At, B0); PG8_BAR; PG8_SCHED;
            PG8_STAGEB(PG8_SB(1, 1), b3 + hstep);
            PG8_WAIT_V(6); PG8_BAR; PG8_MMA(1, 1, At, B1); PG8_BAR;
        }
        E(acc, cur, wr, wc, fr, fq);
        if (!has_next) break;
#pragma unroll
        for (int a = 0; a < 2; ++a)
#pragma unroll
            for (int b = 0; b < 2; ++b)
#pragma unroll
                for (int m = 0; m < 4; ++m)
#pragma unroll
                    for (int n = 0; n < 2; ++n) acc[a][b][m][n] = (f4){0.f, 0.f, 0.f, 0.f};
        cur = nxt; cA = nA; cB = nB; ++ui;
    }
    PG8_WAIT_V(0);
    if (wr == 0) PG8_BAR;
    PG8_BAR;
#undef PG8_SA
#undef PG8_SB
#undef PG8_STAGE
#undef PG8_STAGEB
#undef PG8_STAGEV
#undef PG8_LDA
#undef PG8_LDB
#undef PG8_MMA
#undef PG8_WAIT_V
#undef PG8_WAIT_L
#undef PG8_BAR
#undef PG8_SCHED
}
template <class FN> __device__ __forceinline__ void foreach_frag(const Acc& acc, int wr, int wc, int fr, int fq, FN fn) {
#pragma unroll
    for (int ai = 0; ai < 2; ++ai)
#pragma unroll
        for (int m = 0; m < 4; ++m)
        { int row = ai * HALF + wr * 64 + m * 16 + fr; asm volatile("" : "+v"(row));
#pragma unroll
            for (int bj = 0; bj < 2; ++bj)
#pragma unroll
                for (int n = 0; n < 2; ++n) fn(row, bj * HALF + wc * 32 + n * 16 + 4 * fq, acc[ai][bj][m][n]); }
}
template <class FN> __device__ __forceinline__ void foreach_frag8(const Acc& acc, int wr, int wc, int fr, int fq, FN fn) {
#pragma unroll
    for (int ai = 0; ai < 2; ++ai)
#pragma unroll
        for (int m = 0; m < 4; ++m)
        { int row = ai * HALF + wr * 64 + m * 16 + fr; asm volatile("" : "+v"(row));
#pragma unroll
            for (int bj = 0; bj < 2; ++bj) fn(row, bj * HALF + wc * 32 + 8 * fq, acc[ai][bj][m][0], acc[ai][bj][m][1]); }
}
template <class LD, class ST> __device__ __forceinline__ void foreach_frag2(const Acc& acc, int wr, int wc, int fr, int fq, LD ld, ST st) {
#pragma unroll
    for (int ai = 0; ai < 2; ++ai)
#pragma unroll
        for (int mp = 0; mp < 2; ++mp) {
            int row0 = ai * HALF + wr * 64 + mp * 32 + fr; asm volatile("" : "+v"(row0));
            decltype(ld(0, 0)) tmp[2][2][2];
#pragma unroll
            for (int mm = 0; mm < 2; ++mm)
#pragma unroll
                for (int bj = 0; bj < 2; ++bj)
#pragma unroll
                    for (int n = 0; n < 2; ++n) tmp[mm][bj][n] = ld(row0 + 16 * mm, bj * HALF + wc * 32 + n * 16 + 4 * fq);
#pragma unroll
            for (int mm = 0; mm < 2; ++mm)
#pragma unroll
                for (int bj = 0; bj < 2; ++bj)
#pragma unroll
                    for (int n = 0; n < 2; ++n) st(row0 + 16 * mm, bj * HALF + wc * 32 + n * 16 + 4 * fq, acc[ai][bj][2 * mp + mm][n], tmp[mm][bj][n]);
        }
}
template <class FN> __device__ __forceinline__ void foreach_pair(const Acc& acc, int wr, int wc, int fr, int fq, FN fn) {
#pragma unroll
    for (int ai = 0; ai < 2; ++ai)
#pragma unroll
        for (int m = 0; m < 4; ++m)
        { int row = ai * HALF + wr * 64 + m * 16 + fr; asm volatile("" : "+v"(row));
#pragma unroll
            for (int bj = 0; bj < 2; ++bj) fn(row, bj * 64 + wc * 16 + 4 * fq, acc[ai][bj][m][0], acc[ai][bj][m][1]); }
}
}

__device__ __forceinline__ void ph_prologue(const Params& P) {
    const int tid = tid_(), G = gridDim.x, bid = bid_();
    float* cs = (float*)smem;
    float* red = cs + 5 * D;
    for (int i = tid; i < 5 * D; i += NTHREADS) { const int r = i / D, k = i % D; const float v = r < 4 ? pin(I_C)[r * D + k] : pin(I_CCTX)[k]; cs[i] = siluf_(v); }
    __syncthreads();
    const int lane = tid & 63, w = wid_of(tid);
    for (int t = bid; t < 2 * 96; t += G) {
        const int l = t / 96, n0 = (t % 96) * 128;
        const float* W = pin(I_MODW) + (size_t)l * D * (6 * D) + n0 + 2 * lane;
        float a[5][2];
#pragma unroll
        for (int r = 0; r < 5; ++r) { a[r][0] = 0.f; a[r][1] = 0.f; }
#pragma unroll 16
        for (int k = w * 256; k < w * 256 + 256; ++k) {
            const f2 wv = *(const f2*)(W + (size_t)k * (6 * D));
#pragma unroll
            for (int r = 0; r < 5; ++r) { const float c = cs[r * D + k]; a[r][0] += c * wv[0]; a[r][1] += c * wv[1]; }
        }
#pragma unroll
        for (int r = 0; r < 5; ++r) { red[(w * 5 + r) * 128 + 2 * lane] = a[r][0]; red[(w * 5 + r) * 128 + 2 * lane + 1] = a[r][1]; }
        __syncthreads();
        for (int i = tid; i < 5 * 128; i += NTHREADS) {
            const int r = i / 128, n = i % 128; float s = 0.f;
#pragma unroll
            for (int ww = 0; ww < 8; ++ww) s += red[(ww * 5 + r) * 128 + n];
            P.MOD()[((size_t)l * 5 + r) * (6 * D) + n0 + n] = s + pin(I_MODB)[(size_t)l * 6 * D + n0 + n];
        }
        __syncthreads();
    }
}

template <int KT = 1, class CF> __device__ __forceinline__ void convert_tile(half_t* dst, int K, int ld, int tn, int tk, CF colptr, int kmax = 1 << 30) {
    float* st = (float*)smem;
    const int tid = tid_(), n0 = tn * 64, k0 = tk * 64 * KT;
    {
        const int nl = tid & 63, kk = wid_of(tid); bool ok = true; const float* cp = colptr(n0 + nl, ok);
        float v[8 * KT];
#pragma unroll
        for (int i = 0; i < 8 * KT; ++i) { const int k = kk + 8 * i; const bool kin = (k0 + k) < kmax; v[i] = cp[(size_t)(kin ? k0 + k : 0) * ld]; v[i] = (ok && kin) ? v[i] : 0.f; }
#pragma unroll
        for (int i = 0; i < 8 * KT; ++i) st[(kk + 8 * i) * 65 + nl] = v[i];
    }
    __syncthreads();
    {
        const int nl = tid >> 3, kc = (tid & 7) * 8;
#pragma unroll
        for (int j = 0; j < KT; ++j) { h8 v;
#pragma unroll
            for (int i = 0; i < 8; ++i) v[i] = (half_t)st[(64 * j + kc + i) * 65 + nl];
            *(h8*)(dst + (size_t)(n0 + nl) * K + k0 + 64 * j + kc) = v; }
    }
    __syncthreads();
}
template <class CF> __device__ __forceinline__ void convert_wide(half_t* dst, int K, int ld, int tn, int tk, CF colptr4) {
    float* st = (float*)smem;
    const int tid = tid_(), n0 = tn * 256, k0 = tk * 64;
    {
        const int ng = (tid & 63) * 4, kk = wid_of(tid); bool ok = true; const float* cp = colptr4(n0 + ng, ok);
        f4 v[8];
#pragma unroll
        for (int i = 0; i < 8; ++i) { v[i] = *(const f4*)(cp + (size_t)(k0 + kk + 8 * i) * ld); if (!ok) v[i] = (f4){0.f, 0.f, 0.f, 0.f}; }
#pragma unroll
        for (int i = 0; i < 8; ++i) { const int k = kk + 8 * i; *(f4*)(st + k * 260 + (ng ^ (8 * ((k >> 3) & 3)))) = v[i]; }
    }
    __syncthreads();
#pragma unroll
    for (int j = 0; j < 4; ++j) { const int pidx = tid + NTHREADS * j, nl = pidx >> 3, kc = (pidx & 7) * 8, nsw = nl ^ (8 * ((kc >> 3) & 3)); h8 v;
#pragma unroll
        for (int i = 0; i < 8; ++i) v[i] = (half_t)st[(kc + i) * 260 + nsw];
        *(h8*)(dst + (size_t)(n0 + nl) * K + k0 + kc) = v; }
    __syncthreads();
}
__device__ __forceinline__ void ph_setup(const Params& P, int l_in) {
    const int l = l_in;
    const int G = gridDim.x, bid = bid_(), tid = tid_();
    constexpr int T_WIN = (INPAD / 256) * (D / 64), T_PA = (D / 64) * (ADIM / 64), T_PB = T_PA, T_PC = (D / 64) * (CDIM / 64), T_WO = (D / 256) * (D / 64);
    constexpr int T_LW = 2 * (ADIM / 64), T_LA = T_LW, T_LG = (ADIM / 64) * 2, T_LL = 2 * (BKEY / 64);
    constexpr int T_W13 = NE * (2 * DE / 256) * (D / 64), T_W2 = NE * (D / 256) * (DE / 64), T_GLU = (2 * CDIM / 64) * (CDIM / 64);
    constexpr int T_ALL = T_WIN + T_PA + T_PB + T_PC + T_WO + T_GLU + T_LW + T_LA + T_LG + T_LL;
    const bool s5blk = (G == 256) && bid < 32;
    const int t_first = (G != 256) ? bid : (s5blk ? 224 + (bid % 24) + 248 * (bid / 24) : bid - 32), t_step = (G != 256) ? G : 248;
    for (int tq = t_first, qi = bid; tq < T_ALL; ) {
        const int t = tq;
        if (s5blk) { qi += 32; tq = 248 * (qi / 24) + 224 + (qi % 24); } else tq += t_step;
        int r = t, l = l_in; asm volatile("" : "+s"(l));

        if (r < T_WIN) { const float* src = pin(I_WIN) + (size_t)l * D * INSRC;
            convert_wide(P.WinT(), D, INSRC, r / (D / 64), r % (D / 64), [&](int n, bool& ok) -> const float* { ok = !(n >= 5536 && n < 5632); return src + (n < 5536 ? n : (n < 5632 ? 0 : n - 96)); }); continue; } r -= T_WIN;
        if (r < T_PA) { const float* src = pin(I_PA) + (size_t)l * ADIM * D; convert_tile(P.PaT(), ADIM, D, r / (ADIM / 64), r % (ADIM / 64), [&](int n, bool&) -> const float* { return src + n; }); continue; } r -= T_PA;
        if (r < T_PB) { const float* src = pin(I_PB) + (size_t)l * BDIM * D; convert_tile(P.PbT(), BDIM, D, r / (BDIM / 64), r % (BDIM / 64), [&](int n, bool&) -> const float* { return src + n; }); continue; } r -= T_PB;
        if (r < T_PC) { const float* src = pin(I_PC) + (size_t)l * CDIM * D; convert_tile(P.PcT(), CDIM, D, r / (CDIM / 64), r % (CDIM / 64), [&](int n, bool&) -> const float* { return src + n; }); continue; } r -= T_PC;
        if (r < T_LW) { const int d = r / (ADIM / 64); const float* src = pin(I_RKW2) + (size_t)(l * 2 + d) * 64 * ADIM; convert_tile(P.LW2T() + (size_t)d * ADIM * 64, 64, ADIM, r % (ADIM / 64), 0, [&](int n, bool&) -> const float* { return src + n; }); continue; } r -= T_LW;
        if (r < T_LA) { const int d = r / (ADIM / 64); const float* src = pin(I_RKA2) + (size_t)(l * 2 + d) * 64 * ADIM; convert_tile(P.LA2T() + (size_t)d * ADIM * 64, 64, ADIM, r % (ADIM / 64), 0, [&](int n, bool&) -> const float* { return src + n; }); continue; } r -= T_LA;
        if (r < T_LG) { const float* src = pin(I_RKG2) + (size_t)l * 128 * ADIM; convert_tile(P.LG2T(), 128, ADIM, r >> 1, r & 1, [&](int n, bool&) -> const float* { return src + n; }); continue; } r -= T_LG;
        if (r < T_LL) { const int d = r / (BKEY / 64); const float* src = pin(I_GLAA2) + (size_t)(l * 2 + d) * 16 * BKEY; convert_tile(P.LGLT() + (size_t)d * BKEY * 64, 64, BKEY, r % (BKEY / 64), 0, [&](int n, bool&) -> const float* { return src + n; }, 16); continue; } r -= T_LL;
        if (r < T_WO) { const float* src = pin(I_WOUT) + (size_t)l * D * D; convert_wide(P.WoT(), D, D, r / (D / 64), r % (D / 64), [&](int n, bool&) -> const float* { return src + n; }); continue; } r -= T_WO;
        { const float* src = pin(I_S5GLU) + (size_t)l * CDIM * 2 * CDIM;
            convert_tile(P.GluT(), CDIM, 2 * CDIM, r / (CDIM / 64), r % (CDIM / 64),
                         [&](int n, bool&) -> const float* { const int j = n >> 5, wi = n & 31; return wi < 16 ? src + 16 * j + wi : src + CDIM + 16 * j + wi - 16; }); }
    }
    float* apr = (float*)smem;
    float* api = apr + 2 * 17 * 64;
    float* bbr = api + 2 * 17 * 64;
    float* bbi = bbr + 2 * 64 * 16;
    float* cre = bbi + 2 * 64 * 16;
    float* cim = cre + 16 * 64;
    float* kern = cim + 16 * 64;
    for (int g = bid; g < CGR; g += G) {
        __syncthreads();
        for (int i = tid; i < 2 * 17 * 64; i += NTHREADS) {
            const int d = i / (17 * 64), tau = (i / 64) % 17, p = i % 64;
            const float lr = pin(I_S5LRE)[((l * 2 + d) * CGR + g) * CP + p], li = pin(I_S5LIM)[((l * 2 + d) * CGR + g) * CP + p];
            const float dt = expf(pin(I_S5LDT)[(l * 2 + d) * CGR + g]);
            const float mag = expf(lr * dt * (float)tau), ang = li * dt * (float)tau;
            apr[i] = mag * cosf(ang); api[i] = mag * sinf(ang);
        }
        for (int i = tid; i < 16 * 64; i += NTHREADS) { cre[i] = pin(I_S5CRE)[((size_t)l * CGR + g) * 16 * 64 + i]; cim[i] = pin(I_S5CIM)[((size_t)l * CGR + g) * 16 * 64 + i]; }
        __syncthreads();
        for (int i = tid; i < 2 * 64 * 16; i += NTHREADS) {
            const int d = i / (64 * 16), p = (i / 16) % 64, c = i % 16;
            const float lr = pin(I_S5LRE)[((l * 2 + d) * CGR + g) * CP + p], li = pin(I_S5LIM)[((l * 2 + d) * CGR + g) * CP + p];
            const float ar = apr[(d * 17 + 1) * 64 + p], ai = api[(d * 17 + 1) * 64 + p], den = lr * lr + li * li;
            const float fr = ((ar - 1.0f) * lr + ai * li) / den, fi = (ai * lr - (ar - 1.0f) * li) / den;
            const float br = pin(I_S5BRE)[(((size_t)l * CGR + g) * CP + p) * 16 + c], bi = pin(I_S5BIM)[(((size_t)l * CGR + g) * CP + p) * 16 + c];
            bbr[i] = fr * br - fi * bi; bbi[i] = fr * bi + fi * br;
        }
        __syncthreads();
        for (int i = tid; i < 2 * 16 * 16 * 16; i += NTHREADS) {
            const int d = i >> 12, tau = (i >> 8) & 15, c = (i >> 4) & 15, c2 = i & 15; float s = 0.f;
            for (int p = 0; p < 64; ++p) {
                const float ar = apr[(d * 17 + tau) * 64 + p], ai = api[(d * 17 + tau) * 64 + p], br = bbr[(d * 64 + p) * 16 + c2], bi = bbi[(d * 64 + p) * 16 + c2];
                const float er = ar * br - ai * bi, ei = ar * bi + ai * br;
                s += cre[c * 64 + p] * er - cim[c * 64 + p] * ei;
            }
            kern[i] = s;
        }
        __syncthreads();
        half_t* Mst = P.MstT() + (size_t)g * 256 * 256; half_t* Mcat = P.McatT() + (size_t)g * 256 * 512;
        for (int i = tid; i < 256 * 256; i += NTHREADS) {
            const int n = i >> 8, k = i & 255, d = n >> 7, q = n & 127, p = q & 63, tau = k >> 4, c2 = k & 15;
            const int pw = d ? tau : 15 - tau;
            const float ar = apr[(d * 17 + pw) * 64 + p], ai = api[(d * 17 + pw) * 64 + p], br = bbr[(d * 64 + p) * 16 + c2], bi = bbi[(d * 64 + p) * 16 + c2];
            Mst[i] = (half_t)(q < 64 ? ar * br - ai * bi : ar * bi + ai * br);
        }
        for (int i = tid; i < 256 * 512; i += NTHREADS) {
            const int n = i >> 9, k = i & 511, tau = n >> 4, c = n & 15; float v;
            if (k < 256) { const int t2 = k >> 4, c2 = k & 15; v = 0.f;
                if (t2 <= tau) v += kern[((0 * 16 + (tau - t2)) * 16 + c) * 16 + c2];
                if (t2 >= tau) v += kern[((1 * 16 + (t2 - tau)) * 16 + c) * 16 + c2];
            } else { const int kk = k - 256, d = kk >> 7, q = kk & 127, p = q & 63, pw = d ? 16 - tau : tau + 1;
                const float ar = apr[(d * 17 + pw) * 64 + p], ai = api[(d * 17 + pw) * 64 + p];
                v = q < 64 ? cre[c * 64 + p] * ar - cim[c * 64 + p] * ai : -(cre[c * 64 + p] * ai + cim[c * 64 + p] * ar);
            }
            Mcat[i] = (half_t)v;
        }
    }
    if (bid == 0 && tid < 64) { P.cnt()[tid] = 0; }
}

__device__ __forceinline__ void ph_moe_convert(const Params& P, int l, int qn, int t_begin, int t_end) {
    constexpr int T_W13 = NE * (2 * DE / 256) * (D / 64);
    int* head = P.cnt() + 32 + qn; int* slot = (int*)(smem + 131072 + 1024);
    const int lim = t_end;
    for (;;) {
        __syncthreads();
        if (tid_() == 0) *slot = t_begin + atomicAdd(head, 2);
        __syncthreads();
        const int t0 = *slot;
        if (t0 >= lim) break;
#pragma unroll 1
        for (int q = 0; q < 2; ++q) { int r = t0 + q; if (r >= lim) break;
            if (r < T_W13) { const int e = r / ((2 * DE / 256) * (D / 64)), rr = r % ((2 * DE / 256) * (D / 64));
                const float* s1 = pin(I_W1) + ((size_t)l * NE + e) * D * DE; const float* s3 = pin(I_W3) + ((size_t)l * NE + e) * D * DE;
                convert_wide(P.W13T() + (size_t)e * 2 * DE * D, D, DE, rr / (D / 64), rr % (D / 64),
                             [&](int n, bool&) -> const float* { const int j = n >> 5, wi = n & 31; return wi < 16 ? s1 + 16 * j + wi : s3 + 16 * j + wi - 16; }); }
            else { r -= T_W13; const int e = r / ((D / 256) * (DE / 64)), rr = r % ((D / 256) * (DE / 64)); const float* src = pin(I_W2) + ((size_t)l * NE + e) * DE * D;
                convert_wide(P.W2T() + (size_t)e * D * DE, DE, D, rr / (DE / 64), rr % (DE / 64), [&](int n, bool&) -> const float* { return src + n; }); } }
    }
}
template <int MODE> __device__ __forceinline__ void ph_rows(const Params& P, int l) {
    const int lane = tid_() & 63, gw = bid_() * 8 + wid_of(tid_()), NW = gridDim.x * 8;
    const int nrows = MODE == 2 ? RL : MT;
    const float* gvec = MODE == 2 ? pin(I_FG) : pin(I_N1G) + (size_t)l * D;
    for (int row = gw; row < nrows; row += NW) {
        float* xr = xrow_ptr(P, row); const float* xs = MODE == 0 ? xsrc_ptr(P, row, 0) : xr; const int mr = modrow_of(row);
        f4 v[8]; float ss = 0.f;
#pragma unroll
        for (int j = 0; j < 8; ++j) v[j] = *(const f4*)(xs + (j * 64 + lane) * 4);
        if (MODE >= 1) {
            const int lp = MODE == 2 ? 1 : l - 1;
            const float* ga2 = P.MOD() + ((size_t)lp * 5 + mr) * (6 * D) + 5 * D;
            const int p0 = P.pos()[row * 2], p1 = P.pos()[row * 2 + 1]; const float w0 = P.wsel()[row * 2], w1 = P.wsel()[row * 2 + 1];
            const half_t* y0 = P.Y() + (size_t)p0 * D; const half_t* y1 = P.Y() + (size_t)p1 * D;
#pragma unroll
            for (int j = 0; j < 8; ++j) {
                const int c = (j * 64 + lane) * 4; const h4 a = *(const h4*)(y0 + c), b = *(const h4*)(y1 + c); const f4 g = *(const f4*)(ga2 + c);
#pragma unroll
                for (int i = 0; i < 4; ++i) v[j][i] += g[i] * (w0 * (float)a[i] + w1 * (float)b[i]);
            }
            if (MODE == 1) {
#pragma unroll
                for (int j = 0; j < 8; ++j) *(f4*)(xr + (j * 64 + lane) * 4) = v[j];
            }
        }
#pragma unroll
        for (int j = 0; j < 8; ++j) ss += (v[j][0] * v[j][0] + v[j][1] * v[j][1]) + (v[j][2] * v[j][2] + v[j][3] * v[j][3]);
        ss = wave_sum(ss);
        const float rstd = rsqrtf(ss * (1.0f / D) + 1e-6f);
        if (MODE == 2) {
            const float* fg = gvec;
#pragma unroll
            for (int j = 0; j < 8; ++j) { const int c = (j * 64 + lane) * 4; const f4 g = *(const f4*)(fg + c); f4 o;
#pragma unroll
                for (int i = 0; i < 4; ++i) o[i] = v[j][i] * rstd * g[i];
                *(f4*)(xr + c) = o; }
        } else {
            const float* ng = gvec; const float* sh = P.MOD() + ((size_t)l * 5 + mr) * (6 * D); const float* sc = sh + D;
            half_t* hr = P.H() + (size_t)row * D;
#pragma unroll
            for (int j = 0; j < 8; ++j) { const int c = (j * 64 + lane) * 4; const f4 g = *(const f4*)(ng + c), s1 = *(const f4*)(sc + c), s0 = *(const f4*)(sh + c); f4 o;
#pragma unroll
                for (int i = 0; i < 4; ++i) o[i] = v[j][i] * rstd * g[i] * (1.0f + s1[i]) + s0[i];
                *(h4*)(hr + c) = to_h4(o); }
        }
    }
}

struct SchedDense {
    pg8::TileOrder T; const char* A; const char* B; size_t tstepA, tstepB;
    __device__ __forceinline__ bool next(int i, pg8::Unit& u) const { int pm, pn; if (!T.tile(i, pm, pn)) return false; u.pm = pm; u.pn = pn; u.A = A + (size_t)pm * tstepA; u.B = B + (size_t)pn * tstepB; return true; }
};
template <int PART> __device__ __forceinline__ void ph_inproj(const Params& P, int c, int G, int lim = 1 << 30, int mrows = MT) {
    constexpr int NT0 = (CONV + NLO) / 256, NT1 = NGT / 256, NTOFF = PART ? NT0 : 0;
    SchedDense S; S.T.init(mrows / 256, PART ? NT1 : NT0, G, c, lim); S.A = (const char*)P.H(); S.B = (const char*)(P.WinT() + (size_t)NTOFF * 256 * D); S.tstepA = (size_t)256 * D * 2; S.tstepB = (size_t)256 * D * 2;
    pg8::gemm_phase<true>(D, S, [&](const pg8::Acc& acc, const pg8::Unit& u, int wr, int wc, int fr, int fq) {
        const int m0 = u.pm * 256, n0 = (u.pn + NTOFF) * 256;
        auto st8 = [](half_t* p, f4 a, f4 b) { const h4 x = to_h4(a), y = to_h4(b); h8 o; for (int i = 0; i < 4; ++i) { o[i] = x[i]; o[4 + i] = y[i]; } *(h8*)p = o; };
        if (PART) pg8::foreach_frag8(acc, wr, wc, fr, fq, [&](int m, int n, f4 a, f4 b) { for (int i = 0; i < 4; ++i) { a[i] = sigmoidf_(a[i]); b[i] = sigmoidf_(b[i]); } st8(P.Pg() + (size_t)(m0 + m) * NGT + (n0 - CONV - NLO) + n, a, b); });
        else if (n0 < CONV) pg8::foreach_frag8(acc, wr, wc, fr, fq, [&](int m, int n, f4 a, f4 b) { st8(P.Pconv() + (size_t)(m0 + m) * CONV + n0 + n, a, b); });
        else pg8::foreach_frag8(acc, wr, wc, fr, fq, [&](int m, int n, f4 a, f4 b) { st8(P.Plo() + (size_t)(m0 + m) * NLO + (n0 - CONV) + n, a, b); });
    });
}

__device__ __forceinline__ void ph_convf(const Params& P, int l) {
    const int tid = tid_();
    const float* cw = pin(I_CONVW) + (size_t)l * 9 * CONV;
    for (int it = bid_(); it < MT / 16; it += gridDim.x) {
        const int row0 = it * 16;
        int rows, cols, gi, gj0, base;
        if (row0 < RL) { const int t = row0 & (SEQ - 1); rows = 64; cols = 64; gi = t >> 6; gj0 = t & 63; base = row0 - t; }
        else { const int t = (row0 - RL) & (CTXL - 1); rows = 1; cols = CTXL; gi = 0; gj0 = t; base = row0 - t; }
        __syncthreads();
#pragma unroll 1
        for (int rnd = 0; rnd < 2; ++rnd) {
            const int c0 = (tid + NTHREADS * rnd) * 4;
            if (c0 < CONV) {
                float wt[3][3][4];
#pragma unroll
                for (int u = 0; u < 3; ++u)
#pragma unroll
                    for (int v = 0; v < 3; ++v) { const f4 a = *(const f4*)(cw + (u * 3 + v) * CONV + c0);
#pragma unroll
                        for (int i = 0; i < 4; ++i) wt[u][v][i] = a[i]; }
                h4 win[3][3];
                const h4 hz = {0, 0, 0, 0};
                auto ldp = [&](int u, int j) -> h4 { const int gr = gi + u - 1; if (gr < 0 || gr >= rows || j < 0 || j >= cols) return hz; return *(const h4*)(P.Pconv() + (size_t)(base + gr * cols + j) * CONV + c0); };
#pragma unroll
                for (int u = 0; u < 3; ++u) { win[u][0] = ldp(u, gj0 - 1); win[u][1] = ldp(u, gj0); }
                const bool is_k = (c0 >= ADIM && c0 < 2 * ADIM);
                f4 kkw = (f4){0.f, 0.f, 0.f, 0.f};
                if (is_k) kkw = *(const f4*)(pin(I_RKKK) + l * ADIM + c0 - ADIM);
#pragma unroll 1
                for (int jb = 0; jb < 16; jb += 4) {
                    h4 nw[3][4];
#pragma unroll
                    for (int e = 0; e < 4; ++e)
#pragma unroll
                        for (int u = 0; u < 3; ++u) nw[u][e] = ldp(u, gj0 + jb + e + 1);
                    f4 ov[4], qv[4];
#pragma unroll
                    for (int e = 0; e < 4; ++e) {
#pragma unroll
                        for (int u = 0; u < 3; ++u) win[u][2] = nw[u][e];
                        f4 o = (f4){0.f, 0.f, 0.f, 0.f};
#pragma unroll
                        for (int u = 0; u < 3; ++u)
#pragma unroll
                            for (int v = 0; v < 3; ++v)
#pragma unroll
                                for (int i = 0; i < 4; ++i) o[i] += (float)win[u][v][i] * wt[u][v][i];
                        ov[e] = o;
                        {
                            f4 q; float sq = 0.f;
#pragma unroll
                            for (int i = 0; i < 4; ++i) { q[i] = o[i] * kkw[i]; sq += q[i] * q[i]; }
                            sq = red16(sq);
                            const float inv = rsqrtf(sq + 1e-12f);
#pragma unroll
                            for (int i = 0; i < 4; ++i) q[i] *= inv;
                            qv[e] = q;
                        }
#pragma unroll
                        for (int u = 0; u < 3; ++u) { win[u][0] = win[u][1]; win[u][1] = win[u][2]; }
                    }
#pragma unroll
                    for (int e = 0; e < 4; ++e) { *(h4*)(P.F() + (size_t)(row0 + jb + e) * CONV + c0) = to_h4(ov[e]);
                        if (is_k) *(h4*)(P.KK() + (size_t)(row0 + jb + e) * ADIM + c0 - ADIM) = to_h4(qv[e]); }
                }
            }
        }
    }
}

__device__ __forceinline__ uint4 tanh8(uint4 x) { h8 v = __builtin_bit_cast(h8, x);
#pragma unroll
    for (int i = 0; i < 8; ++i) v[i] = (half_t)tanhf((float)v[i]);
    return __builtin_bit_cast(uint4, v); }
__device__ __forceinline__ uint4 sigm8(uint4 x) { h8 v = __builtin_bit_cast(h8, x);
#pragma unroll
    for (int i = 0; i < 8; ++i) v[i] = (half_t)sigmoidf_((float)v[i]);
    return __builtin_bit_cast(uint4, v); }
__device__ __forceinline__ void ph_lora(const Params& P, int l, int first, int stride) {
    constexpr int NTM = MT / 128;
    half_t* As = (half_t*)smem; half_t* Bs = As + 128 * GST;
    const int tid = tid_(), lane = tid & 63, w = wid_of(tid), wm = w >> 2, wn = w & 3, pr0 = tid >> 3, pk = (tid & 7) * 8;
    for (int u = first; u < 6 * NTM; u += stride) {
        const int kind = u / NTM, tm = u - kind * NTM, m0 = tm * 128, d = kind & 1, cls = kind >> 1;
        const int ncol = cls == 2 ? BKEY : ADIM, nnt = ncol / 128;
        const half_t* A = P.Plo() + (size_t)m0 * NLO + (cls == 0 ? LO_DW + d * 64 : (cls == 1 ? LO_DA + d * 64 : LO_BG + d * 16));
        const half_t* B = (cls == 0 ? P.LW2T() : (cls == 1 ? P.LA2T() : P.LGLT())) + (size_t)d * ncol * 64;
        const float* bw = pin(I_RKW0); const float* ba = pin(I_RKA0); const float* bg = pin(I_GLAAB);
        const float* bias = (cls == 0 ? bw : (cls == 1 ? ba : bg)) + (l * 2 + d) * ncol;
        half_t* O = (cls == 0 ? P.SW() : (cls == 1 ? P.AA() : P.GG())) + ((size_t)d * MT + m0) * ncol;
        uint4 ra[2], rb[2];
#pragma unroll
        for (int i = 0; i < 2; ++i) { uint4 x = (cls == 2 && pk >= 16) ? zero16() : ld16(A + (size_t)(pr0 + 64 * i) * NLO + pk); if (cls == 0) x = tanh8(x); ra[i] = x; rb[i] = ld16(B + (size_t)(pr0 + 64 * i) * 64 + pk); }
        __syncthreads();
#pragma unroll
        for (int i = 0; i < 2; ++i) *(uint4*)(As + (pr0 + 64 * i) * GST + pk) = ra[i];
        for (int nt = 0; nt < nnt; ++nt) {
            half_t* Bc = Bs + (nt & 1) * 128 * GST;
#pragma unroll
            for (int i = 0; i < 2; ++i) *(uint4*)(Bc + (pr0 + 64 * i) * GST + pk) = rb[i];
            if (nt + 1 < nnt) {
#pragma unroll
                for (int i = 0; i < 2; ++i) rb[i] = ld16(B + (size_t)((nt + 1) * 128 + pr0 + 64 * i) * 64 + pk); }
            const f4 bb0 = *(const f4*)(bias + nt * 128 + 32 * wn + 4 * (lane >> 4)), bb1 = *(const f4*)(bias + nt * 128 + 32 * wn + 16 + 4 * (lane >> 4));
            __syncthreads();
            f4 acc[4][2]; acc_zero(acc);
#pragma unroll
            for (int ks = 0; ks < 2; ++ks) {
                h8 af[4], bf[2];
#pragma unroll
                for (int mi = 0; mi < 4; ++mi) af[mi] = *(const h8*)(As + (64 * wm + 16 * mi + (lane & 15)) * GST + 32 * ks + 8 * (lane >> 4));
#pragma unroll
                for (int ni = 0; ni < 2; ++ni) bf[ni] = *(const h8*)(Bc + (32 * wn + 16 * ni + (lane & 15)) * GST + 32 * ks + 8 * (lane >> 4));
#pragma unroll
                for (int mi = 0; mi < 4; ++mi)
#pragma unroll
                    for (int ni = 0; ni < 2; ++ni) acc[mi][ni] = __builtin_amdgcn_mfma_f32_16x16x32_f16(bf[ni], af[mi], acc[mi][ni], 0, 0, 0);
            }
#pragma unroll
            for (int mi = 0; mi < 4; ++mi)
#pragma unroll
                for (int ni = 0; ni < 2; ++ni) { const f4 bb = ni ? bb1 : bb0; const int m = 64 * wm + 16 * mi + (lane & 15), n = nt * 128 + 32 * wn + 16 * ni + 4 * (lane >> 4); f4 o;
#pragma unroll
                    for (int i = 0; i < 4; ++i) { const float x = acc[mi][ni][i] + bb[i]; o[i] = cls == 2 ? (fminf(x, 0.f) - log1pf(__expf(-fabsf(x)))) * (1.0f / 16.0f) : sigmoidf_(x); }
                    *(h4*)(O + (size_t)m * ncol + n) = to_h4(o); }
        }
    }
    __syncthreads();
}

__device__ __forceinline__ h8 ldfrag(const half_t* base, int stride, int row0, int red0, int lane) { return *(const h8*)(base + (row0 + (lane & 15)) * stride + red0 + 8 * (lane >> 4)); }
__device__ __forceinline__ half_t clamp_h(float x) { return (half_t)__builtin_amdgcn_fmed3f(x, -60000.f, 60000.f); }
__device__ __forceinline__ f4 mma16(h8 x, h8 y, f4 c) { return __builtin_amdgcn_mfma_f32_16x16x32_f16(x, y, c, 0, 0, 0); }
__device__ __forceinline__ void ph_rwkv(const Params& P, int l, int first_item, int stride) {
    constexpr int CH = 32, SK = 72, ST = 40;
    const int tid = tid_(), lane = tid & 63, w = wid_of(tid), q = lane >> 4, i16 = lane & 15;
    half_t* Kt = (half_t*)smem; half_t* Rt = Kt + CH * SK; half_t* Bt = Rt + CH * SK; half_t* Dt = Bt + CH * SK; half_t* Wm = Dt + CH * SK; half_t* HTs = Wm + CH * SK;
    half_t* KtT = HTs + 64 * SK; half_t* DhT = KtT + 64 * ST; half_t* BhTn = DhT + 64 * ST; half_t* VT = BhTn + 64 * ST; half_t* UT = VT + 64 * ST; half_t* G1T = UT + 64 * ST;
    half_t* Akd = G1T + 64 * ST; half_t* Ard = Akd + CH * ST; half_t* Arbn = Ard + CH * ST;
    half_t* Pn0 = Arbn + CH * ST; half_t* Pn1 = Pn0 + CH * ST; half_t* PT0 = Pn1 + CH * ST; half_t* PT1 = PT0 + CH * ST; half_t* Tn0 = PT1 + CH * ST; half_t* Tn1 = Tn0 + CH * ST;
    float* Lc = (float*)(Tn1 + CH * ST);
    float* segt = Lc + CH * 64;
    float* gC = segt + 8 * 64; float* gref = gC + 64; float* bonus = gref + 64; float* Yb = bonus + 128;
    for (int item = first_item; item < 2 * NBATCH * AH; item += stride) {
        const int d = item / (NBATCH * AH), b = (item / AH) % NBATCH, h = item % AH;
        const half_t* SWd = P.SW() + (size_t)d * MT * ADIM + h * 64; const half_t* AAd = P.AA() + (size_t)d * MT * ADIM + h * 64; half_t* Zd = P.Z() + (size_t)d * MT * ADIM + h * 64;
        const half_t* Fh = P.F() + h * 64; const half_t* KKh = P.KK() + h * 64;
        const float* kap = pin(I_RKKA) + l * ADIM + h * 64; const float* rkp = pin(I_RKRK) + l * ADIM + h * 64;
        const float* gnw = pin(I_RKGNW) + l * ADIM + h * 64; const float* gnb = pin(I_RKGNB) + l * ADIM + h * 64;
        const int ck = tid & 63, seg = w;
        const float ka_c = kap[ck], rk_c = rkp[ck];
        f4 accH[2];
        accH[0] = (f4){0.f, 0.f, 0.f, 0.f}; accH[1] = (f4){0.f, 0.f, 0.f, 0.f};
        unsigned pr[4], pk[4], pv[4], pkk[4], psw[4], pa[4];
        auto ldu = [](const half_t* p) -> unsigned { return (unsigned)*(const unsigned short*)p; };
        auto h2f = [](unsigned u) -> float { return (float)__builtin_bit_cast(half_t, (unsigned short)u); };
        auto prefetch = [&](int s0) {
#pragma unroll
            for (int i = 0; i < 4; ++i) { const int row = __builtin_amdgcn_readfirstlane(tokrow(d, b, s0 + 4 * seg + i)); const half_t* f = Fh + (size_t)row * CONV + ck;
                pr[i] = ldu(f); pk[i] = ldu(f + ADIM); pv[i] = ldu(f + 2 * ADIM); pkk[i] = ldu(KKh + (size_t)row * ADIM + ck); psw[i] = ldu(SWd + (size_t)row * ADIM + ck); pa[i] = ldu(AAd + (size_t)row * ADIM + ck); }
        };
        prefetch(0);
        for (int s0 = 0; s0 < TS; s0 += CH) {
            float rr[4], kdv[4], bb[4], kkv[4], vv[4], Lv[4];
            { float run = 0.f;
#pragma unroll
              for (int i = 0; i < 4; ++i) { const float a = h2f(pa[i]), kk = h2f(pkk[i]), k = h2f(pk[i]);
                  rr[i] = h2f(pr[i]); vv[i] = h2f(pv[i]); kkv[i] = kk; kdv[i] = k * (1.0f + (a - 1.0f) * ka_c); bb[i] = kk * a; run += -0.6065306597126334f * h2f(psw[i]); Lv[i] = run; } }
            lds_barrier();
            segt[seg * 64 + ck] = Lv[3];
            if (s0 + CH < TS) prefetch(s0 + CH);
            lds_barrier();
            { float off = 0.f;
#pragma unroll
              for (int sg = 0; sg < 7; ++sg) off += segt[sg * 64 + ck] * (sg < seg ? 1.0f : 0.0f);
#pragma unroll
              for (int i = 0; i < 4; ++i) { Lv[i] += off; Lc[(4 * seg + i) * 64 + ck] = Lv[i]; }
              { const float v0 = rr[0] * kdv[0] * rk_c, v1 = rr[1] * kdv[1] * rk_c, v2 = rr[2] * kdv[2] * rk_c, v3 = rr[3] * kdv[3] * rk_c;
                const bool o1 = lane & 1, o2 = lane & 2;
                const float s01 = (o1 ? v1 : v0) + dpp_f<0xB1>(o1 ? v0 : v1), s23 = (o1 ? v3 : v2) + dpp_f<0xB1>(o1 ? v2 : v3);
                float sv = (o2 ? s23 : s01) + dpp_f<0x4E>(o2 ? s01 : s23);
                sv += dpp_f<0x124>(sv); sv += dpp_f<0x128>(sv);
                if (i16 < 4) bonus[(4 * seg + i16) * 4 + q] = sv; }
            }
            lds_barrier();
            { const float Lref = Lc[15 * 64 + ck], L31 = Lc[31 * 64 + ck];
              if (seg == 0) { gC[ck] = __expf(L31); gref[ck] = __expf(Lref); }
              h4 ktp, dhp, bhp, vtp;
              const float c3 = __expf(L31 - Lref); float eprev = __expf(((seg == 0) ? 0.f : Lc[(4 * seg - 1) * 64 + ck]) - Lref);
#pragma unroll
              for (int i = 0; i < 4; ++i) { const int t = 4 * seg + i; const float Lt = Lv[i];
                  const float ep = eprev, et = __expf(Lt - Lref), er = __builtin_amdgcn_rcpf(et), e3 = c3 * er; eprev = et;
                  const half_t ktv = (half_t)(kkv[i] * ep);
                  Kt[t * SK + ck] = ktv; ktp[i] = ktv; Rt[t * SK + ck] = clamp_h(rr[i] * et); Bt[t * SK + ck] = (half_t)(bb[i] * er); Dt[t * SK + ck] = clamp_h(kdv[i] * er);
                  dhp[i] = (half_t)(kdv[i] * e3); bhp[i] = (half_t)(-bb[i] * e3); vtp[i] = (half_t)vv[i]; }
              *(h4*)(KtT + ck * ST + 4 * seg) = ktp; *(h4*)(DhT + ck * ST + 4 * seg) = dhp; *(h4*)(BhTn + ck * ST + 4 * seg) = bhp; *(h4*)(VT + ck * ST + 4 * seg) = vtp;
            }
            lds_barrier();
#pragma unroll
            for (int x = 0; x < 2; ++x) { const int id = 2 * w + x, kt = id >> 2, vt = id & 3, k0 = kt * 16 + 4 * q; h4 hv;
#pragma unroll
                for (int r = 0; r < 4; ++r) hv[r] = (half_t)(accH[x][r] * gref[k0 + r]);
                *(h4*)(HTs + (vt * 16 + i16) * SK + k0) = hv; }
            for (int rwrep = 0; rwrep < RWKV_REP; ++rwrep) {
            {   const int mat = w >> 1, tt = w & 1, incl = (mat >> 1) & 1;
                const half_t* X = (mat & 1) ? Dt : Bt; const half_t* Yp = (mat & 2) ? Rt : Kt; const float sgn = mat == 2 ? -1.0f : 1.0f;
                half_t* dst = mat == 0 ? Pn0 : (mat == 1 ? Akd : (mat == 2 ? Arbn : Ard));
                const h8 y0 = ldfrag(Yp, SK, tt * 16, 0, lane), y1 = ldfrag(Yp, SK, tt * 16, 32, lane);
                const int t = tt * 16 + i16;
#pragma unroll
                for (int ts = 0; ts < 2; ++ts) {
                    f4 acc = mma16(ldfrag(X, SK, ts * 16, 0, lane), y0, (f4){0.f, 0.f, 0.f, 0.f}); acc = mma16(ldfrag(X, SK, ts * 16, 32, lane), y1, acc);
                    const int sb = ts * 16 + 4 * q; h4 av;
#pragma unroll
                    for (int r = 0; r < 4; ++r) av[r] = (half_t)(sgn * __builtin_amdgcn_fmed3f((sb + r < t + incl) ? acc[r] : 0.f, -60000.f, 60000.f));
                    *(h4*)(dst + t * ST + sb) = av;
                    if (mat == 0) { h4 tv;
#pragma unroll
                        for (int r = 0; r < 4; ++r) { PT0[(sb + r) * ST + t] = av[r]; tv[r] = (half_t)(((sb + r == t) ? 1.0f : 0.f) - (float)av[r]); }
                        *(h4*)(Tn0 + t * ST + sb) = tv; }
                }
            }
            lds_barrier();
            {   half_t* Pc = Pn0; half_t* PTc = PT0; half_t* Pq = Pn1; half_t* PTq = PT1; half_t* Tc = Tn0; half_t* Tq = Tn1;
                const int tl = w & 3, t0 = (tl >> 1) * 16, c0 = (tl & 1) * 16;
#pragma unroll
                for (int lev = 0; lev < 5; ++lev) {
                    if (w >= 4) {
                        if (lev < 4) {
                            f4 acc = mma16(ldfrag(Pc, ST, t0, 0, lane), ldfrag(PTc, ST, c0, 0, lane), (f4){0.f, 0.f, 0.f, 0.f});
                            const int tb = t0 + 4 * q, sc = c0 + i16; h4 pv4;
#pragma unroll
                            for (int r = 0; r < 4; ++r) { pv4[r] = (half_t)acc[r]; Pq[(tb + r) * ST + sc] = pv4[r]; }
                            *(h4*)(PTq + sc * ST + tb) = pv4;
                        }
                    } else if (lev > 0) {
                        f4 acc = mma16(ldfrag(Tc, ST, t0, 0, lane), ldfrag(PTc, ST, c0, 0, lane), (f4){0.f, 0.f, 0.f, 0.f});
                        const int tb = t0 + 4 * q, sc = c0 + i16;
#pragma unroll
                        for (int r = 0; r < 4; ++r) Tq[(tb + r) * ST + sc] = (half_t)(acc[r] + (float)Tc[(tb + r) * ST + sc]);
                    }
                    lds_barrier();
                    if (lev < 4) { half_t* tp = Pc; Pc = Pq; Pq = tp; tp = PTc; PTc = PTq; PTq = tp; }
                    if (lev > 0) { half_t* tp = Tc; Tc = Tq; Tq = tp; }
                }
                {   const int kt = w >> 1, tt = w & 1;
                    f4 acc = mma16(ldfrag(KtT, ST, kt * 16, 0, lane), ldfrag(Tc, ST, tt * 16, 0, lane), (f4){0.f, 0.f, 0.f, 0.f});
                    h4 wv;
#pragma unroll
                    for (int r = 0; r < 4; ++r) wv[r] = (half_t)__builtin_amdgcn_fmed3f(acc[r], -60000.f, 60000.f);
                    *(h4*)(Wm + (tt * 16 + i16) * SK + kt * 16 + 4 * q) = wv;
                    const int t2 = w >> 2, vt = w & 3;
                    f4 acc2 = mma16(ldfrag(Akd, ST, t2 * 16, 0, lane), ldfrag(VT, ST, vt * 16, 0, lane), (f4){0.f, 0.f, 0.f, 0.f});
                    h4 gv;
#pragma unroll
                    for (int r = 0; r < 4; ++r) gv[r] = (half_t)__builtin_amdgcn_fmed3f(acc2[r], -60000.f, 60000.f);
                    *(h4*)(G1T + (vt * 16 + i16) * ST + t2 * 16 + 4 * q) = gv;
                }
                lds_barrier();
                {   const int t2 = w >> 2, vt = w & 3;
                    f4 acc = mma16(ldfrag(Tc, ST, t2 * 16, 0, lane), ldfrag(G1T, ST, vt * 16, 0, lane), (f4){0.f, 0.f, 0.f, 0.f});
#pragma unroll
                    for (int ks = 0; ks < 2; ++ks) acc = mma16(ldfrag(Wm, SK, t2 * 16, ks * 32, lane), ldfrag(HTs, SK, vt * 16, ks * 32, lane), acc);
                    h4 uv;
#pragma unroll
                    for (int r = 0; r < 4; ++r) uv[r] = (half_t)__builtin_amdgcn_fmed3f(acc[r], -60000.f, 60000.f);
                    *(h4*)(UT + (vt * 16 + i16) * ST + t2 * 16 + 4 * q) = uv;
                }
            }
            lds_barrier();
            }
            {   const int vt = w >> 1, tt = w & 1;
                f4 acc = (f4){0.f, 0.f, 0.f, 0.f};
#pragma unroll
                for (int ks = 0; ks < 2; ++ks) acc = mma16(ldfrag(HTs, SK, vt * 16, ks * 32, lane), ldfrag(Rt, SK, tt * 16, ks * 32, lane), acc);
                acc = mma16(ldfrag(VT, ST, vt * 16, 0, lane), ldfrag(Ard, ST, tt * 16, 0, lane), acc);
                acc = mma16(ldfrag(UT, ST, vt * 16, 0, lane), ldfrag(Arbn, ST, tt * 16, 0, lane), acc);
                *(f4*)(Yb + (tt * 16 + i16) * 68 + vt * 16 + 4 * q) = acc;
#pragma unroll
                for (int x = 0; x < 2; ++x) { const int id = 2 * w + x, kt = id >> 2, v2 = id & 3, k0 = kt * 16 + 4 * q;
#pragma unroll
                    for (int r = 0; r < 4; ++r) accH[x][r] *= gC[k0 + r];
                    accH[x] = mma16(ldfrag(DhT, ST, kt * 16, 0, lane), ldfrag(VT, ST, v2 * 16, 0, lane), accH[x]);
                    accH[x] = mma16(ldfrag(BhTn, ST, kt * 16, 0, lane), ldfrag(UT, ST, v2 * 16, 0, lane), accH[x]); }
            }
            lds_barrier();
            {   const int t = tid >> 4, c = 4 * (tid & 15), row = tokrow(d, b, s0 + t);
                const f4 y = *(const f4*)(Yb + t * 68 + c); const f4 gw = *(const f4*)(gnw + c), gb = *(const f4*)(gnb + c);
                float sm = (y[0] + y[1]) + (y[2] + y[3]); sm = red16(sm);
                const float mu = sm * (1.0f / 64.0f); float sq = 0.f;
#pragma unroll
                for (int i = 0; i < 4; ++i) { const float dd = y[i] - mu; sq += dd * dd; }
                sq = red16(sq);
                const f4 bp = *(const f4*)(bonus + 4 * t); const float rs = rsqrtf(sq * (1.0f / 64.0f) + 64e-5f), bo = (bp[0] + bp[1]) + (bp[2] + bp[3]); h4 o;
#pragma unroll
                for (int i = 0; i < 4; ++i) o[i] = (half_t)((y[i] - mu) * rs * gw[i] + gb[i] + bo * (float)VT[(c + i) * ST + t]);
                *(h4*)(Zd + (size_t)row * ADIM + c) = o;
            }
        }
        lds_barrier();
    }
}

__device__ __forceinline__ void ph_gla_a(const Params& P, int first, int stride) {
    constexpr int QS = 104, TSR = 72;
    half_t* Q2s = (half_t*)smem; half_t* K2s = Q2s + 64 * QS; half_t* K3T = K2s + 64 * QS; half_t* VT = K3T + 96 * TSR; half_t* Ps = VT + 192 * TSR;
    float* cgf = (float*)(Ps + 64 * TSR); float* segt = cgf + 64 * 96;
    const int tid = tid_(), lane = tid & 63, w = wid_of(tid);
    for (int task = first; task < GLT; task += stride) {
        const int n = task % 68, c = task / 68, h = c & 3, b = (c >> 2) & 3, d = c >> 4, s0 = n * 64;
        const half_t* GGd = P.GG() + (size_t)d * MT * BKEY + h * BHK; half_t* Od = P.O() + (size_t)d * MT * BDIM + h * BHV;
        const half_t* Fq = P.F() + 2304 + h * BHK; const half_t* Fv = P.F() + 3072 + h * BHV;
        lds_barrier();
        h8 qv[2], kv[2];
#pragma unroll
        for (int j = 0; j < 2; ++j) { const int p = tid + NTHREADS * j;
            if (p < 768) { const int i = p / 12, kc = (p % 12) * 8, row = tokrow(d, b, s0 + i);
                qv[j] = *(const h8*)(Fq + (size_t)row * CONV + kc); kv[j] = *(const h8*)(Fq + (size_t)row * CONV + BKEY + kc);
                const h8 g = *(const h8*)(GGd + (size_t)row * BKEY + kc);
#pragma unroll
                for (int e = 0; e < 8; ++e) cgf[i * 96 + kc + e] = (float)g[e]; } }
#pragma unroll
        for (int j = 0; j < 3; ++j) { const int p = tid + NTHREADS * j, i = p / 24, vc = (p % 24) * 8, row = tokrow(d, b, s0 + i);
            const h8 v = *(const h8*)(Fv + (size_t)row * CONV + vc);
#pragma unroll
            for (int e = 0; e < 8; ++e) VT[(vc + e) * TSR + i] = v[e]; }
        lds_barrier();
        { float loc[16]; const int ck = tid % 96, cseg = tid / 96;
          if (tid < 384) { float run = 0.f;
#pragma unroll
              for (int i = 0; i < 16; ++i) { run += cgf[(cseg * 16 + i) * 96 + ck]; loc[i] = run; }
              segt[cseg * 96 + ck] = run; }
          lds_barrier();
          if (tid < 384) { float off = 0.f;
#pragma unroll
              for (int sg = 0; sg < 4; ++sg) off += (sg < cseg) ? segt[sg * 96 + ck] : 0.f;
#pragma unroll
              for (int i = 0; i < 16; ++i) cgf[(cseg * 16 + i) * 96 + ck] = loc[i] + off; }
        }
        lds_barrier();
#pragma unroll
        for (int j = 0; j < 2; ++j) { const int p = tid + NTHREADS * j;
            if (p < 768) { const int i = p / 12, kc = (p % 12) * 8; h8 q1, q2, k2;
#pragma unroll
                for (int e = 0; e < 8; ++e) { const float cg = cgf[i * 96 + kc + e], rf = cgf[31 * 96 + kc + e], tt = cgf[63 * 96 + kc + e];
                    const float qf = (float)qv[j][e] * 0.10206207261596575f, kf = (float)kv[j][e];
                    q1[e] = clamp_h(qf * __expf(cg)); q2[e] = clamp_h(qf * __expf(cg - rf)); k2[e] = clamp_h(kf * __expf(rf - cg)); K3T[(kc + e) * TSR + i] = clamp_h(kf * __expf(tt - cg)); }
                *(h8*)(P.GQ() + ((size_t)task * 64 + i) * BHK + kc) = q1; *(h8*)(Q2s + i * QS + kc) = q2; *(h8*)(K2s + i * QS + kc) = k2; } }
        if (tid < 96) P.GE()[(size_t)task * BHK + tid] = __expf(cgf[63 * 96 + tid]);
        lds_barrier();
#pragma unroll
        for (int x = 0; x < 2; ++x) {
            const int id = w * 2 + x, it = id >> 2, jt = id & 3; f4 a = (f4){0.f, 0.f, 0.f, 0.f};
            if (jt <= it) {
#pragma unroll
                for (int ks = 0; ks < 3; ++ks) a = mma16(ldfrag(K2s, QS, jt * 16, ks * 32, lane), ldfrag(Q2s, QS, it * 16, ks * 32, lane), a);
            }
            const int i = it * 16 + (lane & 15), j = jt * 16 + 4 * (lane >> 4); h4 pv;
#pragma unroll
            for (int r = 0; r < 4; ++r) pv[r] = (j + r <= i) ? clamp_h(a[r]) : (half_t)0.f;
            *(h4*)(Ps + i * TSR + j) = pv;
        }
        lds_barrier();
        {   const int it = w & 3, i = it * 16 + (lane & 15), row = tokrow(d, b, s0 + i);
            const h8 p0 = ldfrag(Ps, TSR, it * 16, 0, lane), p1 = ldfrag(Ps, TSR, it * 16, 32, lane);
#pragma unroll
            for (int x = 0; x < 6; ++x) { const int vt = (w >> 2) * 6 + x;
                f4 a = mma16(ldfrag(VT, TSR, vt * 16, 0, lane), p0, (f4){0.f, 0.f, 0.f, 0.f}); a = mma16(ldfrag(VT, TSR, vt * 16, 32, lane), p1, a);
                *(h4*)(Od + (size_t)row * BDIM + vt * 16 + 4 * (lane >> 4)) = to_h4(a); }
        }
        {   half_t* gs = P.GS() + (size_t)task * BHV * BHK;
#pragma unroll
            for (int x = 0; x < 9; ++x) { const int id = w * 9 + x, kt = id / 12, vt = id - kt * 12;
                f4 a = mma16(ldfrag(K3T, TSR, kt * 16, 0, lane), ldfrag(VT, TSR, vt * 16, 0, lane), (f4){0.f, 0.f, 0.f, 0.f});
                a = mma16(ldfrag(K3T, TSR, kt * 16, 32, lane), ldfrag(VT, TSR, vt * 16, 32, lane), a);
                *(h4*)(gs + (size_t)(vt * 16 + (lane & 15)) * BHK + kt * 16 + 4 * (lane >> 4)) = to_h4(a); }
        }
    }
    __syncthreads();
}
__device__ __forceinline__ void ph_gla_b(const Params& P, int first, int stride) {
    constexpr int NBLK = 32 * (BHV * BHK / 8) / NTHREADS;
    for (int blk = first; blk < NBLK; blk += stride) {
        const int gid = blk * NTHREADS + tid_(), c = gid / (BHV * BHK / 8), e = gid - c * (BHV * BHK / 8), v = e / 12, kc = (e - v * 12) * 8;
        half_t* base = P.GS() + ((size_t)c * 68 * BHV + v) * BHK + kc; const float* eb = P.GE() + (size_t)c * 68 * BHK + kc;
        float S[8];
#pragma unroll
        for (int j = 0; j < 8; ++j) S[j] = 0.f;
        for (int n0 = 0; n0 < 68; n0 += 4) {
            h8 U[4]; f4 e0[4], e1[4];
#pragma unroll
            for (int u = 0; u < 4; ++u) { U[u] = *(const h8*)(base + (size_t)(n0 + u) * BHV * BHK); e0[u] = *(const f4*)(eb + (n0 + u) * BHK); e1[u] = *(const f4*)(eb + (n0 + u) * BHK + 4); }
#pragma unroll
            for (int u = 0; u < 4; ++u) { h8 o;
#pragma unroll
                for (int j = 0; j < 8; ++j) o[j] = clamp_h(S[j]);
                *(h8*)(base + (size_t)(n0 + u) * BHV * BHK) = o;
#pragma unroll
                for (int j = 0; j < 4; ++j) { S[j] = e0[u][j] * S[j] + (float)U[u][j]; S[4 + j] = e1[u][j] * S[4 + j] + (float)U[u][4 + j]; } }
        }
    }
}
__device__ __forceinline__ void ph_gla_c(const Params& P, int l, int first, int stride, bool latent_only) {
    const int tid = tid_(), lane = tid & 63, w = wid_of(tid), q = lane >> 4, i16 = lane & 15;
    const float* ng = pin(I_GLANG) + l * BHV;
    for (int u = first; u < NBATCH * BH * 68 / 2; u += stride) {
        const int t = 2 * u + (w >> 2), m = t % 68, h = (t / 68) & 3, b = t / (68 * 4), it = w & 3, j = it * 16 + i16;
        if (latent_only && m < 4) continue;
        const int row = (m < 4) ? RL + b * CTXL + 64 * m + j : b * SEQ + 64 * (m - 4) + j;
        const int task0 = ((0 * 4 + b) * 4 + h) * 68 + m, task1 = ((1 * 4 + b) * 4 + h) * 68 + (m < 4 ? 3 - m : 71 - m);
        h8 y0[3], y1[3];
        { const half_t* q0 = P.GQ() + ((size_t)task0 * 64 + j) * BHK + 8 * q; const half_t* q1 = P.GQ() + ((size_t)task1 * 64 + (63 - j)) * BHK + 8 * q;
#pragma unroll
          for (int ks = 0; ks < 3; ++ks) { y0[ks] = *(const h8*)(q0 + 32 * ks); y1[ks] = *(const h8*)(q1 + 32 * ks); } }
        const half_t* s0p = P.GS() + ((size_t)task0 * BHV + i16) * BHK + 8 * q; const half_t* s1p = P.GS() + ((size_t)task1 * BHV + i16) * BHK + 8 * q;
        const half_t* o0 = P.O() + (size_t)row * BDIM + h * BHV + 4 * q; const half_t* o1 = o0 + (size_t)MT * BDIM;
        f4 o[12]; float ss = 0.f;
#pragma unroll
        for (int vt = 0; vt < 12; ++vt) {
            f4 a = (f4){0.f, 0.f, 0.f, 0.f};
#pragma unroll
            for (int ks = 0; ks < 3; ++ks) { a = mma16(*(const h8*)(s0p + (size_t)vt * 16 * BHK + 32 * ks), y0[ks], a); a = mma16(*(const h8*)(s1p + (size_t)vt * 16 * BHK + 32 * ks), y1[ks], a); }
            const h4 i0 = *(const h4*)(o0 + vt * 16), i1 = *(const h4*)(o1 + vt * 16);
#pragma unroll
            for (int r = 0; r < 4; ++r) { a[r] += (float)i0[r] + (float)i1[r]; ss += a[r] * a[r]; }
            o[vt] = a;
        }
        ss += __shfl_xor(ss, 16); ss += __shfl_xor(ss, 32);
        const float rs = rsqrtf(ss * (1.0f / BHV) + 1e-6f);
        const half_t* ogp = P.Plo() + (size_t)row * NLO + LO_OG + h * BHV + 4 * q; half_t* yb = P.YB() + (size_t)row * YCP + h * BHV + 4 * q;
#pragma unroll
        for (int vt = 0; vt < 12; ++vt) { const h4 og = *(const h4*)(ogp + vt * 16); const f4 g = *(const f4*)(ng + vt * 16 + 4 * q); f4 r4;
#pragma unroll
            for (int r = 0; r < 4; ++r) r4[r] = o[vt][r] * rs * g[r] * siluf_((float)og[r]);
            *(h4*)(yb + vt * 16) = to_h4(r4); }
    }
}

template <class FN> __device__ __forceinline__ void acc_foreach_pair(const f4 (&acc)[4][2], FN fn) {
    const int lane = tid_() & 63, w = wid_of(tid_()), wm = w >> 2, wn = w & 3;
#pragma unroll
    for (int mi = 0; mi < 4; ++mi) fn(64 * wm + 16 * mi + (lane & 15), 16 * wn + 4 * (lane >> 4), acc[mi][0], acc[mi][1]);
}
__device__ __forceinline__ float gelu_tanh(float x) { const float u = 0.7978845608028654f * (x + 0.044715f * x * x * x); return 0.5f * x * (1.0f + tanhf(u)); }

__device__ __forceinline__ uint4 s5_u_piece(const Params& P, int g, int m, int k) {
    if (m >= S5ROWS) return zero16();
    const int b = m / 272, n = m - b * 272, row0 = s5_block_row0(b, n);
    return ld16(P.Plo() + (size_t)(row0 + (k >> 4)) * NLO + LO_U + g * 16 + (k & 15));
}
__device__ __forceinline__ void ph_s5g2(const Params& P, int first, int stride) {
    for (int u = first; u < CGR * 9 * 2; u += stride) {
        const int g = u / 18, tm = (u % 18) >> 1, tn = u & 1;
        const half_t* B = P.MstT() + (size_t)g * 256 * 256 + (size_t)tn * 128 * 256;
        f4 acc[4][2]; acc_zero(acc);
        gemm_tile(4, [&](int r, int k) { return s5_u_piece(P, g, tm * 128 + r, k); }, [&](int r, int k) { return ld16(B + r * 256 + k); }, acc);
        acc_foreach(acc, [&](int m, int n, f4 v) { const int mm = tm * 128 + m; if (mm < S5ROWS) *(f4*)(P.Sloc() + ((size_t)g * S5ROWS + mm) * 256 + tn * 128 + n) = v; });
    }
}
__device__ __forceinline__ void ph_s5scan(const Params& P, int l, int first, int stride) {
    for (int blk = first; blk < 32; blk += stride) {
        const int gid = blk * NTHREADS + tid_(), p = gid & 63, d = (gid >> 6) & 1, b = (gid >> 7) & 3, g = gid >> 9;
        const float lr = pin(I_S5LRE)[((l * 2 + d) * CGR + g) * CP + p], li = pin(I_S5LIM)[((l * 2 + d) * CGR + g) * CP + p];
        const float dt = expf(pin(I_S5LDT)[(l * 2 + d) * CGR + g]);
        const float mag = expf(lr * dt * 16.0f), ang = li * dt * 16.0f, ar = mag * cosf(ang), ai = mag * sinf(ang);
        float xr = 0.f, xi = 0.f;
        for (int n0 = 0; n0 < 272; n0 += 16) {
            float sr[16], si[16]; size_t oo[16];
#pragma unroll
            for (int u = 0; u < 16; ++u) { const int ns = n0 + u, nb = d == 0 ? ns : (ns < 16 ? 15 - ns : 287 - ns);
                oo[u] = ((size_t)g * S5ROWS + b * 272 + nb) * 256 + d * 128 + p; sr[u] = P.Sloc()[oo[u]]; si[u] = P.Sloc()[oo[u] + 64]; }
#pragma unroll
            for (int u = 0; u < 16; ++u) { P.XinH()[oo[u]] = (half_t)xr; P.XinH()[oo[u] + 64] = (half_t)xi;
                const float nr = ar * xr - ai * xi + sr[u], ni = ar * xi + ai * xr + si[u]; xr = nr; xi = ni; }
        }
    }
}
__device__ __forceinline__ void ph_s5g1(const Params& P, int l, int first, int stride) {
    const float* s5d = pin(I_S5D) + l * CDIM;
    for (int u = first; u < CGR * 9 * 2; u += stride) {
        const int g = u / 18, tm = (u % 18) >> 1, tn = u & 1;
        const half_t* B = P.McatT() + (size_t)g * 256 * 512 + (size_t)tn * 128 * 512;
        f4 acc[4][2]; acc_zero(acc);
        gemm_tile(8, [&](int r, int k) -> uint4 { const int m = tm * 128 + r; if (k < 256) return s5_u_piece(P, g, m, k); if (m >= S5ROWS) return zero16();
                         return ld16(P.XinH() + ((size_t)g * S5ROWS + m) * 256 + (k - 256)); },
                  [&](int r, int k) { return ld16(B + r * 512 + k); }, acc);
        struct UD { h4 u; f4 d; };
        acc_foreach2(acc, [&](int m, int n) { UD r; const int mm = tm * 128 + m < S5ROWS ? tm * 128 + m : S5ROWS - 1;
            const int nn = tn * 128 + n, tau = nn >> 4, c = nn & 15, b = mm / 272, nb = mm - b * 272, row = s5_block_row0(b, nb) + tau, ch = g * 16 + c;
            r.u = *(const h4*)(P.Plo() + (size_t)row * NLO + LO_U + ch); r.d = *(const f4*)(s5d + ch); return r; },
          [&](int m, int n, f4 v, UD r) { const int mm = tm * 128 + m; if (mm >= S5ROWS) return;
            const int nn = tn * 128 + n, tau = nn >> 4, c = nn & 15, b = mm / 272, nb = mm - b * 272, row = s5_block_row0(b, nb) + tau, ch = g * 16 + c; f4 o;
#pragma unroll
            for (int i = 0; i < 4; ++i) o[i] = gelu_tanh(v[i] + r.d[i] * (float)r.u[i]);
            *(h4*)(P.TC() + (size_t)row * CDIM + ch) = to_h4(o); });
    }
}
__device__ __forceinline__ void ph_glu(const Params& P, int mrows) {
    SchedDense S; S.T.init(mrows / 256, (2 * CDIM) / 256, gridDim.x, bid_()); S.A = (const char*)P.TC(); S.B = (const char*)P.GluT(); S.tstepA = (size_t)256 * CDIM * 2; S.tstepB = (size_t)256 * CDIM * 2;
    pg8::gemm_phase(CDIM, S, [&](const pg8::Acc& acc, const pg8::Unit& u, int wr, int wc, int fr, int fq) {
        pg8::foreach_pair(acc, wr, wc, fr, fq, [&](int m, int hc, f4 a, f4 g) { f4 o;
#pragma unroll
            for (int i = 0; i < 4; ++i) o[i] = a[i] * sigmoidf_(g[i]);
            *(h4*)(P.YC() + (size_t)(u.pm * 256 + m) * CDIM + u.pn * 128 + hc) = to_h4(o); });
    });
}

__device__ __forceinline__ void ph_comb(const Params& P, int l, int mrows) {
    const int tid = tid_();
    for (int u = bid_(); u < (mrows / 128) * 6; u += gridDim.x) {
        const int tm = u / 6, tn = u % 6, m0 = tm * 128, n0 = tn * 128;
        const half_t* A = P.Plo() + (size_t)m0 * NLO + LO_DG; const half_t* B = P.LG2T() + (size_t)n0 * 128;
        f4 acc[4][2]; acc_zero(acc);
        gemm_tile(2, [&](int rr, int k) { return sigm8(ld16(A + (size_t)rr * NLO + k)); }, [&](int rr, int k) { return ld16(B + rr * 128 + k); }, acc);
        struct ZZ { h4 a, b; };
        acc_foreach2(acc, [&](int m, int n) { ZZ z; const size_t o = (size_t)(m0 + m) * ADIM + n0 + n; z.a = *(const h4*)(P.Z() + o); z.b = *(const h4*)(P.Z() + (size_t)MT * ADIM + o); return z; },
          [&](int m, int n, f4 v, ZZ z) { const size_t o = (size_t)(m0 + m) * ADIM + n0 + n; f4 r;
#pragma unroll
            for (int i = 0; i < 4; ++i) r[i] = ((float)z.a[i] + (float)z.b[i]) * v[i];
            *(h4*)(P.YA() + o) = to_h4(r); });
    }
}

struct SchedMerge1 {
    pg8::TileOrder T; const char *a, *b; int nb, br0, K;
    __device__ __forceinline__ bool next(int i, pg8::Unit& u) const { const int t = i / nb, br = i - nb * t; int pm, pn; if (!T.tile(t, pm, pn)) return false; u.pm = pm; u.pn = pn * 4 + br0 + br;
        u.A = a + ((size_t)br * MT + (size_t)pm * 256) * K * 2; u.B = b + ((size_t)br * D + (size_t)pn * 256) * K * 2; return true; }
};
template <class S_> __device__ __forceinline__ void merge1_call(const Params& P, const S_& S, int K) {
    pg8::gemm_phase(K, S, [&](const pg8::Acc& acc, const pg8::Unit& u, int wr, int wc, int fr, int fq) {
        const int br = u.pn & 3, m0 = u.pm * 256, n0 = (u.pn >> 2) * 256;
        struct GO { h4 g, o; };
        pg8::foreach_frag2(acc, wr, wc, fr, fq,
            [&](int m, int n) { GO r; r.g = *(const h4*)(P.Pg() + (size_t)(m0 + m) * NGT + br * D + n0 + n); r.o = (h4){0, 0, 0, 0}; if (br != 0) r.o = *(const h4*)(P.U() + (size_t)(m0 + m) * D + n0 + n); return r; },
            [&](int m, int n, f4 v, GO r) { f4 x;
#pragma unroll
                for (int i = 0; i < 4; ++i) x[i] = (float)r.o[i] + (float)r.g[i] * v[i];
                *(h4*)(P.U() + (size_t)(m0 + m) * D + n0 + n) = to_h4(x); });
    });
}
__device__ __forceinline__ void ph_merge1(const Params& P, int mrows_all) {
    const int mrows = RL;
    if (mrows_all > RL) {
        for (int u = bid_(); u < (RC / 128) * (D / 128); u += gridDim.x) {
            const int tm = u >> 4, tn = u & 15, m0 = RL + tm * 128, n0 = tn * 128;
            f4 tot[4][2]; acc_zero(tot);
#pragma unroll 1
            for (int br = 0; br < 3; ++br) {
                const int K = br == 2 ? CDIM : YCP;
                const half_t* A = (br == 0 ? P.YA() : (br == 1 ? P.YB() : P.YC())) + (size_t)m0 * K;
                const half_t* B = (br == 0 ? P.PaT() : (br == 1 ? P.PbT() : P.PcT())) + (size_t)n0 * K;
                f4 acc[4][2]; acc_zero(acc);
                gemm_tile(K / 64, [&](int r, int k) { return ld16(A + (size_t)r * K + k); }, [&](int r, int k) { return ld16(B + (size_t)r * K + k); }, acc);
                const int lane = tid_() & 63, w = wid_of(tid_()), wm = w >> 2, wn = w & 3;
                h4 gt[4][2];
#pragma unroll
                for (int mi = 0; mi < 4; ++mi)
#pragma unroll
                    for (int ni = 0; ni < 2; ++ni) gt[mi][ni] = *(const h4*)(P.Pg() + (size_t)(m0 + 64 * wm + 16 * mi + (lane & 15)) * NGT + br * D + n0 + 32 * wn + 16 * ni + 4 * (lane >> 4));
#pragma unroll
                for (int mi = 0; mi < 4; ++mi)
#pragma unroll
                    for (int ni = 0; ni < 2; ++ni)
#pragma unroll
                        for (int i = 0; i < 4; ++i) tot[mi][ni][i] += (float)gt[mi][ni][i] * acc[mi][ni][i];
            }
            acc_foreach(tot, [&](int m, int n, f4 v) { *(h4*)(P.U() + (size_t)(m0 + m) * D + n0 + n) = to_h4(v); });
        }
        __syncthreads();
    }
    SchedMerge1 S; S.T.init(mrows / 256, D / 256, gridDim.x, bid_()); S.a = (const char*)P.YA(); S.b = (const char*)P.PaT(); S.nb = 2; S.br0 = 0; S.K = YCP;
    merge1_call(P, S, YCP);
    SchedMerge1 S2; S2.T.init(mrows / 256, D / 256, gridDim.x, bid_()); S2.a = (const char*)P.YC(); S2.b = (const char*)P.PcT(); S2.nb = 1; S2.br0 = 2; S2.K = CDIM;
    merge1_call(P, S2, CDIM);
}
__device__ __forceinline__ void ph_merge2(const Params& P, int l, int mrows_all) {
    const int mrows = RL;
    if (mrows_all > RL) {
        for (int u = bid_(); u < (RC / 128) * (D / 128); u += gridDim.x) {
            const int tm = u >> 4, tn = u & 15, m0 = RL + tm * 128, n0 = tn * 128;
            const half_t* A = P.U() + (size_t)m0 * D; const half_t* B = P.WoT() + (size_t)n0 * D;
            f4 acc[4][2]; acc_zero(acc);
            gemm_tile(D / 64, [&](int r, int k) { return ld16(A + (size_t)r * D + k); }, [&](int r, int k) { return ld16(B + (size_t)r * D + k); }, acc);
            const float* gap = P.MOD() + ((size_t)l * 5 + 4) * (6 * D) + 2 * D + n0;
            struct XG { f4 x, g; };
            acc_foreach2(acc, [&](int m, int n) { XG r; r.x = *(const f4*)(xsrc_ptr(P, m0 + m, l) + n0 + n); r.g = *(const f4*)(gap + n); return r; },
                [&](int m, int n, f4 v, XG r) {
#pragma unroll
                    for (int i = 0; i < 4; ++i) r.x[i] += r.g[i] * v[i];
                    *(f4*)(xrow_ptr(P, m0 + m) + n0 + n) = r.x; });
        }
        __syncthreads();
    }
    SchedDense S; S.T.init(mrows / 256, D / 256, gridDim.x, bid_()); S.A = (const char*)P.U(); S.B = (const char*)P.WoT(); S.tstepA = (size_t)256 * D * 2; S.tstepB = (size_t)256 * D * 2;
    pg8::gemm_phase(D, S, [&](const pg8::Acc& acc, const pg8::Unit& u, int wr, int wc, int fr, int fq) {
        const int m0 = u.pm * 256, n0 = u.pn * 256;
        const float* gap = P.MOD() + ((size_t)l * 5 + modrow_of(m0)) * (6 * D) + 2 * D + n0;
        struct XG { f4 x, g; };
        pg8::foreach_frag2(acc, wr, wc, fr, fq,
            [&](int m, int n) { XG r; r.x = *(const f4*)(xsrc_ptr(P, m0 + m, l) + n0 + n); r.g = *(const f4*)(gap + n); return r; },
            [&](int m, int n, f4 v, XG r) {
#pragma unroll
                for (int i = 0; i < 4; ++i) r.x[i] += r.g[i] * v[i];
                *(f4*)(xrow_ptr(P, m0 + m) + n0 + n) = r.x; });
    });
}

__device__ __forceinline__ void ph_route(const Params& P, int l, int mrows) {
    const int tid = tid_(), lane = tid & 63, gw = bid_() * 8 + wid_of(tid), NW = gridDim.x * 8;
    float* rwT = (float*)smem;
    { const float* rwp = pin(I_RW); for (int i = tid; i < D * NE; i += NTHREADS) rwT[(i & 15) * D + (i >> 4)] = rwp[i]; }
    const float* rbias = pin(I_RB); const float* n2g = pin(I_N2G) + (size_t)l * D;
    int* lcnt = (int*)(smem + 131072);
    if (tid < NE) lcnt[tid] = 0;
    __syncthreads();
    for (int row = gw; row < mrows; row += NW) {
        const float* xr = xrow_ptr(P, row); const int mr = modrow_of(row);
        const float* ng = n2g; const float* sh = P.MOD() + ((size_t)l * 5 + mr) * (6 * D) + 3 * D; const float* sc = sh + D;
        f4 v[8]; float ss = 0.f;
#pragma unroll
        for (int j = 0; j < 8; ++j) { v[j] = *(const f4*)(xr + (j * 64 + lane) * 4); ss += (v[j][0] * v[j][0] + v[j][1] * v[j][1]) + (v[j][2] * v[j][2] + v[j][3] * v[j][3]); }
        ss = wave_sum(ss);
        const float rstd = rsqrtf(ss * (1.0f / D) + 1e-6f);
        float lg[NE];
#pragma unroll
        for (int e = 0; e < NE; ++e) lg[e] = 0.f;
        half_t* hr = P.H() + (size_t)row * D;
#pragma unroll
        for (int j = 0; j < 8; ++j) { const int c = (j * 64 + lane) * 4; const f4 g = *(const f4*)(ng + c), s1 = *(const f4*)(sc + c), s0 = *(const f4*)(sh + c); f4 o;
#pragma unroll
            for (int i = 0; i < 4; ++i) o[i] = v[j][i] * rstd * g[i] * (1.0f + s1[i]) + s0[i];
#pragma unroll
            for (int e = 0; e < NE; ++e) { const f4 wv = *(const f4*)(rwT + e * D + c); lg[e] += (o[0] * wv[0] + o[1] * wv[1]) + (o[2] * wv[2] + o[3] * wv[3]); }
            *(h4*)(hr + c) = to_h4(o); asm volatile("" ::: "memory"); }
#pragma unroll
        for (int e = 0; e < NE; ++e) lg[e] = wave_sum(lg[e]);
        float sc16[NE], bi[NE];
#pragma unroll
        for (int e = 0; e < NE; ++e) { sc16[e] = sigmoidf_(lg[e]); bi[e] = sc16[e] + rbias[e]; }
        int gsel = 0; float gbest = -1e30f;
#pragma unroll
        for (int g = 0; g < 4; ++g) { float m1 = -1e30f, m2 = -1e30f;
#pragma unroll
            for (int i = 0; i < 4; ++i) { const float x = bi[4 * g + i]; if (x > m1) { m2 = m1; m1 = x; } else if (x > m2) m2 = x; }
            const float s = m1 + m2; if (s > gbest) { gbest = s; gsel = g; } }
        int i0 = 0, i1 = 0; float b0 = -1e30f, b1 = -1e30f, s0v = 0.f, s1v = 0.f;
#pragma unroll
        for (int e = 0; e < NE; ++e) { const bool in = (e >> 2) == gsel; const float x = bi[e];
            if (in && x > b0) { b1 = b0; i1 = i0; s1v = s0v; b0 = x; i0 = e; s0v = sc16[e]; } else if (in && x > b1) { b1 = x; i1 = e; s1v = sc16[e]; } }
        if (lane == 0) { const float inv = 1.0f / (s0v + s1v);
            P.wsel()[row * 2] = s0v * inv; P.wsel()[row * 2 + 1] = s1v * inv; P.pos()[row * 2] = i0; P.pos()[row * 2 + 1] = i1;
            atomicAdd(&lcnt[i0], 1); atomicAdd(&lcnt[i1], 1); }
    }
    __syncthreads();
    if (tid < NE) P.blkcnt()[bid_() * NE + tid] = lcnt[tid];
}
__device__ __forceinline__ void seg_starts(const Params& P, int (&st)[NE + 1]) {
    int a = 0;
#pragma unroll
    for (int e = 0; e < NE; ++e) { st[e] = a; a += (P.cnt()[e] + 255) & ~255; }
    st[NE] = a;
}
__device__ __forceinline__ void ph_slot(const Params& P, int mrows) {
    const int tid = tid_(), lane = tid & 63, bid = bid_(), gw = bid * 8 + wid_of(tid), NW = gridDim.x * 8, G = gridDim.x;
    int* ls = (int*)smem;
    if (tid < 48) ls[tid] = 0;
    __syncthreads();
    { const int e = tid & 15; int t = 0, p = 0;
        for (int b = tid >> 4; b < G; b += NTHREADS / 16) { const int c = P.blkcnt()[b * NE + e]; t += c; p += (b < bid) ? c : 0; }
        atomicAdd(&ls[e], t); atomicAdd(&ls[16 + e], p); }
    __syncthreads();
    if (tid < NE) { int a = 0;
        for (int q = 0; q < tid; ++q) a += (ls[q] + 255) & ~255;
        ls[32 + tid] = a + ls[16 + tid];
        if (bid == 0) P.cnt()[tid] = ls[tid]; }
    __syncthreads();
    int s0 = 0, s1 = 0;
    { const int row = gw + lane * NW;
        if (lane < 16 && row < mrows) { const int e0 = P.pos()[row * 2], e1 = P.pos()[row * 2 + 1];
            s0 = atomicAdd(&ls[32 + e0], 1); s1 = atomicAdd(&ls[32 + e1], 1);
            P.pos()[row * 2] = s0; P.pos()[row * 2 + 1] = s1; } }
#pragma unroll 4
    for (int r = 0; r < 16; ++r) {
        const int row = gw + r * NW; if (row >= mrows) break;
        const int d0s = __shfl(s0, r), d1s = __shfl(s1, r);
        const uint4* src = (const uint4*)(P.H() + (size_t)row * D);
        uint4* d0 = (uint4*)(P.Hs() + (size_t)d0s * D); uint4* d1 = (uint4*)(P.Hs() + (size_t)d1s * D);
        const uint4 c0 = src[lane], c1 = src[64 + lane], c2 = src[128 + lane], c3 = src[192 + lane];
        d0[lane] = c0; d0[64 + lane] = c1; d0[128 + lane] = c2; d0[192 + lane] = c3;
        d1[lane] = c0; d1[64 + lane] = c1; d1[128 + lane] = c2; d1[192 + lane] = c3;
    }
}
struct SchedMoe {
    pg8::TileOrder T; const char* A; const char* B; size_t tstepA, tstepB, estepB; int st[NE + 1];
    __device__ __forceinline__ bool next(int i, pg8::Unit& u) const { int pm, pn; if (!T.tile(i, pm, pn)) return false; u.pm = pm; u.pn = pn; const int s0 = pm * 256; int e = 0;
#pragma unroll
        for (int q = 1; q < NE; ++q) e = (s0 >= st[q]) ? q : e;
        u.A = A + (size_t)pm * tstepA; u.B = B + (size_t)e * estepB + (size_t)pn * tstepB; return true; }
};
__device__ __forceinline__ void ph_up(const Params& P) {
    SchedMoe S; seg_starts(P, S.st); S.T.init(S.st[NE] >> 8, (2 * DE) / 256, gridDim.x, bid_());
    S.A = (const char*)P.Hs(); S.B = (const char*)P.W13T(); S.tstepA = (size_t)256 * D * 2; S.tstepB = (size_t)256 * D * 2; S.estepB = (size_t)2 * DE * D * 2;
    pg8::gemm_phase(D, S, [&](const pg8::Acc& acc, const pg8::Unit& u, int wr, int wc, int fr, int fq) {
        pg8::foreach_pair(acc, wr, wc, fr, fq, [&](int m, int hc, f4 a, f4 g) { f4 o;
#pragma unroll
            for (int i = 0; i < 4; ++i) o[i] = siluf_(a[i]) * g[i];
            *(h4*)(P.Hg() + (size_t)(u.pm * 256 + m) * DE + u.pn * 128 + hc) = to_h4(o); });
    });
}
__device__ __forceinline__ void ph_down(const Params& P) {
    SchedMoe S; seg_starts(P, S.st); S.T.init(S.st[NE] >> 8, D / 256, gridDim.x, bid_());
    S.A = (const char*)P.Hg(); S.B = (const char*)P.W2T(); S.tstepA = (size_t)256 * DE * 2; S.tstepB = (size_t)256 * DE * 2; S.estepB = (size_t)D * DE * 2;
    pg8::gemm_phase<true>(DE, S, [&](const pg8::Acc& acc, const pg8::Unit& u, int wr, int wc, int fr, int fq) {
        pg8::foreach_frag8(acc, wr, wc, fr, fq, [&](int m, int n, f4 a, f4 b) { const h4 x = to_h4(a), y = to_h4(b); h8 o;
#pragma unroll
            for (int i = 0; i < 4; ++i) { o[i] = x[i]; o[4 + i] = y[i]; }
            *(h8*)(P.Y() + (size_t)(u.pm * 256 + m) * D + u.pn * 256 + n) = o; });
    });
}

#ifndef PROBE_BAR
#define PROBE_BAR 1
#endif
#define XBAR(b) REP(PROBE_BAR, xcd_barrier(b);)
template <int l> __device__ __forceinline__ void layer_body(const Params& P, const XcdBarrier& bar, const int bid, const int G) {
    constexpr int MR = (l == DEPTH - 1) ? RL : MT;

    if (l == 0) { ph_prologue(P); REP(PROBE_SETUP, ph_setup(P, 0); XBAR(bar);) ph_rows<0>(P, 0); }
    else { ph_setup(P, l); ph_rows<1>(P, l); }
    XBAR(bar);
    REP(PROBE_INPROJ, ph_inproj<0>(P, bid, G); XBAR(bar);)
    REP(PROBE_CONVF, REP(PROBE_CONV1, ph_convf(P, l);) ph_lora(P, l, bid, G); REP(PROBE_S5G2, ph_s5g2(P, bid, G);) XBAR(bar);)
    REP(PROBE_SCANS,
    if (G >= 224) { if (bid < 96) { REP(PROBE_RWKV, ph_rwkv(P, l, bid, 1 << 30);) ph_inproj<1>(P, bid, 96, 96 * GATE_KU, MR); }
                    else if (bid >= G - NCONV) { ph_moe_convert(P, l, 2, 0, MOE_A); ph_inproj<1>(P, 96 * GATE_KU + bid - (G - NCONV), NCONV, 96 * GATE_KU + NCONV * CONV_GU, MR); }
                    else { ph_s5scan(P, l, bid - 96, G - 96 - NCONV); ph_gla_a(P, bid - 96, G - 96 - NCONV); ph_inproj<1>(P, 96 * GATE_KU + NCONV * CONV_GU + bid - 96, G - 96 - NCONV, 1 << 30, MR); } }
    else { ph_rwkv(P, l, bid, G); ph_s5scan(P, l, bid, G); ph_gla_a(P, bid, G); ph_inproj<1>(P, bid, G, 1 << 30, MR); ph_moe_convert(P, l, 2, 0, MOE_A); }
    XBAR(bar);)
    ph_gla_b(P, bid, G); ph_s5g1(P, l, bid, G); ph_comb(P, l, MR); ph_moe_convert(P, l, 0, MOE_A, MOE_A + (6144 - MOE_A) / 2);
    XBAR(bar);
    REP(PROBE_P6, ph_gla_c(P, l, bid, G, l == DEPTH - 1); ph_glu(P, MR);) ph_moe_convert(P, l, 1, MOE_A + (6144 - MOE_A) / 2, 6144); XBAR(bar);
    REP(PROBE_MERGE1, ph_merge1(P, MR); XBAR(bar);)
    ph_merge2(P, l, MR);
    XBAR(bar);
    ph_route(P, l, MR);
    XBAR(bar);
    ph_slot(P, MR);
    XBAR(bar);
    REP(PROBE_MOE, ph_up(P); XBAR(bar); ph_down(P); XBAR(bar);)
    }
__global__ void __launch_bounds__(NTHREADS, 2) k_fused(Params P) {
    const int bid = blockIdx.x, G = gridDim.x;
    volatile LAS unsigned* xbw = (volatile LAS unsigned*)(LAS unsigned char*)(smem + LDS_BYTES - 16);
    if (threadIdx.x == 0) { xbw[0] = 0u; xbw[1] = 0u; xbw[2] = 0u; xbw[3] = 0u; }
    __syncthreads();
    const XcdBarrier bar = xcd_barrier_post(P.bar(), xbw);
    layer_body<0>(P, bar, bid, G);
    layer_body<1>(P, bar, bid, G);
    ph_rows<2>(P, 1);
}

extern "C" void kernel_launch(void* const* d_in, const int* in_sizes, int n_in, void* d_out, int out_size, void* d_ws, size_t ws_size, hipStream_t stream) {
    static int grid = 0;
    if (grid == 0) { int dev = 0, cus = 0; (void)hipGetDevice(&dev); (void)hipDeviceGetAttribute(&cus, hipDeviceAttributeMultiprocessorCount, dev); grid = cus > 0 ? cus : 256;
        (void)hipFuncSetAttribute((const void*)k_fused, hipFuncAttributeMaxDynamicSharedMemorySize, LDS_BYTES); }
    Params P{};
    for (int i = 0; i < 42; ++i) P.in[i] = (const float*)d_in[i];
    P.out = (float*)d_out;
    P.ws = (unsigned char*)d_ws;
    if (WS_TOTAL > ws_size || n_in != 42 || out_size != RL * D) { fprintf(stderr, "kernel_launch: workspace %zu < %zu or bad shapes\n", ws_size, (size_t)WS_TOTAL); return; }
    (void)hipMemsetAsync(P.ws + OFF_bar, 0, XCD_BAR_WORDS * sizeof(unsigned), stream);
    hipLaunchKernelGGL(k_fused, dim3(grid), dim3(NTHREADS), LDS_BYTES, stream, P);
}
```

```cpp
#include <hip/hip_runtime.h>
#include <stdint.h>
#include <stdio.h>

typedef _Float16 half_t;
typedef _Float16 h8 __attribute__((ext_vector_type(8)));
typedef _Float16 h4 __attribute__((ext_vector_type(4)));
typedef _Float16 h2 __attribute__((ext_vector_type(2)));
typedef float f4 __attribute__((ext_vector_type(4)));
typedef float f2 __attribute__((ext_vector_type(2)));

constexpr int D = 2048, NBATCH = 4, SEQ = 4096, CTXL = 256, DEPTH = 2;
constexpr int RL = NBATCH * SEQ, RC = NBATCH * CTXL, MT = RL + RC;
constexpr int TS = SEQ + CTXL;
constexpr int ADIM = 768, AH = 12, BDIM = 768, BKEY = 384, BH = 4, BHK = 96, BHV = 192, CDIM = 512, CGR = 32, CP = 64;
constexpr int CONV = 3840, NLO = 1792, NGT = 6144, INSRC = 11680, INPAD = 11776;
constexpr int LO_DW = 0, LO_DA = 128, LO_DG = 256, LO_BG = 384, LO_OG = 416, LO_U = 1184;
constexpr int NE = 16, DE = 1024;
constexpr int SLOTS = 38912;
constexpr int YCP = 768;
constexpr int S5ROWS = NBATCH * (TS / 16);
constexpr int NTHREADS = 512;
#ifndef PROBE_SETUP
#define PROBE_SETUP 1
#endif
#ifndef PROBE_SCAN
#define PROBE_SCAN 1
#endif
#ifndef PROBE_INPROJ
#define PROBE_INPROJ 1
#endif
#ifndef PROBE_CONVF
#define PROBE_CONVF 1
#endif
#ifndef PROBE_MOE
#define PROBE_MOE 1
#endif
#ifndef PROBE_MERGE1
#define PROBE_MERGE1 1
#endif
#ifndef PROBE_GLA
#define PROBE_GLA 1
#endif
#ifndef PROBE_RWKV
#define PROBE_RWKV 1
#endif
#ifndef GATE_KU
#define GATE_KU 1
#endif
#ifndef PROBE_SCANS
#define PROBE_SCANS 1
#endif
#ifndef RWKV_REP
#define RWKV_REP 1
#endif
#ifndef PROBE_CONV1
#define PROBE_CONV1 1
#endif
#ifndef PROBE_S5G2
#define PROBE_S5G2 1
#endif
#ifndef NCONV
#define NCONV 16
#define CONV_GU 6
#define MOE_I 512
#define MOE_A 2048
#endif
#ifndef PROBE_P6
#define PROBE_P6 1
#endif
#define REP_1(...) __VA_ARGS__
#define REP_2(...) __VA_ARGS__ __VA_ARGS__
#define REP_3(...) __VA_ARGS__ __VA_ARGS__ __VA_ARGS__
#define REP_CAT(a, b) a##b
#define REP_X(n, ...) REP_CAT(REP_, n)(__VA_ARGS__)
#define REP(n, ...) REP_X(n, __VA_ARGS__)
#ifndef PROBE_COMB
#define PROBE_COMB 1
#endif
constexpr int LDS_BYTES = 139264;

constexpr size_t al_(size_t x) { return (x + 255) & ~(size_t)255; }
constexpr size_t OFF_bar = 0;
constexpr size_t OFF_cnt = OFF_bar + al_(16384);
constexpr size_t OFF_blkcnt = OFF_cnt + al_(256);
constexpr size_t OFF_sidx = OFF_blkcnt + al_(1024 * NE * 4);
constexpr size_t OFF_MOD = OFF_sidx + al_((size_t)SLOTS * 4);
constexpr size_t OFF_Xc = OFF_MOD + al_((size_t)2 * 5 * 6 * D * 4);
constexpr size_t OFF_pos = OFF_Xc + al_((size_t)RC * D * 4);
constexpr size_t OFF_wsel = OFF_pos + al_((size_t)MT * 2 * 4);
constexpr size_t OFF_WinT = OFF_wsel + al_((size_t)MT * 2 * 4);
constexpr size_t OFF_PaT = OFF_WinT + al_((size_t)INPAD * D * 2);
constexpr size_t OFF_WoT = OFF_PaT + al_((size_t)3 * D * YCP * 2);
constexpr size_t OFF_W13T = OFF_WoT + al_((size_t)D * D * 2);
constexpr size_t OFF_W2T = OFF_W13T + al_((size_t)NE * 2 * DE * D * 2);
constexpr size_t OFF_GluT = OFF_W2T + al_((size_t)NE * D * DE * 2);
constexpr size_t OFF_MstT = OFF_GluT + al_((size_t)2 * CDIM * CDIM * 2);
constexpr size_t OFF_McatT = OFF_MstT + al_((size_t)CGR * 256 * 256 * 2);
constexpr size_t OFF_LW2T = OFF_McatT + al_((size_t)CGR * 256 * 512 * 2);
constexpr size_t OFF_LA2T = OFF_LW2T + al_((size_t)2 * ADIM * 64 * 2);
constexpr size_t OFF_LG2T = OFF_LA2T + al_((size_t)2 * ADIM * 64 * 2);
constexpr size_t OFF_LGLT = OFF_LG2T + al_((size_t)ADIM * 128 * 2);
constexpr size_t OFF_XinH = OFF_LGLT + al_((size_t)2 * BKEY * 64 * 2);
constexpr size_t OFF_H = OFF_XinH + al_((size_t)CGR * S5ROWS * 256 * 2);
constexpr size_t OFF_Pconv = OFF_H + al_((size_t)MT * D * 2);
constexpr size_t OFF_Plo = OFF_Pconv + al_((size_t)MT * CONV * 2);
constexpr size_t OFF_Pg = OFF_Plo + al_((size_t)MT * NLO * 2);
constexpr size_t OFF_F = OFF_Pg + al_((size_t)MT * NGT * 2);
constexpr size_t OFF_KK = OFF_F + al_((size_t)MT * CONV * 2);
constexpr int GLT = 2 * NBATCH * BH * (TS / 64);
constexpr size_t OFF_GS = OFF_KK + al_((size_t)MT * (ADIM * 5 + BKEY * 2) * 2);
constexpr size_t OFF_GQ = OFF_GS + al_((size_t)GLT * BHV * BHK * 2);
constexpr size_t OFF_GE = OFF_GQ + al_((size_t)GLT * 64 * BHK * 2);
constexpr size_t OFF_Sloc = OFF_GE + al_((size_t)GLT * BHK * 4);
constexpr size_t WS_TOTAL = OFF_Sloc + al_((size_t)CGR * S5ROWS * 256 * 4);
static_assert(WS_TOTAL <= (size_t)1416134720, "workspace must fit the guaranteed size (sum of the input bytes)");
static_assert((size_t)SLOTS * D * 2 <= (size_t)MT * (ADIM * 5 + BKEY * 2) * 2, "Hs must fit the feature region");
static_assert((size_t)SLOTS * D * 2 <= (size_t)MT * NGT * 2 && (size_t)SLOTS * DE * 2 <= (size_t)MT * CONV * 2, "Y / Hg must fit");
constexpr size_t OFF_Z = OFF_Pconv, OFF_O = OFF_Pconv + (size_t)2 * MT * ADIM * 2, OFF_Hg = OFF_Pconv, OFF_Y = OFF_Pg;
constexpr size_t OFF_YA = OFF_F, OFF_YB = OFF_YA + (size_t)MT * YCP * 2, OFF_YC = OFF_YB + (size_t)MT * YCP * 2, OFF_TC = OFF_YC + (size_t)MT * CDIM * 2;
constexpr size_t OFF_SW = OFF_KK + (size_t)MT * ADIM * 2, OFF_AA = OFF_SW + (size_t)2 * MT * ADIM * 2, OFF_GG = OFF_AA + (size_t)2 * MT * ADIM * 2, OFF_U = OFF_KK, OFF_Hs = OFF_KK;
constexpr size_t OFF_PbT = OFF_PaT + (size_t)D * YCP * 2, OFF_PcT = OFF_PbT + (size_t)D * YCP * 2;
#define GAS __attribute__((address_space(1)))
struct Params {
    const float* in[42];
    float* out;
    unsigned char* ws;
#define WSP(type, name) __device__ __forceinline__ type* name() const { GAS unsigned char* w = (GAS unsigned char*)ws; asm volatile("" : "+s"(w)); return (type*)(GAS type*)(w + OFF_##name); }
    WSP(unsigned, bar) WSP(int, cnt) WSP(int, blkcnt) WSP(int, sidx) WSP(float, MOD) WSP(float, Xc) WSP(int, pos) WSP(float, wsel) WSP(float, Sloc)
    WSP(half_t, WinT) WSP(half_t, PaT) WSP(half_t, PbT) WSP(half_t, PcT) WSP(half_t, WoT) WSP(half_t, W13T) WSP(half_t, W2T) WSP(half_t, GluT) WSP(half_t, MstT) WSP(half_t, McatT)
    WSP(half_t, LW2T) WSP(half_t, LA2T) WSP(half_t, LG2T) WSP(half_t, LGLT) WSP(half_t, XinH) WSP(half_t, H) WSP(half_t, Pconv) WSP(half_t, Plo) WSP(half_t, Pg) WSP(half_t, F)
    WSP(half_t, KK) WSP(half_t, SW) WSP(half_t, AA) WSP(half_t, GG) WSP(half_t, Z) WSP(half_t, O) WSP(half_t, TC) WSP(half_t, YA) WSP(half_t, YB) WSP(half_t, YC) WSP(half_t, U)
    WSP(half_t, Hg) WSP(half_t, Y) WSP(half_t, Hs) WSP(half_t, GS) WSP(half_t, GQ) WSP(float, GE)
#undef WSP
};
enum { I_X = 0, I_C, I_CTX, I_CCTX, I_MODW, I_MODB, I_N1G, I_N2G, I_WIN, I_CONVW, I_RKW0, I_RKW2, I_RKA0, I_RKA2, I_RKG2, I_RKKK, I_RKKA, I_RKRK, I_RKGNW, I_RKGNB,
       I_GLAA2, I_GLAAB, I_GLANG, I_S5LRE, I_S5LIM, I_S5LDT, I_S5BRE, I_S5BIM, I_S5CRE, I_S5CIM, I_S5D, I_S5GLU, I_PA, I_PB, I_PC, I_WOUT, I_RW, I_RB, I_W1, I_W3, I_W2, I_FG };

extern __shared__ __attribute__((aligned(16))) unsigned char smem[];

__device__ __forceinline__ float sigmoidf_(float x) { return 1.0f / (1.0f + __expf(-x)); }
__device__ __forceinline__ float siluf_(float x) { return x * sigmoidf_(x); }
__device__ __forceinline__ float wave_sum(float v) {
#pragma unroll
    for (int o = 1; o < 64; o <<= 1) v += __shfl_xor(v, o);
    return v;
}
template <int CTRL> __device__ __forceinline__ float dpp_f(float x) {
    return __builtin_bit_cast(float, __builtin_amdgcn_update_dpp(0, __builtin_bit_cast(int, x), CTRL, 0xf, 0xf, true));
}
__device__ __forceinline__ float red8(float x) { x += dpp_f<0xB1>(x); x += dpp_f<0x4E>(x); x += dpp_f<0x141>(x); return x; }
__device__ __forceinline__ float wave_sum_fast(float x);
__device__ __forceinline__ float red16(float x) { x = red8(x); x += dpp_f<0x140>(x); return x; }
__device__ __forceinline__ void lds_barrier() { asm volatile("s_waitcnt lgkmcnt(0)" ::: "memory"); __builtin_amdgcn_s_barrier(); asm volatile("" ::: "memory"); }
__device__ __forceinline__ float wave_sum_fast(float x) { x = red16(x); const int xi = __builtin_bit_cast(int, x);
    const float a = __builtin_bit_cast(float, __builtin_amdgcn_readlane(xi, 0)), b = __builtin_bit_cast(float, __builtin_amdgcn_readlane(xi, 16));
    const float c = __builtin_bit_cast(float, __builtin_amdgcn_readlane(xi, 32)), d = __builtin_bit_cast(float, __builtin_amdgcn_readlane(xi, 48)); return (a + b) + (c + d); }
__device__ __forceinline__ int modrow_of(int row) { return row < RL ? (row >> 12) : 4; }
__device__ __forceinline__ float* xrow_ptr(const Params& P, int row) { return row < RL ? P.out + (size_t)row * D : P.Xc() + (size_t)(row - RL) * D; }
__device__ __forceinline__ const float* pin(int i);
__device__ __forceinline__ const float* xsrc_ptr(const Params& P, int row, int l) {
    if (l == 0) return row < RL ? pin(I_X) + (size_t)row * D : pin(I_CTX) + (size_t)(row - RL) * D;
    return xrow_ptr(P, row);
}
__device__ __forceinline__ int tokrow(int d, int b, int s) {
    if (s < CTXL) return RL + b * CTXL + (d ? (CTXL - 1 - s) : s);
    const int t = s - CTXL; return b * SEQ + (d ? (SEQ - 1 - t) : t);
}
__device__ __forceinline__ int s5_block_row0(int b, int n) { return n < 16 ? RL + b * CTXL + n * 16 : b * SEQ + (n - 16) * 16; }
__device__ __forceinline__ h4 to_h4(f4 v) { h4 r; r[0] = (half_t)v[0]; r[1] = (half_t)v[1]; r[2] = (half_t)v[2]; r[3] = (half_t)v[3]; return r; }

__device__ __forceinline__ int tid_() { int t = threadIdx.x; asm volatile("" : "+v"(t)); return t; }
__device__ __forceinline__ const float* pin(int i) { asm volatile("" : "+s"(i)); const float* p = ((const float* const __attribute__((address_space(4)))*)__builtin_amdgcn_kernarg_segment_ptr())[i];
    return (const float*)(const GAS float*)p; }
__device__ __forceinline__ int wid_of(int tid) { return __builtin_amdgcn_readfirstlane(tid >> 6); }
__device__ __forceinline__ int bid_() { int b = blockIdx.x; asm volatile("" : "+s"(b)); return b; }
#define XB_TMO      128
#define XB_XCNT(j)  (256  + 64 * (j))
#define XB_XSUB(j)  (1280 + 64 * (j))
#define XB_XGEN(j)  (2304 + 64 * (j))
#define XB_TOP      3328
#define XB_TOPGEN   3392
#define XCD_BAR_WORDS 3456
#define XB_SPIN_CAP (1u << 22)
#define LAS __attribute__((address_space(3)))

__device__ __forceinline__ unsigned xb_ld(unsigned* p)              { return __hip_atomic_load(p, __ATOMIC_RELAXED, __HIP_MEMORY_SCOPE_AGENT); }
__device__ __forceinline__ unsigned xb_add(unsigned* p, unsigned v) { return __hip_atomic_fetch_add(p, v, __ATOMIC_RELAXED, __HIP_MEMORY_SCOPE_AGENT); }
__device__ __forceinline__ unsigned xb_xcc_id() { return (unsigned)__builtin_amdgcn_s_getreg((3 << 11) | 20) & 0xFu; }
#define XB_SPIN(cond, bar) do { unsigned _sp = 0; while (cond) { __builtin_amdgcn_s_sleep(1); \
    if ((++_sp & 255u) == 0u) { if (xb_ld(&(bar)[XB_TMO])) break; if (_sp > XB_SPIN_CAP) { atomicAdd(&(bar)[XB_TMO], 1u); break; } } } } while (0)

struct XcdBarrier {
    unsigned* bar; unsigned x;
    volatile LAS unsigned* st;
};

__device__ __forceinline__ XcdBarrier xcd_barrier_post(unsigned* bar, volatile LAS unsigned* st) {
    XcdBarrier b; b.bar = bar; b.x = xb_xcc_id(); b.st = st;
    if (threadIdx.x == 0) (void)xb_add(&bar[XB_XCNT(b.x)], 1u);
    return b;
}
__device__ __forceinline__ void xcd_barrier_complete(unsigned* bar, unsigned x, unsigned& nloc, unsigned& nx) {
    asm volatile("" : "+s"(x));
    const unsigned G = gridDim.x * gridDim.y * gridDim.z;
    unsigned sum, cnt, mine, sp = 0u;
    for (;;) {
        sum = 0u; cnt = 0u; mine = 0u;
#pragma unroll
        for (unsigned j = 0; j < 16; ++j) { const unsigned c = xb_ld(&bar[XB_XCNT(j)]); sum += c; cnt += (c > 0u) ? 1u : 0u; mine = (j == x) ? c : mine; }
        if (sum == G) break;
        __builtin_amdgcn_s_sleep(1);
        if ((++sp & 255u) == 0u) { if (xb_ld(&bar[XB_TMO])) break; if (sp > XB_SPIN_CAP) { atomicAdd(&bar[XB_TMO], 1u); break; } }
    }
    nloc = mine > 0u ? mine : 1u; nx = cnt > 0u ? cnt : 1u;
}

__device__ __forceinline__ void xcd_barrier(const XcdBarrier& b) {
    asm volatile("s_waitcnt vmcnt(0)" ::: "memory");
    __syncthreads();
    if (threadIdx.x == 0) {
        __attribute__((address_space(1))) unsigned* gbar = (__attribute__((address_space(1))) unsigned*)b.bar; asm volatile("" : "+s"(gbar));
        unsigned* bar = (unsigned*)gbar;
        __builtin_amdgcn_s_waitcnt(0);
        unsigned nloc = b.st[0], nx = b.st[1];
        if (nloc == 0u) { xcd_barrier_complete(bar, b.x, nloc, nx); b.st[0] = nloc; b.st[1] = nx; }
        const unsigned old = xb_add(&bar[XB_XSUB(b.x)], 1u);
        const unsigned gen = old / nloc;
        if (old + 1u == (gen + 1u) * nloc) {
            __builtin_amdgcn_fence(__ATOMIC_RELEASE, "agent");
            asm volatile("s_waitcnt vmcnt(0)" ::: "memory");
            const unsigned og = xb_add(&bar[XB_TOP], 1u);
            const unsigned tg = og / nx;
            if (og + 1u == (tg + 1u) * nx) xb_add(&bar[XB_TOPGEN], 1u);
            else XB_SPIN(xb_ld(&bar[XB_TOPGEN]) == tg, bar);
            __builtin_amdgcn_fence(__ATOMIC_ACQUIRE, "agent");
            xb_add(&bar[XB_XGEN(b.x)], 1u);
            asm volatile("s_waitcnt vmcnt(0)" ::: "memory");
        } else {
            XB_SPIN(xb_ld(&bar[XB_XGEN(b.x)]) == gen, bar);
            __builtin_amdgcn_fence(__ATOMIC_ACQUIRE, "agent");
            asm volatile("s_waitcnt vmcnt(0)" ::: "memory");
        }
    }
    __syncthreads();
}


constexpr int GST = 72;
constexpr int GEMM_LDS = 2 * 2 * 128 * GST * 2;
template <class AF, class BF>
__device__ __forceinline__ void gemm_tile(int nk, AF afn, BF bfn, f4 (&acc)[4][2]) {
    half_t* As = (half_t*)smem; half_t* Bs = As + 2 * 128 * GST;
    const int tid = tid_(), lane = tid & 63, w = wid_of(tid), wm = w >> 2, wn = w & 3;
    const int pr0 = tid >> 3, pk = (tid & 7) * 8;
    uint4 ra[2], rb[2];
#pragma unroll
    for (int i = 0; i < 2; ++i) { ra[i] = afn(pr0 + 64 * i, pk); rb[i] = bfn(pr0 + 64 * i, pk); }
    __syncthreads();
#pragma unroll
    for (int i = 0; i < 2; ++i) { *(uint4*)(As + (pr0 + 64 * i) * GST + pk) = ra[i]; *(uint4*)(Bs + (pr0 + 64 * i) * GST + pk) = rb[i]; }
    __syncthreads();
    for (int kt = 0; kt < nk; ++kt) {
        const int cur = kt & 1;
        if (kt + 1 < nk) {
#pragma unroll
            for (int i = 0; i < 2; ++i) { ra[i] = afn(pr0 + 64 * i, (kt + 1) * 64 + pk); rb[i] = bfn(pr0 + 64 * i, (kt + 1) * 64 + pk); }
        }
        const half_t* Ac = As + cur * 128 * GST; const half_t* Bc = Bs + cur * 128 * GST;
#pragma unroll
        for (int ks = 0; ks < 2; ++ks) {
            h8 af[4], bf[2];
#pragma unroll
            for (int mi = 0; mi < 4; ++mi) af[mi] = *(const h8*)(Ac + (64 * wm + 16 * mi + (lane & 15)) * GST + 32 * ks + 8 * (lane >> 4));
#pragma unroll
            for (int ni = 0; ni < 2; ++ni) bf[ni] = *(const h8*)(Bc + (32 * wn + 16 * ni + (lane & 15)) * GST + 32 * ks + 8 * (lane >> 4));
#pragma unroll
            for (int mi = 0; mi < 4; ++mi)
#pragma unroll
                for (int ni = 0; ni < 2; ++ni) acc[mi][ni] = __builtin_amdgcn_mfma_f32_16x16x32_f16(bf[ni], af[mi], acc[mi][ni], 0, 0, 0);
        }
        if (kt + 1 < nk) {
            half_t* An = As + (cur ^ 1) * 128 * GST; half_t* Bn = Bs + (cur ^ 1) * 128 * GST;
#pragma unroll
            for (int i = 0; i < 2; ++i) { *(uint4*)(An + (pr0 + 64 * i) * GST + pk) = ra[i]; *(uint4*)(Bn + (pr0 + 64 * i) * GST + pk) = rb[i]; }
        }
        __syncthreads();
    }
}
__device__ __forceinline__ void acc_zero(f4 (&acc)[4][2]) {
#pragma unroll
    for (int mi = 0; mi < 4; ++mi)
#pragma unroll
        for (int ni = 0; ni < 2; ++ni) acc[mi][ni] = (f4){0.f, 0.f, 0.f, 0.f};
}
template <class FN> __device__ __forceinline__ void acc_foreach(const f4 (&acc)[4][2], FN fn) {
    const int lane = tid_() & 63, w = wid_of(tid_()), wm = w >> 2, wn = w & 3;
#pragma unroll
    for (int mi = 0; mi < 4; ++mi)
#pragma unroll
        for (int ni = 0; ni < 2; ++ni) fn(64 * wm + 16 * mi + (lane & 15), 32 * wn + 16 * ni + 4 * (lane >> 4), acc[mi][ni]);
}
template <class LD, class ST> __device__ __forceinline__ void acc_foreach2(const f4 (&acc)[4][2], LD ld, ST st) {
    const int lane = tid_() & 63, w = wid_of(tid_()), wm = w >> 2, wn = w & 3;
    decltype(ld(0, 0)) tmp[4][2];
#pragma unroll
    for (int mi = 0; mi < 4; ++mi)
#pragma unroll
        for (int ni = 0; ni < 2; ++ni) tmp[mi][ni] = ld(64 * wm + 16 * mi + (lane & 15), 32 * wn + 16 * ni + 4 * (lane >> 4));
#pragma unroll
    for (int mi = 0; mi < 4; ++mi)
#pragma unroll
        for (int ni = 0; ni < 2; ++ni) st(64 * wm + 16 * mi + (lane & 15), 32 * wn + 16 * ni + 4 * (lane >> 4), acc[mi][ni], tmp[mi][ni]);
}
__device__ __forceinline__ uint4 ld16(const half_t* p) { return *(const uint4*)p; }
__device__ __forceinline__ uint4 zero16() { return make_uint4(0u, 0u, 0u, 0u); }

namespace pg8 {
constexpr int BM = 256, BK = 64, HALF = 128, HTB = HALF * BK * 2, STAGE_BYTES = 8 * HTB, NXCD = 8, WGM = 8;
__host__ __device__ __forceinline__ int lds_byte(int r, int c) { const int st = (r >> 4) * 2 + (c >> 5), rr = r & 15, cc = c & 31, ob = rr * 64 + cc * 2; return st * 1024 + (ob ^ (((ob >> 9) & 1) << 5)); }
__host__ __device__ __forceinline__ void stage_rc(int b, int& R, int& C) { const int st = b / 1024, sb = b % 1024, swz = sb ^ (((sb >> 9) & 1) << 5); R = (st >> 1) * 16 + swz / 64; C = (st & 1) * 32 + (swz % 64) / 2; }
__host__ __device__ __forceinline__ int perm32(int rho) { const int n = rho >> 4, i = rho & 15; return 8 * (i >> 2) + 4 * n + (i & 3); }
struct Unit { const char* A; const char* B; int pm, pn; };
struct TileOrder {
    int nM, nN, nwg, G, c, lim;
    __device__ __forceinline__ void init(int nM_, int nN_, int G_, int c_, int lim_ = 1 << 30) { nM = nM_; nN = nN_; nwg = nM * nN; G = G_; c = c_; lim = lim_ < nwg ? lim_ : nwg; }
    __device__ __forceinline__ bool tile(int i, int& pm, int& pn) const {
        const long L = (long)i * G + c; if (L >= lim) return false;
        int wgid = (int)L; { const int q = nwg / NXCD, r = nwg % NXCD, xcd = wgid % NXCD, off = wgid / NXCD; wgid = (xcd < r ? xcd * (q + 1) : r * (q + 1) + (xcd - r) * q) + off; }
        const int nig = WGM * nN, gid = wgid / nig, fm = gid * WGM, gsz = (nM - fm) < WGM ? (nM - fm) : WGM;
        pm = fm + ((wgid % nig) % gsz); pn = (wgid % nig) / gsz; return true;
    }
};
typedef f4 Acc[2][2][4][2];
template <bool PERM = false, bool GATHER = false, class Sched, class Epi>
__device__ __forceinline__ void gemm_phase(const int K, const Sched& S, const Epi& E, const int* gidx = nullptr) {
    LAS unsigned char* lds = (LAS unsigned char*)smem;
    const int tid = tid_(), wid = __builtin_amdgcn_readfirstlane(tid >> 6), lane = tid & 63, wr = wid >> 2, wc = wid & 3, fr = lane & 15, fq = lane >> 4;
    const int nt = K / BK;
    unsigned voff[2], voffB[2];
#pragma unroll
    for (int i = 0; i < 2; ++i) { int R, C; stage_rc(tid * 16 + i * 8192, R, C); const int Rb = PERM ? ((R & ~31) + perm32(R & 31)) : R; voff[i] = (unsigned)(R * K + C) * 2u; voffB[i] = (unsigned)(Rb * K + C) * 2u; }
    const size_t kstep = (size_t)(BK * 2);
    const size_t hstep = (size_t)HALF * K * 2;
    const unsigned ldsw = (unsigned)wid * 1024u;
    const int aoff = lds_byte(wr * 64 + fr, fq * 8), boff = lds_byte(wc * 32 + fr, fq * 8);
#define PG8_SA(b, h) (((b) * 2 + (h)) * HTB)
#define PG8_SB(b, h) ((4 + (b) * 2 + (h)) * HTB)
#define PG8_STAGEV(bufoff, gbase, vo) do { _Pragma("unroll") for (int _i = 0; _i < 2; ++_i) \
        __builtin_amdgcn_global_load_lds((const unsigned*)((const char*)(gbase) + vo[_i]), (LAS unsigned*)(lds + (bufoff) + ldsw + _i * 8192), 16, 0, 0); } while (0)
#define PG8_STAGE(bufoff, gbase) PG8_STAGEV(bufoff, gbase, voff)
#define PG8_STAGEA(bufoff, gbase, h) do { if constexpr (GATHER) PG8_STAGEV(bufoff, gbase, go[h]); else PG8_STAGEV(bufoff, (gbase) + (h) * hstep, voff); } while (0)
#define PG8_GOFF(dst, pm_) do { if constexpr (GATHER) { _Pragma("unroll") for (int _h = 0; _h < 2; ++_h) _Pragma("unroll") for (int _i = 0; _i < 2; ++_i) { int R_, C_; stage_rc(tid * 16 + _i * 8192, R_, C_); \
        dst[_h][_i] = ((unsigned)gidx[(pm_) * 256 + _h * HALF + R_] * (unsigned)K + (unsigned)C_) * 2u; } } } while (0)
#define PG8_STAGEB(bufoff, gbase) PG8_STAGEV(bufoff, gbase, voffB)
#define PG8_LDA(dst, b, h) do { _Pragma("unroll") for (int m = 0; m < 4; ++m) _Pragma("unroll") for (int k = 0; k < 2; ++k) dst[m][k] = *(const LAS h8*)(lds + PG8_SA(b, h) + aoff + m * 2048 + k * 1024); } while (0)
#define PG8_LDB(dst, b, h) do { _Pragma("unroll") for (int n = 0; n < 2; ++n) _Pragma("unroll") for (int k = 0; k < 2; ++k) dst[n][k] = *(const LAS h8*)(lds + PG8_SB(b, h) + boff + n * 2048 + k * 1024); } while (0)
#define PG8_MMA(ai, bj, At, Bt) do { __builtin_amdgcn_s_setprio(1); _Pragma("unroll") for (int m = 0; m < 4; ++m) _Pragma("unroll") for (int n = 0; n < 2; ++n) _Pragma("unroll") for (int k = 0; k < 2; ++k) \
        acc[ai][bj][m][n] = __builtin_amdgcn_mfma_f32_16x16x32_f16(Bt[n][k], At[m][k], acc[ai][bj][m][n], 0, 0, 0); __builtin_amdgcn_s_setprio(0); } while (0)
#define PG8_WAIT_V(n) asm volatile("s_waitcnt vmcnt(" #n ")" ::: "memory")
#define PG8_WAIT_L(n) asm volatile("s_waitcnt lgkmcnt(" #n ")" ::: "memory")
#define PG8_BAR __builtin_amdgcn_s_barrier()
#define PG8_SCHED __builtin_amdgcn_sched_barrier(0)
    Unit cur, nxt; int ui = 0;
    if (!S.next(0, cur)) return;
    unsigned go[2][2], ngo[2][2];
    PG8_GOFF(go, cur.pm);
    Acc acc;
#pragma unroll
    for (int a = 0; a < 2; ++a)
#pragma unroll
        for (int b = 0; b < 2; ++b)
#pragma unroll
            for (int m = 0; m < 4; ++m)
#pragma unroll
                for (int n = 0; n < 2; ++n) acc[a][b][m][n] = (f4){0.f, 0.f, 0.f, 0.f};
    h8 At[4][2], B0[2][2], B1[2][2];
    const char* cA = cur.A; const char* cB = cur.B;
    PG8_STAGEB(PG8_SB(0, 0), cB); PG8_STAGEA(PG8_SA(0, 0), cA, 0); PG8_STAGEB(PG8_SB(0, 1), cB + hstep); PG8_STAGEA(PG8_SA(0, 1), cA, 1);
    if (wr == 1) PG8_BAR;
    PG8_WAIT_V(4); PG8_BAR;
    PG8_STAGEB(PG8_SB(1, 0), cB + kstep); PG8_STAGEA(PG8_SA(1, 0), cA + kstep, 0); PG8_STAGEB(PG8_SB(1, 1), cB + hstep + kstep);
    PG8_WAIT_V(6); PG8_BAR;
    for (;;) {
        const bool has_next = S.next(ui + 1, nxt);
        const char* nA = has_next ? nxt.A : cA; const char* nB = has_next ? nxt.B : cB;
        if constexpr (GATHER) { if (has_next) PG8_GOFF(ngo, nxt.pm); else {
#pragma unroll
            for (int _h = 0; _h < 2; ++_h) { ngo[_h][0] = go[_h][0]; ngo[_h][1] = go[_h][1]; } } }
        for (int t = 0; t < nt; t += 2) {
            const bool last = (t == nt - 2);
            const char* a1 = cA + (size_t)(t + 1) * kstep;
            const char* a2 = last ? nA : cA + (size_t)(t + 2) * kstep; const char* b2 = last ? nB : cB + (size_t)(t + 2) * kstep;
            const char* a3 = a2 + kstep; const char* b3 = b2 + kstep;
            PG8_LDB(B0, 0, 0); PG8_SCHED; PG8_LDA(At, 0, 0); PG8_STAGEA(PG8_SA(1, 1), a1, 1);
            if constexpr (GATHER) { if (last) { asm volatile("" ::: "memory");
#pragma unroll
                for (int _h = 0; _h < 2; ++_h) { go[_h][0] = ngo[_h][0]; go[_h][1] = ngo[_h][1]; } } }
            PG8_WAIT_L(8); PG8_BAR; PG8_WAIT_L(0); PG8_MMA(0, 0, At, B0); PG8_BAR; PG8_SCHED;
            PG8_LDB(B1, 0, 1); PG8_STAGEB(PG8_SB(0, 0), b2);
            PG8_BAR; PG8_WAIT_L(0); PG8_MMA(0, 1, At, B1); PG8_BAR;
            PG8_LDA(At, 0, 1); PG8_STAGEA(PG8_SA(0, 0), a2, 0);
            PG8_BAR; PG8_WAIT_L(0); PG8_MMA(1, 0, At, B0); PG8_BAR; PG8_SCHED;
            PG8_STAGEB(PG8_SB(0, 1), b2 + hstep);
            PG8_WAIT_V(6); PG8_BAR; PG8_MMA(1, 1, At, B1); PG8_BAR;
            PG8_LDB(B0, 1, 0); PG8_SCHED; PG8_LDA(At, 1, 0); PG8_STAGEA(PG8_SA(0, 1), a2, 1);
            PG8_WAIT_L(8); PG8_BAR; PG8_WAIT_L(0); PG8_MMA(0, 0, At, B0); PG8_BAR; PG8_SCHED;
            PG8_LDB(B1, 1, 1); PG8_STAGEB(PG8_SB(1, 0), b3);
            PG8_BAR; PG8_WAIT_L(0); PG8_MMA(0, 1, At, B1); PG8_BAR;
            PG8_LDA(At, 1, 1); PG8_STAGEA(PG8_SA(1, 0), a3, 0);
            PG8_BAR; PG8_WAIT_L(0); PG8_MMA(1, 0, At, B0); PG8_BAR; PG8_SCHED;
            PG8_STAGEB(PG8_SB(1, 1), b3 + hstep);
            PG8_WAIT_V(6); PG8_BAR; PG8_MMA(1, 1, At, B1); PG8_BAR;
        }
        E(acc, cur, wr, wc, fr, fq);
        if (!has_next) break;
#pragma unroll
        for (int a = 0; a < 2; ++a)
#pragma unroll
            for (int b = 0; b < 2; ++b)
#pragma unroll
                for (int m = 0; m < 4; ++m)
#pragma unroll
                    for (int n = 0; n < 2; ++n) acc[a][b][m][n] = (f4){0.f, 0.f, 0.f, 0.f};
        cur = nxt; cA = nA; cB = nB; ++ui;
    }
    PG8_WAIT_V(0);
    if (wr == 0) PG8_BAR;
    PG8_BAR;
#undef PG8_SA
#undef PG8_SB
#undef PG8_STAGE
#undef PG8_STAGEB
#undef PG8_STAGEA
#undef PG8_GOFF
#undef PG8_STAGEV
#undef PG8_LDA
#undef PG8_LDB
#undef PG8_MMA
#undef PG8_WAIT_V
#undef PG8_WAIT_L
#undef PG8_BAR
#undef PG8_SCHED
}
template <class FN> __device__ __forceinline__ void foreach_frag(const Acc& acc, int wr, int wc, int fr, int fq, FN fn) {
#pragma unroll
    for (int ai = 0; ai < 2; ++ai)
#pragma unroll
        for (int m = 0; m < 4; ++m)
        { int row = ai * HALF + wr * 64 + m * 16 + fr; asm volatile("" : "+v"(row));
#pragma unroll
            for (int bj = 0; bj < 2; ++bj)
#pragma unroll
                for (int n = 0; n < 2; ++n) fn(row, bj * HALF + wc * 32 + n * 16 + 4 * fq, acc[ai][bj][m][n]); }
}
template <class FN> __device__ __forceinline__ void foreach_frag8(const Acc& acc, int wr, int wc, int fr, int fq, FN fn) {
#pragma unroll
    for (int ai = 0; ai < 2; ++ai)
#pragma unroll
        for (int m = 0; m < 4; ++m)
        { int row = ai * HALF + wr * 64 + m * 16 + fr; asm volatile("" : "+v"(row));
#pragma unroll
            for (int bj = 0; bj < 2; ++bj) fn(row, bj * HALF + wc * 32 + 8 * fq, acc[ai][bj][m][0], acc[ai][bj][m][1]); }
}
template <class LD, class ST> __device__ __forceinline__ void foreach_frag2(const Acc& acc, int wr, int wc, int fr, int fq, LD ld, ST st) {
#pragma unroll
    for (int ai = 0; ai < 2; ++ai)
#pragma unroll
        for (int mp = 0; mp < 2; ++mp) {
            int row0 = ai * HALF + wr * 64 + mp * 32 + fr; asm volatile("" : "+v"(row0));
            decltype(ld(0, 0)) tmp[2][2][2];
#pragma unroll
            for (int mm = 0; mm < 2; ++mm)
#pragma unroll
                for (int bj = 0; bj < 2; ++bj)
#pragma unroll
                    for (int n = 0; n < 2; ++n) tmp[mm][bj][n] = ld(row0 + 16 * mm, bj * HALF + wc * 32 + n * 16 + 4 * fq);
#pragma unroll
            for (int mm = 0; mm < 2; ++mm)
#pragma unroll
                for (int bj = 0; bj < 2; ++bj)
#pragma unroll
                    for (int n = 0; n < 2; ++n) st(row0 + 16 * mm, bj * HALF + wc * 32 + n * 16 + 4 * fq, acc[ai][bj][2 * mp + mm][n], tmp[mm][bj][n]);
        }
}
template <class LD, class ST> __device__ __forceinline__ void foreach_frag2w(const Acc& acc, int wr, int wc, int fr, int fq, LD ld, ST st) {
#pragma unroll
    for (int ai = 0; ai < 2; ++ai) {
        int row0 = ai * HALF + wr * 64 + fr; asm volatile("" : "+v"(row0));
        decltype(ld(0, 0)) tmp[4][2][2];
#pragma unroll
        for (int m = 0; m < 4; ++m)
#pragma unroll
            for (int bj = 0; bj < 2; ++bj)
#pragma unroll
                for (int n = 0; n < 2; ++n) tmp[m][bj][n] = ld(row0 + 16 * m, bj * HALF + wc * 32 + n * 16 + 4 * fq);
#pragma unroll
        for (int m = 0; m < 4; ++m)
#pragma unroll
            for (int bj = 0; bj < 2; ++bj)
#pragma unroll
                for (int n = 0; n < 2; ++n) st(row0 + 16 * m, bj * HALF + wc * 32 + n * 16 + 4 * fq, acc[ai][bj][m][n], tmp[m][bj][n]);
    }
}
template <class FN> __device__ __forceinline__ void foreach_pair(const Acc& acc, int wr, int wc, int fr, int fq, FN fn) {
#pragma unroll
    for (int ai = 0; ai < 2; ++ai)
#pragma unroll
        for (int m = 0; m < 4; ++m)
        { int row = ai * HALF + wr * 64 + m * 16 + fr; asm volatile("" : "+v"(row));
#pragma unroll
            for (int bj = 0; bj < 2; ++bj) fn(row, bj * 64 + wc * 16 + 4 * fq, acc[ai][bj][m][0], acc[ai][bj][m][1]); }
}
}

__device__ __forceinline__ void ph_prologue(const Params& P) {
    const int tid = tid_(), G = gridDim.x, bid = bid_();
    float* cs = (float*)smem;
    float* red = cs + 5 * D;
    for (int i = tid; i < 5 * D; i += NTHREADS) { const int r = i / D, k = i % D; const float v = r < 4 ? pin(I_C)[r * D + k] : pin(I_CCTX)[k]; cs[i] = siluf_(v); }
    __syncthreads();
    const int lane = tid & 63, w = wid_of(tid);
    for (int t = bid; t < 2 * 96; t += G) {
        const int l = t / 96, n0 = (t % 96) * 128;
        const float* W = pin(I_MODW) + (size_t)l * D * (6 * D) + n0 + 2 * lane;
        float a[5][2];
#pragma unroll
        for (int r = 0; r < 5; ++r) { a[r][0] = 0.f; a[r][1] = 0.f; }
#pragma unroll 16
        for (int k = w * 256; k < w * 256 + 256; ++k) {
            const f2 wv = *(const f2*)(W + (size_t)k * (6 * D));
#pragma unroll
            for (int r = 0; r < 5; ++r) { const float c = cs[r * D + k]; a[r][0] += c * wv[0]; a[r][1] += c * wv[1]; }
        }
#pragma unroll
        for (int r = 0; r < 5; ++r) { red[(w * 5 + r) * 128 + 2 * lane] = a[r][0]; red[(w * 5 + r) * 128 + 2 * lane + 1] = a[r][1]; }
        __syncthreads();
        for (int i = tid; i < 5 * 128; i += NTHREADS) {
            const int r = i / 128, n = i % 128; float s = 0.f;
#pragma unroll
            for (int ww = 0; ww < 8; ++ww) s += red[(ww * 5 + r) * 128 + n];
            P.MOD()[((size_t)l * 5 + r) * (6 * D) + n0 + n] = s + pin(I_MODB)[(size_t)l * 6 * D + n0 + n];
        }
        __syncthreads();
    }
}

template <int KT = 1, class CF> __device__ __forceinline__ void convert_tile(half_t* dst, int K, int ld, int tn, int tk, CF colptr, int kmax = 1 << 30) {
    float* st = (float*)smem;
    const int tid = tid_(), n0 = tn * 64, k0 = tk * 64 * KT;
    {
        const int nl = tid & 63, kk = wid_of(tid); bool ok = true; const float* cp = colptr(n0 + nl, ok);
        float v[8 * KT];
#pragma unroll
        for (int i = 0; i < 8 * KT; ++i) { const int k = kk + 8 * i; const bool kin = (k0 + k) < kmax; v[i] = cp[(size_t)(kin ? k0 + k : 0) * ld]; v[i] = (ok && kin) ? v[i] : 0.f; }
#pragma unroll
        for (int i = 0; i < 8 * KT; ++i) st[(kk + 8 * i) * 65 + nl] = v[i];
    }
    __syncthreads();
    {
        const int nl = tid >> 3, kc = (tid & 7) * 8;
#pragma unroll
        for (int j = 0; j < KT; ++j) { h8 v;
#pragma unroll
            for (int i = 0; i < 8; ++i) v[i] = (half_t)st[(64 * j + kc + i) * 65 + nl];
            *(h8*)(dst + (size_t)(n0 + nl) * K + k0 + 64 * j + kc) = v; }
    }
    __syncthreads();
}
template <class CF> __device__ __forceinline__ void convert_wide(half_t* dst, int K, int ld, int tn, int tk, CF colptr4) {
    float* st = (float*)smem;
    const int tid = tid_(), n0 = tn * 256, k0 = tk * 64;
    {
        const int ng = (tid & 63) * 4, kk = wid_of(tid); bool ok = true; const float* cp = colptr4(n0 + ng, ok);
        f4 v[8];
#pragma unroll
        for (int i = 0; i < 8; ++i) { v[i] = *(const f4*)(cp + (size_t)(k0 + kk + 8 * i) * ld); if (!ok) v[i] = (f4){0.f, 0.f, 0.f, 0.f}; }
#pragma unroll
        for (int i = 0; i < 8; ++i) { const int k = kk + 8 * i; *(f4*)(st + k * 260 + (ng ^ (8 * ((k >> 3) & 3)))) = v[i]; }
    }
    __syncthreads();
#pragma unroll
    for (int j = 0; j < 4; ++j) { const int pidx = tid + NTHREADS * j, nl = pidx >> 3, kc = (pidx & 7) * 8, nsw = nl ^ (8 * ((kc >> 3) & 3)); h8 v;
#pragma unroll
        for (int i = 0; i < 8; ++i) v[i] = (half_t)st[(kc + i) * 260 + nsw];
        *(h8*)(dst + (size_t)(n0 + nl) * K + k0 + kc) = v; }
    __syncthreads();
}
namespace stp {
constexpr int T_WIN = (INPAD / 256) * (D / 64), T_PA = (D / 64) * (ADIM / 64), T_PB = T_PA, T_PC = (D / 64) * (CDIM / 64), T_WO = (D / 256) * (D / 64);
constexpr int T_LW = 2 * (ADIM / 64), T_LA = T_LW, T_LG = (ADIM / 64) * 2, T_LL = 2 * (BKEY / 64);
constexpr int T_GLU = (2 * CDIM / 64) * (CDIM / 64);
constexpr int T_ALL = T_WIN + T_PA + T_PB + T_PC + T_WO + T_GLU + T_LW + T_LA + T_LG + T_LL;
constexpr int QA = 1536, QB = 2304;
}
__device__ __forceinline__ void setup_task(const Params& P, int l_in, int t) {
    using namespace stp;
        int r = t, l = l_in; asm volatile("" : "+s"(l));
        if (r < T_WIN) { const float* src = pin(I_WIN) + (size_t)l * D * INSRC;
            convert_wide(P.WinT(), D, INSRC, r / (D / 64), r % (D / 64), [&](int n, bool& ok) -> const float* { ok = !(n >= 5536 && n < 5632); return src + (n < 5536 ? n : (n < 5632 ? 0 : n - 96)); }); return; } r -= T_WIN;
        if (r < T_PA) { const float* src = pin(I_PA) + (size_t)l * ADIM * D; convert_tile(P.PaT(), ADIM, D, r / (ADIM / 64), r % (ADIM / 64), [&](int n, bool&) -> const float* { return src + n; }); return; } r -= T_PA;
        if (r < T_PB) { const float* src = pin(I_PB) + (size_t)l * BDIM * D; convert_tile(P.PbT(), BDIM, D, r / (BDIM / 64), r % (BDIM / 64), [&](int n, bool&) -> const float* { return src + n; }); return; } r -= T_PB;
        if (r < T_PC) { const float* src = pin(I_PC) + (size_t)l * CDIM * D; convert_tile(P.PcT(), CDIM, D, r / (CDIM / 64), r % (CDIM / 64), [&](int n, bool&) -> const float* { return src + n; }); return; } r -= T_PC;
        if (r < T_LW) { const int d = r / (ADIM / 64); const float* src = pin(I_RKW2) + (size_t)(l * 2 + d) * 64 * ADIM; convert_tile(P.LW2T() + (size_t)d * ADIM * 64, 64, ADIM, r % (ADIM / 64), 0, [&](int n, bool&) -> const float* { return src + n; }); return; } r -= T_LW;
        if (r < T_LA) { const int d = r / (ADIM / 64); const float* src = pin(I_RKA2) + (size_t)(l * 2 + d) * 64 * ADIM; convert_tile(P.LA2T() + (size_t)d * ADIM * 64, 64, ADIM, r % (ADIM / 64), 0, [&](int n, bool&) -> const float* { return src + n; }); return; } r -= T_LA;
        if (r < T_LG) { const float* src = pin(I_RKG2) + (size_t)l * 128 * ADIM; convert_tile(P.LG2T(), 128, ADIM, r >> 1, r & 1, [&](int n, bool&) -> const float* { return src + n; }); return; } r -= T_LG;
        if (r < T_LL) { const int d = r / (BKEY / 64); const float* src = pin(I_GLAA2) + (size_t)(l * 2 + d) * 16 * BKEY; convert_tile(P.LGLT() + (size_t)d * BKEY * 64, 64, BKEY, r % (BKEY / 64), 0, [&](int n, bool&) -> const float* { return src + n; }, 16); return; } r -= T_LL;
        if (r < T_WO) { const float* src = pin(I_WOUT) + (size_t)l * D * D; convert_wide(P.WoT(), D, D, r / (D / 64), r % (D / 64), [&](int n, bool&) -> const float* { return src + n; }); return; } r -= T_WO;
        { const float* src = pin(I_S5GLU) + (size_t)l * CDIM * 2 * CDIM;
            convert_tile(P.GluT(), CDIM, 2 * CDIM, r / (CDIM / 64), r % (CDIM / 64),
                         [&](int n, bool&) -> const float* { const int j = n >> 5, wi = n & 31; return wi < 16 ? src + 16 * j + wi : src + CDIM + 16 * j + wi - 16; }); }
}
__device__ __forceinline__ void s5_matrix_task(const Params& P, int l, int g) {
    const int tid = tid_();
    float* apr = (float*)smem;
    float* api = apr + 2 * 17 * 64;
    float* bbr = api + 2 * 17 * 64;
    float* bbi = bbr + 2 * 64 * 16;
    float* cre = bbi + 2 * 64 * 16;
    float* cim = cre + 16 * 64;
    float* kern = cim + 16 * 64;
    {
        __syncthreads();
        for (int i = tid; i < 2 * 17 * 64; i += NTHREADS) {
            const int d = i / (17 * 64), tau = (i / 64) % 17, p = i % 64;
            const float lr = pin(I_S5LRE)[((l * 2 + d) * CGR + g) * CP + p], li = pin(I_S5LIM)[((l * 2 + d) * CGR + g) * CP + p];
            const float dt = expf(pin(I_S5LDT)[(l * 2 + d) * CGR + g]);
            const float mag = expf(lr * dt * (float)tau), ang = li * dt * (float)tau;
            apr[i] = mag * cosf(ang); api[i] = mag * sinf(ang);
        }
        for (int i = tid; i < 16 * 64; i += NTHREADS) { cre[i] = pin(I_S5CRE)[((size_t)l * CGR + g) * 16 * 64 + i]; cim[i] = pin(I_S5CIM)[((size_t)l * CGR + g) * 16 * 64 + i]; }
        __syncthreads();
        for (int i = tid; i < 2 * 64 * 16; i += NTHREADS) {
            const int d = i / (64 * 16), p = (i / 16) % 64, c = i % 16;
            const float lr = pin(I_S5LRE)[((l * 2 + d) * CGR + g) * CP + p], li = pin(I_S5LIM)[((l * 2 + d) * CGR + g) * CP + p];
            const float ar = apr[(d * 17 + 1) * 64 + p], ai = api[(d * 17 + 1) * 64 + p], den = lr * lr + li * li;
            const float fr = ((ar - 1.0f) * lr + ai * li) / den, fi = (ai * lr - (ar - 1.0f) * li) / den;
            const float br = pin(I_S5BRE)[(((size_t)l * CGR + g) * CP + p) * 16 + c], bi = pin(I_S5BIM)[(((size_t)l * CGR + g) * CP + p) * 16 + c];
            bbr[i] = fr * br - fi * bi; bbi[i] = fr * bi + fi * br;
        }
        __syncthreads();
        for (int i = tid; i < 2 * 16 * 16 * 16; i += NTHREADS) {
            const int d = i >> 12, tau = (i >> 8) & 15, c = (i >> 4) & 15, c2 = i & 15; float s = 0.f;
            for (int p = 0; p < 64; ++p) {
                const float ar = apr[(d * 17 + tau) * 64 + p], ai = api[(d * 17 + tau) * 64 + p], br = bbr[(d * 64 + p) * 16 + c2], bi = bbi[(d * 64 + p) * 16 + c2];
                const float er = ar * br - ai * bi, ei = ar * bi + ai * br;
                s += cre[c * 64 + p] * er - cim[c * 64 + p] * ei;
            }
            kern[i] = s;
        }
        __syncthreads();
        half_t* Mst = P.MstT() + (size_t)g * 256 * 256; half_t* Mcat = P.McatT() + (size_t)g * 256 * 512;
        for (int i = tid; i < 256 * 256; i += NTHREADS) {
            const int n = i >> 8, k = i & 255, d = n >> 7, q = n & 127, p = q & 63, tau = k >> 4, c2 = k & 15;
            const int pw = d ? tau : 15 - tau;
            const float ar = apr[(d * 17 + pw) * 64 + p], ai = api[(d * 17 + pw) * 64 + p], br = bbr[(d * 64 + p) * 16 + c2], bi = bbi[(d * 64 + p) * 16 + c2];
            Mst[i] = (half_t)(q < 64 ? ar * br - ai * bi : ar * bi + ai * br);
        }
        for (int i = tid; i < 256 * 512; i += NTHREADS) {
            const int n = i >> 9, k = i & 511, tau = n >> 4, c = n & 15; float v;
            if (k < 256) { const int t2 = k >> 4, c2 = k & 15; v = 0.f;
                if (t2 <= tau) v += kern[((0 * 16 + (tau - t2)) * 16 + c) * 16 + c2];
                if (t2 >= tau) v += kern[((1 * 16 + (t2 - tau)) * 16 + c) * 16 + c2];
            } else { const int kk = k - 256, d = kk >> 7, q = kk & 127, p = q & 63, pw = d ? 16 - tau : tau + 1;
                const float ar = apr[(d * 17 + pw) * 64 + p], ai = api[(d * 17 + pw) * 64 + p];
                v = q < 64 ? cre[c * 64 + p] * ar - cim[c * 64 + p] * ai : -(cre[c * 64 + p] * ai + cim[c * 64 + p] * ar);
            }
            Mcat[i] = (half_t)v;
        }
    }
    __syncthreads();
}
__device__ __forceinline__ void ph_setup(const Params& P, int l) {
    using namespace stp;
    const int G = gridDim.x, bid = bid_(), tid = tid_();
    const bool s5blk = (G == 256) && bid >= 224; const int sb = bid - 224;
    const int t_first = (G != 256) ? bid : (s5blk ? 224 + (sb % 24) + 248 * (sb / 24) : bid), t_step = (G != 256) ? G : 248;
    for (int tq = t_first, qi = sb; tq < T_ALL; ) {
        const int t = tq;
        if (s5blk) { qi += 32; tq = 248 * (qi / 24) + 224 + (qi % 24); } else tq += t_step;
        setup_task(P, l, t);
    }
    for (int g = (G == 256) ? sb : bid; g >= 0 && g < CGR; g += (G == 256) ? CGR : G) s5_matrix_task(P, l, g);
    if (bid == 0 && tid < 64) { P.cnt()[tid] = 0; }
}
__device__ __forceinline__ void ph_setup_queue(const Params& P, int l, int qn, int q_begin, int q_end) {
    int* head = P.cnt() + 32 + qn; int* slot = (int*)(smem + 131072 + 1024);
    for (;;) {
        __syncthreads();
        if (tid_() == 0) *slot = q_begin + atomicAdd(head, 4);
        __syncthreads();
        const int t0 = *slot;
        if (t0 >= q_end) break;
#pragma unroll 1
        for (int q = 0; q < 4; ++q) { const int r = t0 + q; if (r >= q_end) break; setup_task(P, l, r); }
    }
}
__device__ __forceinline__ void ph_setup_rest(const Params& P, int l) {
    ph_setup_queue(P, l, 5, stp::QB, stp::T_ALL);
    if (bid_() == 0 && (tid_() < 35 || tid_() == 38)) { P.cnt()[tid_()] = 0; }
}
__device__ __forceinline__ void ph_setup_s5_next(const Params& P, int l) {
    const int G = gridDim.x, bid = bid_();
    if (G >= 64) { const int g = bid - (G - CGR); if (g >= 0) s5_matrix_task(P, l, g); }
    else for (int g = bid; g < CGR; g += G) s5_matrix_task(P, l, g);
}
__device__ __forceinline__ void moe_convert_task(const Params& P, int l, int r) {
    constexpr int T_W13 = NE * (2 * DE / 256) * (D / 64);
    if (r < T_W13) { const int e = r / ((2 * DE / 256) * (D / 64)), rr = r % ((2 * DE / 256) * (D / 64));
        const float* s1 = pin(I_W1) + ((size_t)l * NE + e) * D * DE; const float* s3 = pin(I_W3) + ((size_t)l * NE + e) * D * DE;
        convert_wide(P.W13T() + (size_t)e * 2 * DE * D, D, DE, rr / (D / 64), rr % (D / 64),
                     [&](int n, bool&) -> const float* { const int j = n >> 5, wi = n & 31; return wi < 16 ? s1 + 16 * j + wi : s3 + 16 * j + wi - 16; }); }
    else { r -= T_W13; const int e = r / ((D / 256) * (DE / 64)), rr = r % ((D / 256) * (DE / 64)); const float* src = pin(I_W2) + ((size_t)l * NE + e) * DE * D;
        convert_wide(P.W2T() + (size_t)e * D * DE, DE, D, rr / (DE / 64), rr % (DE / 64), [&](int n, bool&) -> const float* { return src + n; }); }
}
__device__ __forceinline__ void ph_moe_convert(const Params& P, int l, int qn, int t_begin, int t_end) {
    int* head = P.cnt() + 32 + qn; int* slot = (int*)(smem + 131072 + 1024);
    const int lim = t_end;
    for (;;) {
        __syncthreads();
        if (tid_() == 0) *slot = t_begin + atomicAdd(head, 3);
        __syncthreads();
        const int t0 = *slot;
        if (t0 >= lim) break;
#pragma unroll 1
        for (int q = 0; q < 3; ++q) { const int r = t0 + q; if (r >= lim) break; moe_convert_task(P, l, r); }
    }
}
__device__ __forceinline__ void ph_moe_convert_static(const Params& P, int l, int t_begin, int t_end, int idx, int n) {
#pragma unroll 1
    for (int r = t_begin + idx; r < t_end; r += n) { __syncthreads(); moe_convert_task(P, l, r); }
}
template <int MODE> __device__ __forceinline__ void ph_rows(const Params& P, int l) {
    const int lane = tid_() & 63, gw = bid_() * 8 + wid_of(tid_()), NW = gridDim.x * 8;
    const int nrows = MODE == 2 ? RL : MT;
    const float* gvec = MODE == 2 ? pin(I_FG) : pin(I_N1G) + (size_t)l * D;
    for (int row = gw; row < nrows; row += NW) {
        float* xr = xrow_ptr(P, row); const float* xs = MODE == 0 ? xsrc_ptr(P, row, 0) : xr; const int mr = modrow_of(row);
        f4 v[8]; float ss = 0.f;
#pragma unroll
        for (int j = 0; j < 8; ++j) v[j] = *(const f4*)(xs + (j * 64 + lane) * 4);
        if (MODE >= 1) {
            const int lp = MODE == 2 ? 1 : l - 1;
            const float* ga2 = P.MOD() + ((size_t)lp * 5 + mr) * (6 * D) + 5 * D;
            const int p0 = P.pos()[row * 2], p1 = P.pos()[row * 2 + 1]; const float w0 = P.wsel()[row * 2], w1 = P.wsel()[row * 2 + 1];
            const half_t* y0 = P.Y() + (size_t)p0 * D; const half_t* y1 = P.Y() + (size_t)p1 * D;
#pragma unroll
            for (int j = 0; j < 8; ++j) {
                const int c = (j * 64 + lane) * 4; const h4 a = *(const h4*)(y0 + c), b = *(const h4*)(y1 + c); const f4 g = *(const f4*)(ga2 + c);
#pragma unroll
                for (int i = 0; i < 4; ++i) v[j][i] += g[i] * (w0 * (float)a[i] + w1 * (float)b[i]);
            }
            if (MODE == 1) {
#pragma unroll
                for (int j = 0; j < 8; ++j) *(f4*)(xr + (j * 64 + lane) * 4) = v[j];
            }
        }
#pragma unroll
        for (int j = 0; j < 8; ++j) ss += (v[j][0] * v[j][0] + v[j][1] * v[j][1]) + (v[j][2] * v[j][2] + v[j][3] * v[j][3]);
        ss = wave_sum(ss);
        const float rstd = rsqrtf(ss * (1.0f / D) + 1e-6f);
        if (MODE == 2) {
            const float* fg = gvec;
#pragma unroll
            for (int j = 0; j < 8; ++j) { const int c = (j * 64 + lane) * 4; const f4 g = *(const f4*)(fg + c); f4 o;
#pragma unroll
                for (int i = 0; i < 4; ++i) o[i] = v[j][i] * rstd * g[i];
                *(f4*)(xr + c) = o; }
        } else {
            const float* ng = gvec; const float* sh = P.MOD() + ((size_t)l * 5 + mr) * (6 * D); const float* sc = sh + D;
            half_t* hr = P.H() + (size_t)row * D;
#pragma unroll
            for (int j = 0; j < 8; ++j) { const int c = (j * 64 + lane) * 4; const f4 g = *(const f4*)(ng + c), s1 = *(const f4*)(sc + c), s0 = *(const f4*)(sh + c); f4 o;
#pragma unroll
                for (int i = 0; i < 4; ++i) o[i] = v[j][i] * rstd * g[i] * (1.0f + s1[i]) + s0[i];
                *(h4*)(hr + c) = to_h4(o); }
        }
    }
}

struct SchedDense {
    pg8::TileOrder T; const char* A; const char* B; size_t tstepA, tstepB;
    __device__ __forceinline__ bool next(int i, pg8::Unit& u) const { int pm, pn; if (!T.tile(i, pm, pn)) return false; u.pm = pm; u.pn = pn; u.A = A + (size_t)pm * tstepA; u.B = B + (size_t)pn * tstepB; return true; }
};
template <int PART> __device__ __forceinline__ void ph_inproj(const Params& P, int c, int G, int lim = 1 << 30, int mrows = MT) {
    constexpr int NT0 = (CONV + NLO) / 256, NT1 = NGT / 256, NTOFF = PART ? NT0 : 0;
    SchedDense S; S.T.init(mrows / 256, PART ? NT1 : NT0, G, c, lim); S.A = (const char*)P.H(); S.B = (const char*)(P.WinT() + (size_t)NTOFF * 256 * D); S.tstepA = (size_t)256 * D * 2; S.tstepB = (size_t)256 * D * 2;
    pg8::gemm_phase<true>(D, S, [&](const pg8::Acc& acc, const pg8::Unit& u, int wr, int wc, int fr, int fq) {
        const int m0 = u.pm * 256, n0 = (u.pn + NTOFF) * 256;
        auto st8 = [](half_t* p, f4 a, f4 b) { const h4 x = to_h4(a), y = to_h4(b); h8 o; for (int i = 0; i < 4; ++i) { o[i] = x[i]; o[4 + i] = y[i]; } *(h8*)p = o; };
        if (PART) pg8::foreach_frag8(acc, wr, wc, fr, fq, [&](int m, int n, f4 a, f4 b) { for (int i = 0; i < 4; ++i) { a[i] = sigmoidf_(a[i]); b[i] = sigmoidf_(b[i]); } st8(P.Pg() + (size_t)(m0 + m) * NGT + (n0 - CONV - NLO) + n, a, b); });
        else if (n0 < CONV) pg8::foreach_frag8(acc, wr, wc, fr, fq, [&](int m, int n, f4 a, f4 b) { st8(P.Pconv() + (size_t)(m0 + m) * CONV + n0 + n, a, b); });
        else pg8::foreach_frag8(acc, wr, wc, fr, fq, [&](int m, int n, f4 a, f4 b) { st8(P.Plo() + (size_t)(m0 + m) * NLO + (n0 - CONV) + n, a, b); });
    });
}

__device__ __forceinline__ void ph_convf(const Params& P, int l) {
    const int tid = tid_();
    const float* cw = pin(I_CONVW) + (size_t)l * 9 * CONV;
    for (int it = bid_(); it < MT / 16; it += gridDim.x) {
        const int row0 = it * 16;
        int rows, cols, gi, gj0, base;
        if (row0 < RL) { const int t = row0 & (SEQ - 1); rows = 64; cols = 64; gi = t >> 6; gj0 = t & 63; base = row0 - t; }
        else { const int t = (row0 - RL) & (CTXL - 1); rows = 1; cols = CTXL; gi = 0; gj0 = t; base = row0 - t; }
        __syncthreads();
#pragma unroll 1
        for (int rnd = 0; rnd < 2; ++rnd) {
            const int c0 = (tid + NTHREADS * rnd) * 4;
            if (c0 < CONV) {
                float wt[3][3][4];
#pragma unroll
                for (int u = 0; u < 3; ++u)
#pragma unroll
                    for (int v = 0; v < 3; ++v) { const f4 a = *(const f4*)(cw + (u * 3 + v) * CONV + c0);
#pragma unroll
                        for (int i = 0; i < 4; ++i) wt[u][v][i] = a[i]; }
                h4 win[3][3];
                const h4 hz = {0, 0, 0, 0};
                auto ldp = [&](int u, int j) -> h4 { const int gr = gi + u - 1; if (gr < 0 || gr >= rows || j < 0 || j >= cols) return hz; return *(const h4*)(P.Pconv() + (size_t)(base + gr * cols + j) * CONV + c0); };
#pragma unroll
                for (int u = 0; u < 3; ++u) { win[u][0] = ldp(u, gj0 - 1); win[u][1] = ldp(u, gj0); }
                const bool is_k = (c0 >= ADIM && c0 < 2 * ADIM);
                f4 kkw = (f4){0.f, 0.f, 0.f, 0.f};
                if (is_k) kkw = *(const f4*)(pin(I_RKKK) + l * ADIM + c0 - ADIM);
#pragma unroll 1
                for (int jb = 0; jb < 16; jb += 4) {
                    h4 nw[3][4];
#pragma unroll
                    for (int e = 0; e < 4; ++e)
#pragma unroll
                        for (int u = 0; u < 3; ++u) nw[u][e] = ldp(u, gj0 + jb + e + 1);
                    f4 ov[4], qv[4];
#pragma unroll
                    for (int e = 0; e < 4; ++e) {
#pragma unroll
                        for (int u = 0; u < 3; ++u) win[u][2] = nw[u][e];
                        f4 o = (f4){0.f, 0.f, 0.f, 0.f};
#pragma unroll
                        for (int u = 0; u < 3; ++u)
#pragma unroll
                            for (int v = 0; v < 3; ++v)
#pragma unroll
                                for (int i = 0; i < 4; ++i) o[i] += (float)win[u][v][i] * wt[u][v][i];
                        ov[e] = o;
                        {
                            f4 q; float sq = 0.f;
#pragma unroll
                            for (int i = 0; i < 4; ++i) { q[i] = o[i] * kkw[i]; sq += q[i] * q[i]; }
                            sq = red16(sq);
                            const float inv = rsqrtf(sq + 1e-12f);
#pragma unroll
                            for (int i = 0; i < 4; ++i) q[i] *= inv;
                            qv[e] = q;
                        }
#pragma unroll
                        for (int u = 0; u < 3; ++u) { win[u][0] = win[u][1]; win[u][1] = win[u][2]; }
                    }
#pragma unroll
                    for (int e = 0; e < 4; ++e) { *(h4*)(P.F() + (size_t)(row0 + jb + e) * CONV + c0) = to_h4(ov[e]);
                        if (is_k) *(h4*)(P.KK() + (size_t)(row0 + jb + e) * ADIM + c0 - ADIM) = to_h4(qv[e]); }
                }
            }
        }
    }
}

__device__ __forceinline__ uint4 tanh8(uint4 x) { h8 v = __builtin_bit_cast(h8, x);
#pragma unroll
    for (int i = 0; i < 8; ++i) v[i] = (half_t)tanhf((float)v[i]);
    return __builtin_bit_cast(uint4, v); }
__device__ __forceinline__ uint4 sigm8(uint4 x) { h8 v = __builtin_bit_cast(h8, x);
#pragma unroll
    for (int i = 0; i < 8; ++i) v[i] = (half_t)sigmoidf_((float)v[i]);
    return __builtin_bit_cast(uint4, v); }
__device__ __forceinline__ void ph_lora(const Params& P, int l, int first, int stride) {
    constexpr int NTM = MT / 128;
    half_t* As = (half_t*)smem; half_t* Bs = As + 128 * GST;
    const int tid = tid_(), lane = tid & 63, w = wid_of(tid), wm = w >> 2, wn = w & 3, pr0 = tid >> 3, pk = (tid & 7) * 8;
    for (int u = first; u < 6 * NTM; u += stride) {
        const int kind = u / NTM, tm = u - kind * NTM, m0 = tm * 128, d = kind & 1, cls = kind >> 1;
        const int ncol = cls == 2 ? BKEY : ADIM, nnt = ncol / 128;
        const half_t* A = P.Plo() + (size_t)m0 * NLO + (cls == 0 ? LO_DW + d * 64 : (cls == 1 ? LO_DA + d * 64 : LO_BG + d * 16));
        const half_t* B = (cls == 0 ? P.LW2T() : (cls == 1 ? P.LA2T() : P.LGLT())) + (size_t)d * ncol * 64;
        const float* bw = pin(I_RKW0); const float* ba = pin(I_RKA0); const float* bg = pin(I_GLAAB);
        const float* bias = (cls == 0 ? bw : (cls == 1 ? ba : bg)) + (l * 2 + d) * ncol;
        half_t* O = (cls == 0 ? P.SW() : (cls == 1 ? P.AA() : P.GG())) + ((size_t)d * MT + m0) * ncol;
        uint4 ra[2], rb[2];
#pragma unroll
        for (int i = 0; i < 2; ++i) { uint4 x = (cls == 2 && pk >= 16) ? zero16() : ld16(A + (size_t)(pr0 + 64 * i) * NLO + pk); if (cls == 0) x = tanh8(x); ra[i] = x; rb[i] = ld16(B + (size_t)(pr0 + 64 * i) * 64 + pk); }
        __syncthreads();
#pragma unroll
        for (int i = 0; i < 2; ++i) *(uint4*)(As + (pr0 + 64 * i) * GST + pk) = ra[i];
        for (int nt = 0; nt < nnt; ++nt) {
            half_t* Bc = Bs + (nt & 1) * 128 * GST;
#pragma unroll
            for (int i = 0; i < 2; ++i) *(uint4*)(Bc + (pr0 + 64 * i) * GST + pk) = rb[i];
            if (nt + 1 < nnt) {
#pragma unroll
                for (int i = 0; i < 2; ++i) rb[i] = ld16(B + (size_t)((nt + 1) * 128 + pr0 + 64 * i) * 64 + pk); }
            const f4 bb0 = *(const f4*)(bias + nt * 128 + 32 * wn + 4 * (lane >> 4)), bb1 = *(const f4*)(bias + nt * 128 + 32 * wn + 16 + 4 * (lane >> 4));
            __syncthreads();
            f4 acc[4][2]; acc_zero(acc);
#pragma unroll
            for (int ks = 0; ks < 2; ++ks) {
                h8 af[4], bf[2];
#pragma unroll
                for (int mi = 0; mi < 4; ++mi) af[mi] = *(const h8*)(As + (64 * wm + 16 * mi + (lane & 15)) * GST + 32 * ks + 8 * (lane >> 4));
#pragma unroll
                for (int ni = 0; ni < 2; ++ni) bf[ni] = *(const h8*)(Bc + (32 * wn + 16 * ni + (lane & 15)) * GST + 32 * ks + 8 * (lane >> 4));
#pragma unroll
                for (int mi = 0; mi < 4; ++mi)
#pragma unroll
                    for (int ni = 0; ni < 2; ++ni) acc[mi][ni] = __builtin_amdgcn_mfma_f32_16x16x32_f16(bf[ni], af[mi], acc[mi][ni], 0, 0, 0);
            }
#pragma unroll
            for (int mi = 0; mi < 4; ++mi)
#pragma unroll
                for (int ni = 0; ni < 2; ++ni) { const f4 bb = ni ? bb1 : bb0; const int m = 64 * wm + 16 * mi + (lane & 15), n = nt * 128 + 32 * wn + 16 * ni + 4 * (lane >> 4); f4 o;
#pragma unroll
                    for (int i = 0; i < 4; ++i) { const float x = acc[mi][ni][i] + bb[i]; o[i] = cls == 2 ? (fminf(x, 0.f) - log1pf(__expf(-fabsf(x)))) * (1.0f / 16.0f) : sigmoidf_(x); }
                    *(h4*)(O + (size_t)m * ncol + n) = to_h4(o); }
        }
    }
    __syncthreads();
}

__device__ __forceinline__ h8 ldfrag(const half_t* base, int stride, int row0, int red0, int lane) { return *(const h8*)(base + (row0 + (lane & 15)) * stride + red0 + 8 * (lane >> 4)); }
__device__ __forceinline__ half_t clamp_h(float x) { return (half_t)__builtin_amdgcn_fmed3f(x, -60000.f, 60000.f); }
__device__ __forceinline__ f4 mma16(h8 x, h8 y, f4 c) { return __builtin_amdgcn_mfma_f32_16x16x32_f16(x, y, c, 0, 0, 0); }
__device__ __forceinline__ void ph_rwkv(const Params& P, int l, int first_item, int stride) {
    constexpr int CH = 32, SK = 72, ST = 40;
    const int tid = tid_(), lane = tid & 63, w = wid_of(tid), q = lane >> 4, i16 = lane & 15;
    half_t* Kt = (half_t*)smem; half_t* Rt = Kt + CH * SK; half_t* Bt = Rt + CH * SK; half_t* Dt = Bt + CH * SK; half_t* Wm = Dt + CH * SK; half_t* HTs = Wm + CH * SK;
    half_t* KtT = HTs + 64 * SK; half_t* DhT = KtT + 64 * ST; half_t* BhTn = DhT + 64 * ST; half_t* VT = BhTn + 64 * ST; half_t* UT = VT + 64 * ST; half_t* G1T = UT + 64 * ST;
    half_t* Akd = G1T + 64 * ST; half_t* Ard = Akd + CH * ST; half_t* Arbn = Ard + CH * ST;
    half_t* Pn0 = Arbn + CH * ST; half_t* Pn1 = Pn0 + CH * ST; half_t* PT0 = Pn1 + CH * ST; half_t* PT1 = PT0 + CH * ST; half_t* Tn0 = PT1 + CH * ST; half_t* Tn1 = Tn0 + CH * ST;
    float* Lc = (float*)(Tn1 + CH * ST);
    float* segt = Lc + CH * 64;
    float* gC = segt + 8 * 64; float* gref = gC + 64; float* bonus = gref + 64; float* Yb = bonus + 128;
    for (int item = first_item; item < 2 * NBATCH * AH; item += stride) {
        const int d = item / (NBATCH * AH), b = (item / AH) % NBATCH, h = item % AH;
        const half_t* SWd = P.SW() + (size_t)d * MT * ADIM + h * 64; const half_t* AAd = P.AA() + (size_t)d * MT * ADIM + h * 64; half_t* Zd = P.Z() + (size_t)d * MT * ADIM + h * 64;
        const half_t* Fh = P.F() + h * 64; const half_t* KKh = P.KK() + h * 64;
        const float* kap = pin(I_RKKA) + l * ADIM + h * 64; const float* rkp = pin(I_RKRK) + l * ADIM + h * 64;
        const float* gnw = pin(I_RKGNW) + l * ADIM + h * 64; const float* gnb = pin(I_RKGNB) + l * ADIM + h * 64;
        const int ck = tid & 63, seg = w;
        const float ka_c = kap[ck], rk_c = rkp[ck];
        f4 accH[2];
        accH[0] = (f4){0.f, 0.f, 0.f, 0.f}; accH[1] = (f4){0.f, 0.f, 0.f, 0.f};
        unsigned pr[4], pk[4], pv[4], pkk[4], psw[4], pa[4];
        auto ldu = [](const half_t* p) -> unsigned { return (unsigned)*(const unsigned short*)p; };
        auto h2f = [](unsigned u) -> float { return (float)__builtin_bit_cast(half_t, (unsigned short)u); };
        auto prefetch = [&](int s0) {
#pragma unroll
            for (int i = 0; i < 4; ++i) { const int row = __builtin_amdgcn_readfirstlane(tokrow(d, b, s0 + 4 * seg + i)); const half_t* f = Fh + (size_t)row * CONV + ck;
                pr[i] = ldu(f); pk[i] = ldu(f + ADIM); pv[i] = ldu(f + 2 * ADIM); pkk[i] = ldu(KKh + (size_t)row * ADIM + ck); psw[i] = ldu(SWd + (size_t)row * ADIM + ck); pa[i] = ldu(AAd + (size_t)row * ADIM + ck); }
        };
        prefetch(0);
        for (int s0 = 0; s0 < TS; s0 += CH) {
            float rr[4], kdv[4], bb[4], kkv[4], vv[4], Lv[4];
            { float run = 0.f;
#pragma unroll
              for (int i = 0; i < 4; ++i) { const float a = h2f(pa[i]), kk = h2f(pkk[i]), k = h2f(pk[i]);
                  rr[i] = h2f(pr[i]); vv[i] = h2f(pv[i]); kkv[i] = kk; kdv[i] = k * (1.0f + (a - 1.0f) * ka_c); bb[i] = kk * a; run += -0.6065306597126334f * h2f(psw[i]); Lv[i] = run; } }
            lds_barrier();
            segt[seg * 64 + ck] = Lv[3];
            if (s0 + CH < TS) prefetch(s0 + CH);
            lds_barrier();
            { float off = 0.f;
#pragma unroll
              for (int sg = 0; sg < 7; ++sg) off += segt[sg * 64 + ck] * (sg < seg ? 1.0f : 0.0f);
#pragma unroll
              for (int i = 0; i < 4; ++i) { Lv[i] += off; Lc[(4 * seg + i) * 64 + ck] = Lv[i]; }
              { const float v0 = rr[0] * kdv[0] * rk_c, v1 = rr[1] * kdv[1] * rk_c, v2 = rr[2] * kdv[2] * rk_c, v3 = rr[3] * kdv[3] * rk_c;
                const bool o1 = lane & 1, o2 = lane & 2;
                const float s01 = (o1 ? v1 : v0) + dpp_f<0xB1>(o1 ? v0 : v1), s23 = (o1 ? v3 : v2) + dpp_f<0xB1>(o1 ? v2 : v3);
                float sv = (o2 ? s23 : s01) + dpp_f<0x4E>(o2 ? s01 : s23);
                sv += dpp_f<0x124>(sv); sv += dpp_f<0x128>(sv);
                if (i16 < 4) bonus[(4 * seg + i16) * 4 + q] = sv; }
            }
            lds_barrier();
            { const float Lref = Lc[15 * 64 + ck], L31 = Lc[31 * 64 + ck];
              if (seg == 0) { gC[ck] = __expf(L31); gref[ck] = __expf(Lref); }
              h4 ktp, dhp, bhp, vtp;
              const float c3 = __expf(L31 - Lref); float eprev = __expf(((seg == 0) ? 0.f : Lc[(4 * seg - 1) * 64 + ck]) - Lref);
#pragma unroll
              for (int i = 0; i < 4; ++i) { const int t = 4 * seg + i; const float Lt = Lv[i];
                  const float ep = eprev, et = __expf(Lt - Lref), er = __builtin_amdgcn_rcpf(et), e3 = c3 * er; eprev = et;
                  const half_t ktv = (half_t)(kkv[i] * ep);
                  Kt[t * SK + ck] = ktv; ktp[i] = ktv; Rt[t * SK + ck] = clamp_h(rr[i] * et); Bt[t * SK + ck] = (half_t)(bb[i] * er); Dt[t * SK + ck] = clamp_h(kdv[i] * er);
                  dhp[i] = (half_t)(kdv[i] * e3); bhp[i] = (half_t)(-bb[i] * e3); vtp[i] = (half_t)vv[i]; }
              *(h4*)(KtT + ck * ST + 4 * seg) = ktp; *(h4*)(DhT + ck * ST + 4 * seg) = dhp; *(h4*)(BhTn + ck * ST + 4 * seg) = bhp; *(h4*)(VT + ck * ST + 4 * seg) = vtp;
            }
            lds_barrier();
#pragma unroll
            for (int x = 0; x < 2; ++x) { const int id = 2 * w + x, kt = id >> 2, vt = id & 3, k0 = kt * 16 + 4 * q; h4 hv;
#pragma unroll
                for (int r = 0; r < 4; ++r) hv[r] = (half_t)(accH[x][r] * gref[k0 + r]);
                *(h4*)(HTs + (vt * 16 + i16) * SK + k0) = hv; }
            for (int rwrep = 0; rwrep < RWKV_REP; ++rwrep) {
            {   const int mat = w >> 1, tt = w & 1, incl = (mat >> 1) & 1;
                const half_t* X = (mat & 1) ? Dt : Bt; const half_t* Yp = (mat & 2) ? Rt : Kt; const float sgn = mat == 2 ? -1.0f : 1.0f;
                half_t* dst = mat == 0 ? Pn0 : (mat == 1 ? Akd : (mat == 2 ? Arbn : Ard));
                const h8 y0 = ldfrag(Yp, SK, tt * 16, 0, lane), y1 = ldfrag(Yp, SK, tt * 16, 32, lane);
                const int t = tt * 16 + i16;
#pragma unroll
                for (int ts = 0; ts < 2; ++ts) {
                    f4 acc = mma16(ldfrag(X, SK, ts * 16, 0, lane), y0, (f4){0.f, 0.f, 0.f, 0.f}); acc = mma16(ldfrag(X, SK, ts * 16, 32, lane), y1, acc);
                    const int sb = ts * 16 + 4 * q; h4 av;
#pragma unroll
                    for (int r = 0; r < 4; ++r) av[r] = (half_t)(sgn * __builtin_amdgcn_fmed3f((sb + r < t + incl) ? acc[r] : 0.f, -60000.f, 60000.f));
                    *(h4*)(dst + t * ST + sb) = av;
                    if (mat == 0) { h4 tv;
#pragma unroll
                        for (int r = 0; r < 4; ++r) { PT0[(sb + r) * ST + t] = av[r]; tv[r] = (half_t)(((sb + r == t) ? 1.0f : 0.f) - (float)av[r]); }
                        *(h4*)(Tn0 + t * ST + sb) = tv; }
                }
            }
            lds_barrier();
            {   half_t* Pc = Pn0; half_t* PTc = PT0; half_t* Pq = Pn1; half_t* PTq = PT1; half_t* Tc = Tn0; half_t* Tq = Tn1;
                const int tl = w & 3, t0 = (tl >> 1) * 16, c0 = (tl & 1) * 16;
#pragma unroll
                for (int lev = 0; lev < 5; ++lev) {
                    if (w >= 4) {
                        if (lev < 4) {
                            f4 acc = mma16(ldfrag(Pc, ST, t0, 0, lane), ldfrag(PTc, ST, c0, 0, lane), (f4){0.f, 0.f, 0.f, 0.f});
                            const int tb = t0 + 4 * q, sc = c0 + i16; h4 pv4;
#pragma unroll
                            for (int r = 0; r < 4; ++r) { pv4[r] = (half_t)acc[r]; Pq[(tb + r) * ST + sc] = pv4[r]; }
                            *(h4*)(PTq + sc * ST + tb) = pv4;
                        }
                    } else if (lev > 0) {
                        f4 acc = mma16(ldfrag(Tc, ST, t0, 0, lane), ldfrag(PTc, ST, c0, 0, lane), (f4){0.f, 0.f, 0.f, 0.f});
                        const int tb = t0 + 4 * q, sc = c0 + i16;
#pragma unroll
                        for (int r = 0; r < 4; ++r) Tq[(tb + r) * ST + sc] = (half_t)(acc[r] + (float)Tc[(tb + r) * ST + sc]);
                    }
                    lds_barrier();
                    if (lev < 4) { half_t* tp = Pc; Pc = Pq; Pq = tp; tp = PTc; PTc = PTq; PTq = tp; }
                    if (lev > 0) { half_t* tp = Tc; Tc = Tq; Tq = tp; }
                }
                {   const int kt = w >> 1, tt = w & 1;
                    f4 acc = mma16(ldfrag(KtT, ST, kt * 16, 0, lane), ldfrag(Tc, ST, tt * 16, 0, lane), (f4){0.f, 0.f, 0.f, 0.f});
                    h4 wv;
#pragma unroll
                    for (int r = 0; r < 4; ++r) wv[r] = (half_t)__builtin_amdgcn_fmed3f(acc[r], -60000.f, 60000.f);
                    *(h4*)(Wm + (tt * 16 + i16) * SK + kt * 16 + 4 * q) = wv;
                    const int t2 = w >> 2, vt = w & 3;
                    f4 acc2 = mma16(ldfrag(Akd, ST, t2 * 16, 0, lane), ldfrag(VT, ST, vt * 16, 0, lane), (f4){0.f, 0.f, 0.f, 0.f});
                    h4 gv;
#pragma unroll
                    for (int r = 0; r < 4; ++r) gv[r] = (half_t)__builtin_amdgcn_fmed3f(acc2[r], -60000.f, 60000.f);
                    *(h4*)(G1T + (vt * 16 + i16) * ST + t2 * 16 + 4 * q) = gv;
                }
                lds_barrier();
                {   const int t2 = w >> 2, vt = w & 3;
                    f4 acc = mma16(ldfrag(Tc, ST, t2 * 16, 0, lane), ldfrag(G1T, ST, vt * 16, 0, lane), (f4){0.f, 0.f, 0.f, 0.f});
#pragma unroll
                    for (int ks = 0; ks < 2; ++ks) acc = mma16(ldfrag(Wm, SK, t2 * 16, ks * 32, lane), ldfrag(HTs, SK, vt * 16, ks * 32, lane), acc);
                    h4 uv;
#pragma unroll
                    for (int r = 0; r < 4; ++r) uv[r] = (half_t)__builtin_amdgcn_fmed3f(acc[r], -60000.f, 60000.f);
                    *(h4*)(UT + (vt * 16 + i16) * ST + t2 * 16 + 4 * q) = uv;
                }
            }
            lds_barrier();
            }
            {   const int vt = w >> 1, tt = w & 1;
                f4 acc = (f4){0.f, 0.f, 0.f, 0.f};
#pragma unroll
                for (int ks = 0; ks < 2; ++ks) acc = mma16(ldfrag(HTs, SK, vt * 16, ks * 32, lane), ldfrag(Rt, SK, tt * 16, ks * 32, lane), acc);
                acc = mma16(ldfrag(VT, ST, vt * 16, 0, lane), ldfrag(Ard, ST, tt * 16, 0, lane), acc);
                acc = mma16(ldfrag(UT, ST, vt * 16, 0, lane), ldfrag(Arbn, ST, tt * 16, 0, lane), acc);
                *(f4*)(Yb + (tt * 16 + i16) * 68 + vt * 16 + 4 * q) = acc;
#pragma unroll
                for (int x = 0; x < 2; ++x) { const int id = 2 * w + x, kt = id >> 2, v2 = id & 3, k0 = kt * 16 + 4 * q;
#pragma unroll
                    for (int r = 0; r < 4; ++r) accH[x][r] *= gC[k0 + r];
                    accH[x] = mma16(ldfrag(DhT, ST, kt * 16, 0, lane), ldfrag(VT, ST, v2 * 16, 0, lane), accH[x]);
                    accH[x] = mma16(ldfrag(BhTn, ST, kt * 16, 0, lane), ldfrag(UT, ST, v2 * 16, 0, lane), accH[x]); }
            }
            lds_barrier();
            {   const int t = tid >> 4, c = 4 * (tid & 15), row = tokrow(d, b, s0 + t);
                const f4 y = *(const f4*)(Yb + t * 68 + c); const f4 gw = *(const f4*)(gnw + c), gb = *(const f4*)(gnb + c);
                float sm = (y[0] + y[1]) + (y[2] + y[3]); sm = red16(sm);
                const float mu = sm * (1.0f / 64.0f); float sq = 0.f;
#pragma unroll
                for (int i = 0; i < 4; ++i) { const float dd = y[i] - mu; sq += dd * dd; }
                sq = red16(sq);
                const f4 bp = *(const f4*)(bonus + 4 * t); const float rs = rsqrtf(sq * (1.0f / 64.0f) + 64e-5f), bo = (bp[0] + bp[1]) + (bp[2] + bp[3]); h4 o;
#pragma unroll
                for (int i = 0; i < 4; ++i) o[i] = (half_t)((y[i] - mu) * rs * gw[i] + gb[i] + bo * (float)VT[(c + i) * ST + t]);
                *(h4*)(Zd + (size_t)row * ADIM + c) = o;
            }
        }
        lds_barrier();
    }
}

__device__ __forceinline__ void ph_gla_a(const Params& P, int first, int stride) {
    constexpr int QS = 104, TSR = 72;
    half_t* Q2s = (half_t*)smem; half_t* K2s = Q2s + 64 * QS; half_t* K3T = K2s + 64 * QS; half_t* VT = K3T + 96 * TSR; half_t* Ps = VT + 192 * TSR;
    float* cgf = (float*)(Ps + 64 * TSR); float* segt = cgf + 64 * 96;
    const int tid = tid_(), lane = tid & 63, w = wid_of(tid);
    for (int task = first; task < GLT; task += stride) {
        const int n = task % 68, c = task / 68, h = c & 3, b = (c >> 2) & 3, d = c >> 4, s0 = n * 64;
        const half_t* GGd = P.GG() + (size_t)d * MT * BKEY + h * BHK; half_t* Od = P.O() + (size_t)d * MT * BDIM + h * BHV;
        const half_t* Fq = P.F() + 2304 + h * BHK; const half_t* Fv = P.F() + 3072 + h * BHV;
        lds_barrier();
        h8 qv[2], kv[2];
#pragma unroll
        for (int j = 0; j < 2; ++j) { const int p = tid + NTHREADS * j;
            if (p < 768) { const int i = p / 12, kc = (p % 12) * 8, row = tokrow(d, b, s0 + i);
                qv[j] = *(const h8*)(Fq + (size_t)row * CONV + kc); kv[j] = *(const h8*)(Fq + (size_t)row * CONV + BKEY + kc);
                const h8 g = *(const h8*)(GGd + (size_t)row * BKEY + kc);
#pragma unroll
                for (int e = 0; e < 8; ++e) cgf[i * 96 + kc + e] = (float)g[e]; } }
#pragma unroll
        for (int j = 0; j < 3; ++j) { const int p = tid + NTHREADS * j, i = p / 24, vc = (p % 24) * 8, row = tokrow(d, b, s0 + i);
            const h8 v = *(const h8*)(Fv + (size_t)row * CONV + vc);
#pragma unroll
            for (int e = 0; e < 8; ++e) VT[(vc + e) * TSR + i] = v[e]; }
        lds_barrier();
        { float loc[16]; const int ck = tid % 96, cseg = tid / 96;
          if (tid < 384) { float run = 0.f;
#pragma unroll
              for (int i = 0; i < 16; ++i) { run += cgf[(cseg * 16 + i) * 96 + ck]; loc[i] = run; }
              segt[cseg * 96 + ck] = run; }
          lds_barrier();
          if (tid < 384) { float off = 0.f;
#pragma unroll
              for (int sg = 0; sg < 4; ++sg) off += (sg < cseg) ? segt[sg * 96 + ck] : 0.f;
#pragma unroll
              for (int i = 0; i < 16; ++i) cgf[(cseg * 16 + i) * 96 + ck] = loc[i] + off; }
        }
        lds_barrier();
#pragma unroll
        for (int j = 0; j < 2; ++j) { const int p = tid + NTHREADS * j;
            if (p < 768) { const int i = p / 12, kc = (p % 12) * 8; h8 q1, q2, k2;
#pragma unroll
                for (int e = 0; e < 8; ++e) { const float cg = cgf[i * 96 + kc + e], rf = cgf[31 * 96 + kc + e], tt = cgf[63 * 96 + kc + e];
                    const float qf = (float)qv[j][e] * 0.10206207261596575f, kf = (float)kv[j][e];
                    q1[e] = clamp_h(qf * __expf(cg)); q2[e] = clamp_h(qf * __expf(cg - rf)); k2[e] = clamp_h(kf * __expf(rf - cg)); K3T[(kc + e) * TSR + i] = clamp_h(kf * __expf(tt - cg)); }
                *(h8*)(P.GQ() + ((size_t)task * 64 + i) * BHK + kc) = q1; *(h8*)(Q2s + i * QS + kc) = q2; *(h8*)(K2s + i * QS + kc) = k2; } }
        if (tid < 96) P.GE()[(size_t)task * BHK + tid] = __expf(cgf[63 * 96 + tid]);
        lds_barrier();
#pragma unroll
        for (int x = 0; x < 2; ++x) {
            const int id = w * 2 + x, it = id >> 2, jt = id & 3; f4 a = (f4){0.f, 0.f, 0.f, 0.f};
            if (jt <= it) {
#pragma unroll
                for (int ks = 0; ks < 3; ++ks) a = mma16(ldfrag(K2s, QS, jt * 16, ks * 32, lane), ldfrag(Q2s, QS, it * 16, ks * 32, lane), a);
            }
            const int i = it * 16 + (lane & 15), j = jt * 16 + 4 * (lane >> 4); h4 pv;
#pragma unroll
            for (int r = 0; r < 4; ++r) pv[r] = (j + r <= i) ? clamp_h(a[r]) : (half_t)0.f;
            *(h4*)(Ps + i * TSR + j) = pv;
        }
        lds_barrier();
        {   const int it = w & 3, i = it * 16 + (lane & 15), row = tokrow(d, b, s0 + i);
            const h8 p0 = ldfrag(Ps, TSR, it * 16, 0, lane), p1 = ldfrag(Ps, TSR, it * 16, 32, lane);
#pragma unroll
            for (int x = 0; x < 6; ++x) { const int vt = (w >> 2) * 6 + x;
                f4 a = mma16(ldfrag(VT, TSR, vt * 16, 0, lane), p0, (f4){0.f, 0.f, 0.f, 0.f}); a = mma16(ldfrag(VT, TSR, vt * 16, 32, lane), p1, a);
                *(h4*)(Od + (size_t)row * BDIM + vt * 16 + 4 * (lane >> 4)) = to_h4(a); }
        }
        {   half_t* gs = P.GS() + (size_t)task * BHV * BHK;
#pragma unroll
            for (int x = 0; x < 9; ++x) { const int id = w * 9 + x, kt = id / 12, vt = id - kt * 12;
                f4 a = mma16(ldfrag(K3T, TSR, kt * 16, 0, lane), ldfrag(VT, TSR, vt * 16, 0, lane), (f4){0.f, 0.f, 0.f, 0.f});
                a = mma16(ldfrag(K3T, TSR, kt * 16, 32, lane), ldfrag(VT, TSR, vt * 16, 32, lane), a);
                *(h4*)(gs + (size_t)(vt * 16 + (lane & 15)) * BHK + kt * 16 + 4 * (lane >> 4)) = to_h4(a); }
        }
    }
    __syncthreads();
}
__device__ __forceinline__ void ph_gla_b(const Params& P, int first, int stride) {
    constexpr int NBLK = 32 * (BHV * BHK / 8) / NTHREADS;
    for (int blk = first; blk < NBLK; blk += stride) {
        const int gid = blk * NTHREADS + tid_(), c = gid / (BHV * BHK / 8), e = gid - c * (BHV * BHK / 8), v = e / 12, kc = (e - v * 12) * 8;
        half_t* base = P.GS() + ((size_t)c * 68 * BHV + v) * BHK + kc; const float* eb = P.GE() + (size_t)c * 68 * BHK + kc;
        float S[8];
#pragma unroll
        for (int j = 0; j < 8; ++j) S[j] = 0.f;
        for (int n0 = 0; n0 < 68; n0 += 4) {
            h8 U[4]; f4 e0[4], e1[4];
#pragma unroll
            for (int u = 0; u < 4; ++u) { U[u] = *(const h8*)(base + (size_t)(n0 + u) * BHV * BHK); e0[u] = *(const f4*)(eb + (n0 + u) * BHK); e1[u] = *(const f4*)(eb + (n0 + u) * BHK + 4); }
#pragma unroll
            for (int u = 0; u < 4; ++u) { h8 o;
#pragma unroll
                for (int j = 0; j < 8; ++j) o[j] = clamp_h(S[j]);
                *(h8*)(base + (size_t)(n0 + u) * BHV * BHK) = o;
#pragma unroll
                for (int j = 0; j < 4; ++j) { S[j] = e0[u][j] * S[j] + (float)U[u][j]; S[4 + j] = e1[u][j] * S[4 + j] + (float)U[u][4 + j]; } }
        }
    }
}
__device__ __forceinline__ void ph_gla_c(const Params& P, int l, int first, int stride, bool latent_only) {
    const int tid = tid_(), lane = tid & 63, w = wid_of(tid), q = lane >> 4, i16 = lane & 15;
    const float* ng = pin(I_GLANG) + l * BHV;
    for (int u = first; u < NBATCH * BH * 68 / 2; u += stride) {
        const int t = 2 * u + (w >> 2), m = t % 68, h = (t / 68) & 3, b = t / (68 * 4), it = w & 3, j = it * 16 + i16;
        if (latent_only && m < 4) continue;
        const int row = (m < 4) ? RL + b * CTXL + 64 * m + j : b * SEQ + 64 * (m - 4) + j;
        const int task0 = ((0 * 4 + b) * 4 + h) * 68 + m, task1 = ((1 * 4 + b) * 4 + h) * 68 + (m < 4 ? 3 - m : 71 - m);
        h8 y0[3], y1[3];
        { const half_t* q0 = P.GQ() + ((size_t)task0 * 64 + j) * BHK + 8 * q; const half_t* q1 = P.GQ() + ((size_t)task1 * 64 + (63 - j)) * BHK + 8 * q;
#pragma unroll
          for (int ks = 0; ks < 3; ++ks) { y0[ks] = *(const h8*)(q0 + 32 * ks); y1[ks] = *(const h8*)(q1 + 32 * ks); } }
        const half_t* s0p = P.GS() + ((size_t)task0 * BHV + i16) * BHK + 8 * q; const half_t* s1p = P.GS() + ((size_t)task1 * BHV + i16) * BHK + 8 * q;
        const half_t* o0 = P.O() + (size_t)row * BDIM + h * BHV + 4 * q; const half_t* o1 = o0 + (size_t)MT * BDIM;
        f4 o[12]; float ss = 0.f;
#pragma unroll
        for (int vt = 0; vt < 12; ++vt) {
            f4 a = (f4){0.f, 0.f, 0.f, 0.f};
#pragma unroll
            for (int ks = 0; ks < 3; ++ks) { a = mma16(*(const h8*)(s0p + (size_t)vt * 16 * BHK + 32 * ks), y0[ks], a); a = mma16(*(const h8*)(s1p + (size_t)vt * 16 * BHK + 32 * ks), y1[ks], a); }
            const h4 i0 = *(const h4*)(o0 + vt * 16), i1 = *(const h4*)(o1 + vt * 16);
#pragma unroll
            for (int r = 0; r < 4; ++r) { a[r] += (float)i0[r] + (float)i1[r]; ss += a[r] * a[r]; }
            o[vt] = a;
        }
        ss += __shfl_xor(ss, 16); ss += __shfl_xor(ss, 32);
        const float rs = rsqrtf(ss * (1.0f / BHV) + 1e-6f);
        const half_t* ogp = P.Plo() + (size_t)row * NLO + LO_OG + h * BHV + 4 * q; half_t* yb = P.YB() + (size_t)row * YCP + h * BHV + 4 * q;
#pragma unroll
        for (int vt = 0; vt < 12; ++vt) { const h4 og = *(const h4*)(ogp + vt * 16); const f4 g = *(const f4*)(ng + vt * 16 + 4 * q); f4 r4;
#pragma unroll
            for (int r = 0; r < 4; ++r) r4[r] = o[vt][r] * rs * g[r] * siluf_((float)og[r]);
            *(h4*)(yb + vt * 16) = to_h4(r4); }
    }
}

template <class FN> __device__ __forceinline__ void acc_foreach_pair(const f4 (&acc)[4][2], FN fn) {
    const int lane = tid_() & 63, w = wid_of(tid_()), wm = w >> 2, wn = w & 3;
#pragma unroll
    for (int mi = 0; mi < 4; ++mi) fn(64 * wm + 16 * mi + (lane & 15), 16 * wn + 4 * (lane >> 4), acc[mi][0], acc[mi][1]);
}
__device__ __forceinline__ float gelu_tanh(float x) { const float u = 0.7978845608028654f * (x + 0.044715f * x * x * x); return 0.5f * x * (1.0f + tanhf(u)); }

__device__ __forceinline__ uint4 s5_u_piece(const Params& P, int g, int m, int k) {
    if (m >= S5ROWS) return zero16();
    const int b = m / 272, n = m - b * 272, row0 = s5_block_row0(b, n);
    return ld16(P.Plo() + (size_t)(row0 + (k >> 4)) * NLO + LO_U + g * 16 + (k & 15));
}
__device__ __forceinline__ void ph_s5g2(const Params& P, int first, int stride) {
    for (int u = first; u < CGR * 9 * 2; u += stride) {
        const int g = u / 18, tm = (u % 18) >> 1, tn = u & 1;
        const half_t* B = P.MstT() + (size_t)g * 256 * 256 + (size_t)tn * 128 * 256;
        f4 acc[4][2]; acc_zero(acc);
        gemm_tile(4, [&](int r, int k) { return s5_u_piece(P, g, tm * 128 + r, k); }, [&](int r, int k) { return ld16(B + r * 256 + k); }, acc);
        acc_foreach(acc, [&](int m, int n, f4 v) { const int mm = tm * 128 + m; if (mm < S5ROWS) *(f4*)(P.Sloc() + ((size_t)g * S5ROWS + mm) * 256 + tn * 128 + n) = v; });
    }
}
__device__ __forceinline__ void ph_s5scan(const Params& P, int l, int first, int stride) {
    for (int blk = first; blk < 32; blk += stride) {
        const int gid = blk * NTHREADS + tid_(), p = gid & 63, d = (gid >> 6) & 1, b = (gid >> 7) & 3, g = gid >> 9;
        const float lr = pin(I_S5LRE)[((l * 2 + d) * CGR + g) * CP + p], li = pin(I_S5LIM)[((l * 2 + d) * CGR + g) * CP + p];
        const float dt = expf(pin(I_S5LDT)[(l * 2 + d) * CGR + g]);
        const float mag = expf(lr * dt * 16.0f), ang = li * dt * 16.0f, ar = mag * cosf(ang), ai = mag * sinf(ang);
        float xr = 0.f, xi = 0.f;
        for (int n0 = 0; n0 < 272; n0 += 16) {
            float sr[16], si[16]; size_t oo[16];
#pragma unroll
            for (int u = 0; u < 16; ++u) { const int ns = n0 + u, nb = d == 0 ? ns : (ns < 16 ? 15 - ns : 287 - ns);
                oo[u] = ((size_t)g * S5ROWS + b * 272 + nb) * 256 + d * 128 + p; sr[u] = P.Sloc()[oo[u]]; si[u] = P.Sloc()[oo[u] + 64]; }
#pragma unroll
            for (int u = 0; u < 16; ++u) { P.XinH()[oo[u]] = (half_t)xr; P.XinH()[oo[u] + 64] = (half_t)xi;
                const float nr = ar * xr - ai * xi + sr[u], ni = ar * xi + ai * xr + si[u]; xr = nr; xi = ni; }
        }
    }
}
__device__ __forceinline__ void ph_s5g1(const Params& P, int l, int first, int stride) {
    const float* s5d = pin(I_S5D) + l * CDIM;
    for (int u = first; u < CGR * 9 * 2; u += stride) {
        const int g = u / 18, tm = (u % 18) >> 1, tn = u & 1;
        const half_t* B = P.McatT() + (size_t)g * 256 * 512 + (size_t)tn * 128 * 512;
        f4 acc[4][2]; acc_zero(acc);
        gemm_tile(8, [&](int r, int k) -> uint4 { const int m = tm * 128 + r; if (k < 256) return s5_u_piece(P, g, m, k); if (m >= S5ROWS) return zero16();
                         return ld16(P.XinH() + ((size_t)g * S5ROWS + m) * 256 + (k - 256)); },
                  [&](int r, int k) { return ld16(B + r * 512 + k); }, acc);
        struct UD { h4 u; f4 d; };
        acc_foreach2(acc, [&](int m, int n) { UD r; const int mm = tm * 128 + m < S5ROWS ? tm * 128 + m : S5ROWS - 1;
            const int nn = tn * 128 + n, tau = nn >> 4, c = nn & 15, b = mm / 272, nb = mm - b * 272, row = s5_block_row0(b, nb) + tau, ch = g * 16 + c;
            r.u = *(const h4*)(P.Plo() + (size_t)row * NLO + LO_U + ch); r.d = *(const f4*)(s5d + ch); return r; },
          [&](int m, int n, f4 v, UD r) { const int mm = tm * 128 + m; if (mm >= S5ROWS) return;
            const int nn = tn * 128 + n, tau = nn >> 4, c = nn & 15, b = mm / 272, nb = mm - b * 272, row = s5_block_row0(b, nb) + tau, ch = g * 16 + c; f4 o;
#pragma unroll
            for (int i = 0; i < 4; ++i) o[i] = gelu_tanh(v[i] + r.d[i] * (float)r.u[i]);
            *(h4*)(P.TC() + (size_t)row * CDIM + ch) = to_h4(o); });
    }
}
__device__ __forceinline__ void ph_glu(const Params& P, int mrows) {
    SchedDense S; S.T.init(mrows / 256, (2 * CDIM) / 256, gridDim.x, bid_()); S.A = (const char*)P.TC(); S.B = (const char*)P.GluT(); S.tstepA = (size_t)256 * CDIM * 2; S.tstepB = (size_t)256 * CDIM * 2;
    pg8::gemm_phase(CDIM, S, [&](const pg8::Acc& acc, const pg8::Unit& u, int wr, int wc, int fr, int fq) {
        pg8::foreach_pair(acc, wr, wc, fr, fq, [&](int m, int hc, f4 a, f4 g) { f4 o;
#pragma unroll
            for (int i = 0; i < 4; ++i) o[i] = a[i] * sigmoidf_(g[i]);
            *(h4*)(P.YC() + (size_t)(u.pm * 256 + m) * CDIM + u.pn * 128 + hc) = to_h4(o); });
    });
}

__device__ __forceinline__ void ph_comb(const Params& P, int l, int mrows) {
    const int tid = tid_();
    for (int u = bid_(); u < (mrows / 128) * 6; u += gridDim.x) {
        const int tm = u / 6, tn = u % 6, m0 = tm * 128, n0 = tn * 128;
        const half_t* A = P.Plo() + (size_t)m0 * NLO + LO_DG; const half_t* B = P.LG2T() + (size_t)n0 * 128;
        f4 acc[4][2]; acc_zero(acc);
        gemm_tile(2, [&](int rr, int k) { return sigm8(ld16(A + (size_t)rr * NLO + k)); }, [&](int rr, int k) { return ld16(B + rr * 128 + k); }, acc);
        struct ZZ { h4 a, b; };
        acc_foreach2(acc, [&](int m, int n) { ZZ z; const size_t o = (size_t)(m0 + m) * ADIM + n0 + n; z.a = *(const h4*)(P.Z() + o); z.b = *(const h4*)(P.Z() + (size_t)MT * ADIM + o); return z; },
          [&](int m, int n, f4 v, ZZ z) { const size_t o = (size_t)(m0 + m) * ADIM + n0 + n; f4 r;
#pragma unroll
            for (int i = 0; i < 4; ++i) r[i] = ((float)z.a[i] + (float)z.b[i]) * v[i];
            *(h4*)(P.YA() + o) = to_h4(r); });
    }
}

struct SchedMerge1 {
    pg8::TileOrder T; const char *a, *b; int nb, br0, K;
    __device__ __forceinline__ bool next(int i, pg8::Unit& u) const { const int t = i / nb, br = i - nb * t; int pm, pn; if (!T.tile(t, pm, pn)) return false; u.pm = pm; u.pn = pn * 4 + br0 + br;
        u.A = a + ((size_t)br * MT + (size_t)pm * 256) * K * 2; u.B = b + ((size_t)br * D + (size_t)pn * 256) * K * 2; return true; }
};
template <class S_> __device__ __forceinline__ void merge1_call(const Params& P, const S_& S, int K) {
    pg8::gemm_phase(K, S, [&](const pg8::Acc& acc, const pg8::Unit& u, int wr, int wc, int fr, int fq) {
        const int br = u.pn & 3, m0 = u.pm * 256, n0 = (u.pn >> 2) * 256;
        struct GO { h4 g, o; };
        pg8::foreach_frag2w(acc, wr, wc, fr, fq,
            [&](int m, int n) { GO r; r.g = *(const h4*)(P.Pg() + (size_t)(m0 + m) * NGT + br * D + n0 + n); r.o = (h4){0, 0, 0, 0}; if (br != 0) r.o = *(const h4*)(P.U() + (size_t)(m0 + m) * D + n0 + n); return r; },
            [&](int m, int n, f4 v, GO r) { f4 x;
#pragma unroll
                for (int i = 0; i < 4; ++i) x[i] = (float)r.o[i] + (float)r.g[i] * v[i];
                *(h4*)(P.U() + (size_t)(m0 + m) * D + n0 + n) = to_h4(x); });
    });
}
__device__ __forceinline__ void ph_merge1(const Params& P, int mrows_all) {
    const int mrows = RL;
    if (mrows_all > RL) {
        for (int u = bid_(); u < (RC / 128) * (D / 128); u += gridDim.x) {
            const int tm = u >> 4, tn = u & 15, m0 = RL + tm * 128, n0 = tn * 128;
            f4 tot[4][2]; acc_zero(tot);
#pragma unroll 1
            for (int br = 0; br < 3; ++br) {
                const int K = br == 2 ? CDIM : YCP;
                const half_t* A = (br == 0 ? P.YA() : (br == 1 ? P.YB() : P.YC())) + (size_t)m0 * K;
                const half_t* B = (br == 0 ? P.PaT() : (br == 1 ? P.PbT() : P.PcT())) + (size_t)n0 * K;
                f4 acc[4][2]; acc_zero(acc);
                gemm_tile(K / 64, [&](int r, int k) { return ld16(A + (size_t)r * K + k); }, [&](int r, int k) { return ld16(B + (size_t)r * K + k); }, acc);
                const int lane = tid_() & 63, w = wid_of(tid_()), wm = w >> 2, wn = w & 3;
                h4 gt[4][2];
#pragma unroll
                for (int mi = 0; mi < 4; ++mi)
#pragma unroll
                    for (int ni = 0; ni < 2; ++ni) gt[mi][ni] = *(const h4*)(P.Pg() + (size_t)(m0 + 64 * wm + 16 * mi + (lane & 15)) * NGT + br * D + n0 + 32 * wn + 16 * ni + 4 * (lane >> 4));
#pragma unroll
                for (int mi = 0; mi < 4; ++mi)
#pragma unroll
                    for (int ni = 0; ni < 2; ++ni)
#pragma unroll
                        for (int i = 0; i < 4; ++i) tot[mi][ni][i] += (float)gt[mi][ni][i] * acc[mi][ni][i];
            }
            acc_foreach(tot, [&](int m, int n, f4 v) { *(h4*)(P.U() + (size_t)(m0 + m) * D + n0 + n) = to_h4(v); });
        }
        __syncthreads();
    }
    SchedMerge1 S; S.T.init(mrows / 256, D / 256, gridDim.x, bid_()); S.a = (const char*)P.YA(); S.b = (const char*)P.PaT(); S.nb = 2; S.br0 = 0; S.K = YCP;
    merge1_call(P, S, YCP);
    SchedMerge1 S2; S2.T.init(mrows / 256, D / 256, gridDim.x, bid_()); S2.a = (const char*)P.YC(); S2.b = (const char*)P.PcT(); S2.nb = 1; S2.br0 = 2; S2.K = CDIM;
    merge1_call(P, S2, CDIM);
}
__device__ __forceinline__ void ph_merge2(const Params& P, int l, int mrows_all) {
    const int mrows = RL;
    if (mrows_all > RL) {
        for (int u = bid_(); u < (RC / 128) * (D / 128); u += gridDim.x) {
            const int tm = u >> 4, tn = u & 15, m0 = RL + tm * 128, n0 = tn * 128;
            const half_t* A = P.U() + (size_t)m0 * D; const half_t* B = P.WoT() + (size_t)n0 * D;
            f4 acc[4][2]; acc_zero(acc);
            gemm_tile(D / 64, [&](int r, int k) { return ld16(A + (size_t)r * D + k); }, [&](int r, int k) { return ld16(B + (size_t)r * D + k); }, acc);
            const float* gap = P.MOD() + ((size_t)l * 5 + 4) * (6 * D) + 2 * D + n0;
            struct XG { f4 x, g; };
            acc_foreach2(acc, [&](int m, int n) { XG r; r.x = *(const f4*)(xsrc_ptr(P, m0 + m, l) + n0 + n); r.g = *(const f4*)(gap + n); return r; },
                [&](int m, int n, f4 v, XG r) {
#pragma unroll
                    for (int i = 0; i < 4; ++i) r.x[i] += r.g[i] * v[i];
                    *(f4*)(xrow_ptr(P, m0 + m) + n0 + n) = r.x; });
        }
        __syncthreads();
    }
    SchedDense S; S.T.init(mrows / 256, D / 256, gridDim.x, bid_()); S.A = (const char*)P.U(); S.B = (const char*)P.WoT(); S.tstepA = (size_t)256 * D * 2; S.tstepB = (size_t)256 * D * 2;
    pg8::gemm_phase(D, S, [&](const pg8::Acc& acc, const pg8::Unit& u, int wr, int wc, int fr, int fq) {
        const int m0 = u.pm * 256, n0 = u.pn * 256;
        const float* gap = P.MOD() + ((size_t)l * 5 + modrow_of(m0)) * (6 * D) + 2 * D + n0;
        f4 gv[2][2];
#pragma unroll
        for (int bj = 0; bj < 2; ++bj)
#pragma unroll
            for (int n = 0; n < 2; ++n) gv[bj][n] = *(const f4*)(gap + bj * pg8::HALF + wc * 32 + n * 16 + 4 * fq);
        pg8::foreach_frag2w(acc, wr, wc, fr, fq,
            [&](int m, int n) { return *(const f4*)(xsrc_ptr(P, m0 + m, l) + n0 + n); },
            [&](int m, int n, f4 v, f4 x) { const int cg = (n - wc * 32 - 4 * fq) >> 4;
                const f4 g = (cg & 8) ? ((cg & 1) ? gv[1][1] : gv[1][0]) : ((cg & 1) ? gv[0][1] : gv[0][0]);
#pragma unroll
                for (int i = 0; i < 4; ++i) x[i] += g[i] * v[i];
                *(f4*)(xrow_ptr(P, m0 + m) + n0 + n) = x; });
    });
}

__device__ __forceinline__ void ph_route(const Params& P, int l, int mrows) {
    const int tid = tid_(), lane = tid & 63, gw = bid_() * 8 + wid_of(tid), NW = gridDim.x * 8;
    constexpr int RWS = D + 4;
    float* rwT = (float*)smem;
    { const float* rwp = pin(I_RW); for (int i = tid; i < D * NE; i += NTHREADS) rwT[(i & 15) * RWS + (i >> 4)] = rwp[i]; }
    const float* rbias = pin(I_RB); const float* n2g = pin(I_N2G) + (size_t)l * D;
    for (int i = bid_() * NTHREADS + tid; i < SLOTS; i += gridDim.x * NTHREADS) P.sidx()[i] = 0;
    int* lcnt = (int*)(smem + 131072 + 512);
    if (tid < NE) lcnt[tid] = 0;
    __syncthreads();
    for (int row = gw; row < mrows; row += NW) {
        const float* xr = xrow_ptr(P, row); const int mr = modrow_of(row);
        const float* ng = n2g; const float* sh = P.MOD() + ((size_t)l * 5 + mr) * (6 * D) + 3 * D; const float* sc = sh + D;
        f4 v[8]; float ss = 0.f;
#pragma unroll
        for (int j = 0; j < 8; ++j) { v[j] = *(const f4*)(xr + (j * 64 + lane) * 4); ss += (v[j][0] * v[j][0] + v[j][1] * v[j][1]) + (v[j][2] * v[j][2] + v[j][3] * v[j][3]); }
        ss = wave_sum(ss);
        const float rstd = rsqrtf(ss * (1.0f / D) + 1e-6f);
        float lg[NE];
#pragma unroll
        for (int e = 0; e < NE; ++e) lg[e] = 0.f;
        half_t* hr = P.H() + (size_t)row * D;
#pragma unroll
        for (int j = 0; j < 8; ++j) { const int c = (j * 64 + lane) * 4; const f4 g = *(const f4*)(ng + c), s1 = *(const f4*)(sc + c), s0 = *(const f4*)(sh + c); f4 o;
#pragma unroll
            for (int i = 0; i < 4; ++i) o[i] = v[j][i] * rstd * g[i] * (1.0f + s1[i]) + s0[i];
#pragma unroll
            for (int e = 0; e < NE; ++e) { const f4 wv = *(const f4*)(rwT + e * RWS + c); lg[e] += (o[0] * wv[0] + o[1] * wv[1]) + (o[2] * wv[2] + o[3] * wv[3]); }
            *(h4*)(hr + c) = to_h4(o); asm volatile("" ::: "memory"); }
#pragma unroll
        for (int e = 0; e < NE; ++e) lg[e] = wave_sum(lg[e]);
        float sc16[NE], bi[NE];
#pragma unroll
        for (int e = 0; e < NE; ++e) { sc16[e] = sigmoidf_(lg[e]); bi[e] = sc16[e] + rbias[e]; }
        int gsel = 0; float gbest = -1e30f;
#pragma unroll
        for (int g = 0; g < 4; ++g) { float m1 = -1e30f, m2 = -1e30f;
#pragma unroll
            for (int i = 0; i < 4; ++i) { const float x = bi[4 * g + i]; if (x > m1) { m2 = m1; m1 = x; } else if (x > m2) m2 = x; }
            const float s = m1 + m2; if (s > gbest) { gbest = s; gsel = g; } }
        int i0 = 0, i1 = 0; float b0 = -1e30f, b1 = -1e30f, s0v = 0.f, s1v = 0.f;
#pragma unroll
        for (int e = 0; e < NE; ++e) { const bool in = (e >> 2) == gsel; const float x = bi[e];
            if (in && x > b0) { b1 = b0; i1 = i0; s1v = s0v; b0 = x; i0 = e; s0v = sc16[e]; } else if (in && x > b1) { b1 = x; i1 = e; s1v = sc16[e]; } }
        if (lane == 0) { const float inv = 1.0f / (s0v + s1v);
            P.wsel()[row * 2] = s0v * inv; P.wsel()[row * 2 + 1] = s1v * inv; P.pos()[row * 2] = i0; P.pos()[row * 2 + 1] = i1;
            atomicAdd(&lcnt[i0], 1); atomicAdd(&lcnt[i1], 1); }
    }
    __syncthreads();
    if (tid < NE) P.blkcnt()[bid_() * NE + tid] = lcnt[tid];
}
__device__ __forceinline__ void seg_starts(const Params& P, int (&st)[NE + 1]) {
    int a = 0;
#pragma unroll
    for (int e = 0; e < NE; ++e) { st[e] = a; a += (P.cnt()[e] + 255) & ~255; }
    st[NE] = a;
}
__device__ __forceinline__ void ph_slot(const Params& P, int mrows) {
    const int tid = tid_(), lane = tid & 63, bid = bid_(), gw = bid * 8 + wid_of(tid), NW = gridDim.x * 8, G = gridDim.x;
    int* ls = (int*)smem;
    if (tid < 48) ls[tid] = 0;
    __syncthreads();
    { const int e = tid & 15; int t = 0, p = 0;
        for (int b = tid >> 4; b < G; b += NTHREADS / 16) { const int c = P.blkcnt()[b * NE + e]; t += c; p += (b < bid) ? c : 0; }
        atomicAdd(&ls[e], t); atomicAdd(&ls[16 + e], p); }
    __syncthreads();
    if (tid < NE) { int a = 0;
        for (int q = 0; q < tid; ++q) a += (ls[q] + 255) & ~255;
        ls[32 + tid] = a + ls[16 + tid];
        if (bid == 0) P.cnt()[tid] = ls[tid]; }
    __syncthreads();
    { const int row = gw + lane * NW;
        if (row < mrows) { const int e0 = P.pos()[row * 2], e1 = P.pos()[row * 2 + 1];
            const int s0 = atomicAdd(&ls[32 + e0], 1), s1 = atomicAdd(&ls[32 + e1], 1);
            P.pos()[row * 2] = s0; P.pos()[row * 2 + 1] = s1; P.sidx()[s0] = row; P.sidx()[s1] = row; } }
}
struct SchedMoe {
    pg8::TileOrder T; const char* A; const char* B; size_t tstepA, tstepB, estepB; int st[NE + 1];
    __device__ __forceinline__ bool next(int i, pg8::Unit& u) const { int pm, pn; if (!T.tile(i, pm, pn)) return false; u.pm = pm; u.pn = pn; const int s0 = pm * 256; int e = 0;
#pragma unroll
        for (int q = 1; q < NE; ++q) e = (s0 >= st[q]) ? q : e;
        u.A = A + (size_t)pm * tstepA; u.B = B + (size_t)e * estepB + (size_t)pn * tstepB; return true; }
};
__device__ __forceinline__ void ph_up(const Params& P) {
    SchedMoe S; seg_starts(P, S.st); S.T.init(S.st[NE] >> 8, (2 * DE) / 256, gridDim.x, bid_());
    S.A = (const char*)P.H(); S.B = (const char*)P.W13T(); S.tstepA = 0; S.tstepB = (size_t)256 * D * 2; S.estepB = (size_t)2 * DE * D * 2;
    pg8::gemm_phase<false, true>(D, S, [&](const pg8::Acc& acc, const pg8::Unit& u, int wr, int wc, int fr, int fq) {
        pg8::foreach_pair(acc, wr, wc, fr, fq, [&](int m, int hc, f4 a, f4 g) { f4 o;
#pragma unroll
            for (int i = 0; i < 4; ++i) o[i] = siluf_(a[i]) * g[i];
            *(h4*)(P.Hg() + (size_t)(u.pm * 256 + m) * DE + u.pn * 128 + hc) = to_h4(o); });
    }, P.sidx());
}
__device__ __forceinline__ void ph_down(const Params& P) {
    SchedMoe S; seg_starts(P, S.st); S.T.init(S.st[NE] >> 8, D / 256, gridDim.x, bid_());
    S.A = (const char*)P.Hg(); S.B = (const char*)P.W2T(); S.tstepA = (size_t)256 * DE * 2; S.tstepB = (size_t)256 * DE * 2; S.estepB = (size_t)D * DE * 2;
    pg8::gemm_phase<true>(DE, S, [&](const pg8::Acc& acc, const pg8::Unit& u, int wr, int wc, int fr, int fq) {
        pg8::foreach_frag8(acc, wr, wc, fr, fq, [&](int m, int n, f4 a, f4 b) { const h4 x = to_h4(a), y = to_h4(b); h8 o;
#pragma unroll
            for (int i = 0; i < 4; ++i) { o[i] = x[i]; o[4 + i] = y[i]; }
            *(h8*)(P.Y() + (size_t)(u.pm * 256 + m) * D + u.pn * 256 + n) = o; });
    });
}

#ifndef PROBE_BAR
#define PROBE_BAR 1
#endif
#define XBAR(b) REP(PROBE_BAR, xcd_barrier(b);)
#ifndef TPROBE
#define TPROBE 0
#endif
#define TPMUL 8
template <int ID, int END> __device__ __forceinline__ void tp_mark(const Params& P) {
    if (((TPROBE >> ID) & 1) && blockIdx.x == 0 && threadIdx.x == 0) {
        GAS unsigned char* w = (GAS unsigned char*)P.ws; asm volatile("" : "+s"(w));
        GAS unsigned long long* s = (GAS unsigned long long*)(w + WS_TOTAL);
        const unsigned long long t = __builtin_amdgcn_s_memrealtime();
        if (END) s[0] += t - s[1]; else s[1] = t; }
}
#define TPB(id) tp_mark<id, 0>(P);
#define TPE(id) tp_mark<id, 1>(P);
template <int l> __device__ __forceinline__ void layer_body(const Params& P, const XcdBarrier& bar, const int bid, const int G) {
    constexpr int MR = (l == DEPTH - 1) ? RL : MT;

    TPB(1)
    if (l == 0) { ph_prologue(P); REP(PROBE_SETUP, ph_setup(P, 0); XBAR(bar);) ph_rows<0>(P, 0); }
    else { ph_setup_rest(P, l); ph_rows<1>(P, l); }
    XBAR(bar);
    TPE(1) TPB(2)
    REP(PROBE_INPROJ, ph_inproj<0>(P, bid, G); ph_moe_convert(P, l, 6, 6144 - MOE_I, 6144); XBAR(bar);)
    TPE(2) TPB(3)
    REP(PROBE_CONVF, REP(PROBE_CONV1, ph_convf(P, l);) ph_lora(P, l, bid, G); REP(PROBE_S5G2, ph_s5g2(P, bid, G);) XBAR(bar);)
    TPE(3) TPB(4)
    REP(PROBE_SCANS,
    if (G >= 224) { if (bid < 96) { REP(PROBE_RWKV, ph_rwkv(P, l, bid, 1 << 30);) ph_inproj<1>(P, bid, 96, 96 * GATE_KU, MR); }
                    else if (bid >= G - NCONV) { ph_moe_convert_static(P, l, 0, MOE_A, bid - (G - NCONV), NCONV); ph_inproj<1>(P, 96 * GATE_KU + bid - (G - NCONV), NCONV, 96 * GATE_KU + NCONV * CONV_GU, MR); }
                    else { ph_s5scan(P, l, bid - 96, G - 96 - NCONV); ph_gla_a(P, bid - 96, G - 96 - NCONV); ph_inproj<1>(P, 96 * GATE_KU + NCONV * CONV_GU + bid - 96, G - 96 - NCONV, 1 << 30, MR); } }
    else { ph_rwkv(P, l, bid, G); ph_s5scan(P, l, bid, G); ph_gla_a(P, bid, G); ph_inproj<1>(P, bid, G, 1 << 30, MR); ph_moe_convert(P, l, 2, 0, MOE_A); }
    XBAR(bar);)
    TPE(4) TPB(5)
    ph_gla_b(P, bid, G); ph_s5g1(P, l, bid, G); ph_comb(P, l, MR); ph_moe_convert(P, l, 0, MOE_A, MOE_A + (6144 - MOE_I - MOE_A) / 2);
    XBAR(bar);
    TPE(5) TPB(6)
    REP(PROBE_P6, ph_gla_c(P, l, bid, G, l == DEPTH - 1); ph_glu(P, MR);) ph_moe_convert(P, l, 1, MOE_A + (6144 - MOE_I - MOE_A) / 2, 6144 - MOE_I); XBAR(bar);
    TPE(6) TPB(7)
    REP(PROBE_MERGE1, ph_merge1(P, MR); XBAR(bar);)
    TPE(7) TPB(8)
    ph_merge2(P, l, MR);
    XBAR(bar);
    TPE(8) TPB(9)
    ph_route(P, l, MR);
    XBAR(bar);
    TPE(9) TPB(10)
    ph_slot(P, MR);
    XBAR(bar);
    TPE(10) TPB(11)
    ph_up(P); if (l + 1 < DEPTH) { ph_setup_s5_next(P, l + 1); ph_setup_queue(P, l + 1, 3, 0, stp::QA); } XBAR(bar);
    TPE(11) TPB(12)
    ph_down(P); if (l + 1 < DEPTH) ph_setup_queue(P, l + 1, 4, stp::QA, stp::QB); XBAR(bar);
    TPE(12)
    }
__global__ void __launch_bounds__(NTHREADS, 2) k_fused(Params P) {
    const int bid = blockIdx.x, G = gridDim.x;
    volatile LAS unsigned* xbw = (volatile LAS unsigned*)(LAS unsigned char*)(smem + LDS_BYTES - 16);
    if (threadIdx.x == 0) { xbw[0] = 0u; xbw[1] = 0u; xbw[2] = 0u; xbw[3] = 0u; }
    __syncthreads();
    const XcdBarrier bar = xcd_barrier_post(P.bar(), xbw);
    if (TPROBE && blockIdx.x == 0 && threadIdx.x == 0) { GAS unsigned long long* s = (GAS unsigned long long*)((GAS unsigned char*)P.ws + WS_TOTAL); s[0] = 0ull; }
    layer_body<0>(P, bar, bid, G);
    layer_body<1>(P, bar, bid, G);
    TPB(13)
    ph_rows<2>(P, 1);
    TPE(13)
    if (TPROBE && blockIdx.x == 0 && threadIdx.x == 0) { GAS unsigned long long* s = (GAS unsigned long long*)((GAS unsigned char*)P.ws + WS_TOTAL);
        const unsigned long long T = s[0] * TPMUL, t0 = __builtin_amdgcn_s_memrealtime();
        while (__builtin_amdgcn_s_memrealtime() - t0 < T) __builtin_amdgcn_s_sleep(32); }
}

extern "C" void kernel_launch(void* const* d_in, const int* in_sizes, int n_in, void* d_out, int out_size, void* d_ws, size_t ws_size, hipStream_t stream) {
    static int grid = 0;
    if (grid == 0) { int dev = 0, cus = 0; (void)hipGetDevice(&dev); (void)hipDeviceGetAttribute(&cus, hipDeviceAttributeMultiprocessorCount, dev); grid = cus > 0 ? cus : 256;
        (void)hipFuncSetAttribute((const void*)k_fused, hipFuncAttributeMaxDynamicSharedMemorySize, LDS_BYTES); }
    Params P{};
    for (int i = 0; i < 42; ++i) P.in[i] = (const float*)d_in[i];
    P.out = (float*)d_out;
    P.ws = (unsigned char*)d_ws;
    if (WS_TOTAL + 256 > ws_size || n_in != 42 || out_size != RL * D) { fprintf(stderr, "kernel_launch: workspace %zu < %zu or bad shapes\n", ws_size, (size_t)WS_TOTAL); return; }
    (void)hipMemsetAsync(P.ws + OFF_bar, 0, XCD_BAR_WORDS * sizeof(unsigned), stream);
    hipLaunchKernelGGL(k_fused, dim3(grid), dim3(NTHREADS), LDS_BYTES, stream, P);
}
```

```cpp
#include <hip/hip_runtime.h>
#include <stdint.h>
#include <stdio.h>

typedef _Float16 half_t;
typedef _Float16 h8 __attribute__((ext_vector_type(8)));
typedef _Float16 h4 __attribute__((ext_vector_type(4)));
typedef _Float16 h2 __attribute__((ext_vector_type(2)));
typedef float f4 __attribute__((ext_vector_type(4)));
typedef float f2 __attribute__((ext_vector_type(2)));

constexpr int D = 2048, NBATCH = 4, SEQ = 4096, CTXL = 256, DEPTH = 2;
constexpr int RL = NBATCH * SEQ, RC = NBATCH * CTXL, MT = RL + RC;
constexpr int TS = SEQ + CTXL;
constexpr int ADIM = 768, AH = 12, BDIM = 768, BKEY = 384, BH = 4, BHK = 96, BHV = 192, CDIM = 512, CGR = 32, CP = 64;
constexpr int CONV = 3840, NLO = 1792, NGT = 6144, INSRC = 11680, INPAD = 11776;
constexpr int LO_DW = 0, LO_DA = 128, LO_DG = 256, LO_BG = 384, LO_OG = 416, LO_U = 1184;
constexpr int NE = 16, DE = 1024;
constexpr int SLOTS = 38912;
constexpr int YCP = 768;
constexpr int S5ROWS = NBATCH * (TS / 16);
constexpr int NTHREADS = 512;
#ifndef PROBE_SETUP
#define PROBE_SETUP 1
#endif
#ifndef PROBE_SCAN
#define PROBE_SCAN 1
#endif
#ifndef PROBE_INPROJ
#define PROBE_INPROJ 1
#endif
#ifndef PROBE_CONVF
#define PROBE_CONVF 1
#endif
#ifndef PROBE_MOE
#define PROBE_MOE 1
#endif
#ifndef PROBE_MERGE1
#define PROBE_MERGE1 1
#endif
#ifndef PROBE_GLA
#define PROBE_GLA 1
#endif
#ifndef PROBE_RWKV
#define PROBE_RWKV 1
#endif
#ifndef GATE_KU
#define GATE_KU 1
#endif
#ifndef PROBE_SCANS
#define PROBE_SCANS 1
#endif
#ifndef RWKV_REP
#define RWKV_REP 1
#endif
#ifndef PROBE_CONV1
#define PROBE_CONV1 1
#endif
#ifndef PROBE_S5G2
#define PROBE_S5G2 1
#endif
#ifndef NCONV
#define NCONV 16
#define CONV_GU 6
#define MOE_I 768
#define MOE_A 2048
#endif
#ifndef PROBE_P6
#define PROBE_P6 1
#endif
#define REP_1(...) __VA_ARGS__
#define REP_2(...) __VA_ARGS__ __VA_ARGS__
#define REP_3(...) __VA_ARGS__ __VA_ARGS__ __VA_ARGS__
#define REP_CAT(a, b) a##b
#define REP_X(n, ...) REP_CAT(REP_, n)(__VA_ARGS__)
#define REP(n, ...) REP_X(n, __VA_ARGS__)
#ifndef PROBE_COMB
#define PROBE_COMB 1
#endif
constexpr int LDS_BYTES = 139264;

constexpr size_t al_(size_t x) { return (x + 255) & ~(size_t)255; }
constexpr size_t OFF_bar = 0;
constexpr size_t OFF_cnt = OFF_bar + al_(16384);
constexpr size_t OFF_blkcnt = OFF_cnt + al_(256);
constexpr size_t OFF_sidx = OFF_blkcnt + al_(1024 * NE * 4);
constexpr size_t OFF_MOD = OFF_sidx + al_((size_t)SLOTS * 4);
constexpr size_t OFF_Xc = OFF_MOD + al_((size_t)2 * 5 * 6 * D * 4);
constexpr size_t OFF_pos = OFF_Xc + al_((size_t)RC * D * 4);
constexpr size_t OFF_wsel = OFF_pos + al_((size_t)MT * 2 * 4);
constexpr size_t OFF_WinT = OFF_wsel + al_((size_t)MT * 2 * 4);
constexpr size_t OFF_PaT = OFF_WinT + al_((size_t)INPAD * D * 2);
constexpr size_t OFF_WoT = OFF_PaT + al_((size_t)3 * D * YCP * 2);
constexpr size_t OFF_W13T = OFF_WoT + al_((size_t)D * D * 2);
constexpr size_t OFF_W2T = OFF_W13T + al_((size_t)NE * 2 * DE * D * 2);
constexpr size_t OFF_GluT = OFF_W2T + al_((size_t)NE * D * DE * 2);
constexpr size_t OFF_MstT = OFF_GluT + al_((size_t)2 * CDIM * CDIM * 2);
constexpr size_t OFF_McatT = OFF_MstT + al_((size_t)CGR * 256 * 256 * 2);
constexpr size_t OFF_LW2T = OFF_McatT + al_((size_t)CGR * 256 * 512 * 2);
constexpr size_t OFF_LA2T = OFF_LW2T + al_((size_t)2 * ADIM * 64 * 2);
constexpr size_t OFF_LG2T = OFF_LA2T + al_((size_t)2 * ADIM * 64 * 2);
constexpr size_t OFF_LGLT = OFF_LG2T + al_((size_t)ADIM * 128 * 2);
constexpr size_t OFF_XinH = OFF_LGLT + al_((size_t)2 * BKEY * 64 * 2);
constexpr size_t OFF_H = OFF_XinH + al_((size_t)CGR * S5ROWS * 256 * 2);
constexpr size_t OFF_Pconv = OFF_H + al_((size_t)MT * D * 2);
constexpr size_t OFF_Plo = OFF_Pconv + al_((size_t)MT * CONV * 2);
constexpr size_t OFF_Pg = OFF_Plo + al_((size_t)MT * NLO * 2);
constexpr size_t OFF_F = OFF_Pg + al_((size_t)MT * NGT * 2);
constexpr size_t OFF_KK = OFF_F + al_((size_t)MT * CONV * 2);
constexpr int GLT = 2 * NBATCH * BH * (TS / 64);
constexpr size_t OFF_GS = OFF_KK + al_((size_t)MT * (ADIM * 5 + BKEY * 2) * 2);
constexpr size_t OFF_GQ = OFF_GS + al_((size_t)GLT * BHV * BHK * 2);
constexpr size_t OFF_GE = OFF_GQ + al_((size_t)GLT * 64 * BHK * 2);
constexpr size_t OFF_Sloc = OFF_GE + al_((size_t)GLT * BHK * 4);
constexpr size_t WS_TOTAL = OFF_Sloc + al_((size_t)CGR * S5ROWS * 256 * 4);
static_assert(WS_TOTAL <= (size_t)1416134720, "workspace must fit the guaranteed size (sum of the input bytes)");
static_assert((size_t)SLOTS * D * 2 <= (size_t)MT * (ADIM * 5 + BKEY * 2) * 2, "Hs must fit the feature region");
static_assert((size_t)SLOTS * D * 2 <= (size_t)MT * NGT * 2 && (size_t)SLOTS * DE * 2 <= (size_t)MT * CONV * 2, "Y / Hg must fit");
constexpr size_t OFF_Z = OFF_Pconv, OFF_O = OFF_Pconv + (size_t)2 * MT * ADIM * 2, OFF_Hg = OFF_Pconv, OFF_Y = OFF_Pg;
constexpr size_t OFF_YA = OFF_F, OFF_YB = OFF_YA + (size_t)MT * YCP * 2, OFF_YC = OFF_YB + (size_t)MT * YCP * 2, OFF_TC = OFF_YC + (size_t)MT * CDIM * 2;
constexpr size_t OFF_SW = OFF_KK + (size_t)MT * ADIM * 2, OFF_AA = OFF_SW + (size_t)2 * MT * ADIM * 2, OFF_GG = OFF_AA + (size_t)2 * MT * ADIM * 2, OFF_U = OFF_KK, OFF_Hs = OFF_KK;
constexpr size_t OFF_PbT = OFF_PaT + (size_t)D * YCP * 2, OFF_PcT = OFF_PbT + (size_t)D * YCP * 2;
#define GAS __attribute__((address_space(1)))
struct Params {
    const float* in[42];
    float* out;
    unsigned char* ws;
#define WSP(type, name) __device__ __forceinline__ type* name() const { GAS unsigned char* w = (GAS unsigned char*)ws; asm volatile("" : "+s"(w)); return (type*)(GAS type*)(w + OFF_##name); }
    WSP(unsigned, bar) WSP(int, cnt) WSP(int, blkcnt) WSP(int, sidx) WSP(float, MOD) WSP(float, Xc) WSP(int, pos) WSP(float, wsel) WSP(float, Sloc)
    WSP(half_t, WinT) WSP(half_t, PaT) WSP(half_t, PbT) WSP(half_t, PcT) WSP(half_t, WoT) WSP(half_t, W13T) WSP(half_t, W2T) WSP(half_t, GluT) WSP(half_t, MstT) WSP(half_t, McatT)
    WSP(half_t, LW2T) WSP(half_t, LA2T) WSP(half_t, LG2T) WSP(half_t, LGLT) WSP(half_t, XinH) WSP(half_t, H) WSP(half_t, Pconv) WSP(half_t, Plo) WSP(half_t, Pg) WSP(half_t, F)
    WSP(half_t, KK) WSP(half_t, SW) WSP(half_t, AA) WSP(half_t, GG) WSP(half_t, Z) WSP(half_t, O) WSP(half_t, TC) WSP(half_t, YA) WSP(half_t, YB) WSP(half_t, YC) WSP(half_t, U)
    WSP(half_t, Hg) WSP(half_t, Y) WSP(half_t, Hs) WSP(half_t, GS) WSP(half_t, GQ) WSP(float, GE)
#undef WSP
};
enum { I_X = 0, I_C, I_CTX, I_CCTX, I_MODW, I_MODB, I_N1G, I_N2G, I_WIN, I_CONVW, I_RKW0, I_RKW2, I_RKA0, I_RKA2, I_RKG2, I_RKKK, I_RKKA, I_RKRK, I_RKGNW, I_RKGNB,
       I_GLAA2, I_GLAAB, I_GLANG, I_S5LRE, I_S5LIM, I_S5LDT, I_S5BRE, I_S5BIM, I_S5CRE, I_S5CIM, I_S5D, I_S5GLU, I_PA, I_PB, I_PC, I_WOUT, I_RW, I_RB, I_W1, I_W3, I_W2, I_FG };

extern __shared__ __attribute__((aligned(16))) unsigned char smem[];

__device__ __forceinline__ float sigmoidf_(float x) { return 1.0f / (1.0f + __expf(-x)); }
__device__ __forceinline__ float siluf_(float x) { return x * sigmoidf_(x); }
__device__ __forceinline__ float wave_sum(float v) {
#pragma unroll
    for (int o = 1; o < 64; o <<= 1) v += __shfl_xor(v, o);
    return v;
}
template <int CTRL> __device__ __forceinline__ float dpp_f(float x) {
    return __builtin_bit_cast(float, __builtin_amdgcn_update_dpp(0, __builtin_bit_cast(int, x), CTRL, 0xf, 0xf, true));
}
__device__ __forceinline__ float red8(float x) { x += dpp_f<0xB1>(x); x += dpp_f<0x4E>(x); x += dpp_f<0x141>(x); return x; }
__device__ __forceinline__ float wave_sum_fast(float x);
__device__ __forceinline__ float red16(float x) { x = red8(x); x += dpp_f<0x140>(x); return x; }
__device__ __forceinline__ void lds_barrier() { asm volatile("s_waitcnt lgkmcnt(0)" ::: "memory"); __builtin_amdgcn_s_barrier(); asm volatile("" ::: "memory"); }
__device__ __forceinline__ float wave_sum_fast(float x) { x = red16(x); const int xi = __builtin_bit_cast(int, x);
    const float a = __builtin_bit_cast(float, __builtin_amdgcn_readlane(xi, 0)), b = __builtin_bit_cast(float, __builtin_amdgcn_readlane(xi, 16));
    const float c = __builtin_bit_cast(float, __builtin_amdgcn_readlane(xi, 32)), d = __builtin_bit_cast(float, __builtin_amdgcn_readlane(xi, 48)); return (a + b) + (c + d); }
__device__ __forceinline__ int modrow_of(int row) { return row < RL ? (row >> 12) : 4; }
__device__ __forceinline__ float* xrow_ptr(const Params& P, int row) { return row < RL ? P.out + (size_t)row * D : P.Xc() + (size_t)(row - RL) * D; }
__device__ __forceinline__ const float* pin(int i);
__device__ __forceinline__ const float* xsrc_ptr(const Params& P, int row, int l) {
    if (l == 0) return row < RL ? pin(I_X) + (size_t)row * D : pin(I_CTX) + (size_t)(row - RL) * D;
    return xrow_ptr(P, row);
}
__device__ __forceinline__ int tokrow(int d, int b, int s) {
    if (s < CTXL) return RL + b * CTXL + (d ? (CTXL - 1 - s) : s);
    const int t = s - CTXL; return b * SEQ + (d ? (SEQ - 1 - t) : t);
}
__device__ __forceinline__ int s5_block_row0(int b, int n) { return n < 16 ? RL + b * CTXL + n * 16 : b * SEQ + (n - 16) * 16; }
__device__ __forceinline__ h4 to_h4(f4 v) { h4 r; r[0] = (half_t)v[0]; r[1] = (half_t)v[1]; r[2] = (half_t)v[2]; r[3] = (half_t)v[3]; return r; }

__device__ __forceinline__ int tid_() { int t = threadIdx.x; asm volatile("" : "+v"(t)); return t; }
__device__ __forceinline__ const float* pin(int i) { asm volatile("" : "+s"(i)); const float* p = ((const float* const __attribute__((address_space(4)))*)__builtin_amdgcn_kernarg_segment_ptr())[i];
    return (const float*)(const GAS float*)p; }
__device__ __forceinline__ int wid_of(int tid) { return __builtin_amdgcn_readfirstlane(tid >> 6); }
__device__ __forceinline__ int bid_() { int b = blockIdx.x; asm volatile("" : "+s"(b)); return b; }
#define XB_TMO      128
#define XB_XCNT(j)  (256  + 64 * (j))
#define XB_XSUB(j)  (1280 + 64 * (j))
#define XB_XGEN(j)  (2304 + 64 * (j))
#define XB_TOP      3328
#define XB_TOPGEN   3392
#define XCD_BAR_WORDS 3456
#define XB_SPIN_CAP (1u << 22)
#define LAS __attribute__((address_space(3)))

__device__ __forceinline__ unsigned xb_ld(unsigned* p)              { return __hip_atomic_load(p, __ATOMIC_RELAXED, __HIP_MEMORY_SCOPE_AGENT); }
__device__ __forceinline__ unsigned xb_add(unsigned* p, unsigned v) { return __hip_atomic_fetch_add(p, v, __ATOMIC_RELAXED, __HIP_MEMORY_SCOPE_AGENT); }
__device__ __forceinline__ unsigned xb_xcc_id() { return (unsigned)__builtin_amdgcn_s_getreg((3 << 11) | 20) & 0xFu; }
#define XB_SPIN(cond, bar) do { unsigned _sp = 0; while (cond) { __builtin_amdgcn_s_sleep(1); \
    if ((++_sp & 255u) == 0u) { if (xb_ld(&(bar)[XB_TMO])) break; if (_sp > XB_SPIN_CAP) { atomicAdd(&(bar)[XB_TMO], 1u); break; } } } } while (0)

struct XcdBarrier {
    unsigned* bar; unsigned x;
    volatile LAS unsigned* st;
};

__device__ __forceinline__ XcdBarrier xcd_barrier_post(unsigned* bar, volatile LAS unsigned* st) {
    XcdBarrier b; b.bar = bar; b.x = xb_xcc_id(); b.st = st;
    if (threadIdx.x == 0) (void)xb_add(&bar[XB_XCNT(b.x)], 1u);
    return b;
}
__device__ __forceinline__ void xcd_barrier_complete(unsigned* bar, unsigned x, unsigned& nloc, unsigned& nx) {
    asm volatile("" : "+s"(x));
    const unsigned G = gridDim.x * gridDim.y * gridDim.z;
    unsigned sum, cnt, mine, sp = 0u;
    for (;;) {
        sum = 0u; cnt = 0u; mine = 0u;
#pragma unroll
        for (unsigned j = 0; j < 16; ++j) { const unsigned c = xb_ld(&bar[XB_XCNT(j)]); sum += c; cnt += (c > 0u) ? 1u : 0u; mine = (j == x) ? c : mine; }
        if (sum == G) break;
        __builtin_amdgcn_s_sleep(1);
        if ((++sp & 255u) == 0u) { if (xb_ld(&bar[XB_TMO])) break; if (sp > XB_SPIN_CAP) { atomicAdd(&bar[XB_TMO], 1u); break; } }
    }
    nloc = mine > 0u ? mine : 1u; nx = cnt > 0u ? cnt : 1u;
}

__device__ __forceinline__ void xcd_barrier(const XcdBarrier& b) {
    asm volatile("s_waitcnt vmcnt(0)" ::: "memory");
    __syncthreads();
    if (threadIdx.x == 0) {
        __attribute__((address_space(1))) unsigned* gbar = (__attribute__((address_space(1))) unsigned*)b.bar; asm volatile("" : "+s"(gbar));
        unsigned* bar = (unsigned*)gbar;
        __builtin_amdgcn_s_waitcnt(0);
        unsigned nloc = b.st[0], nx = b.st[1];
        if (nloc == 0u) { xcd_barrier_complete(bar, b.x, nloc, nx); b.st[0] = nloc; b.st[1] = nx; }
        const unsigned old = xb_add(&bar[XB_XSUB(b.x)], 1u);
        const unsigned gen = old / nloc;
        if (old + 1u == (gen + 1u) * nloc) {
            __builtin_amdgcn_fence(__ATOMIC_RELEASE, "agent");
            asm volatile("s_waitcnt vmcnt(0)" ::: "memory");
            const unsigned og = xb_add(&bar[XB_TOP], 1u);
            const unsigned tg = og / nx;
            if (og + 1u == (tg + 1u) * nx) xb_add(&bar[XB_TOPGEN], 1u);
            else XB_SPIN(xb_ld(&bar[XB_TOPGEN]) == tg, bar);
            __builtin_amdgcn_fence(__ATOMIC_ACQUIRE, "agent");
            xb_add(&bar[XB_XGEN(b.x)], 1u);
            asm volatile("s_waitcnt vmcnt(0)" ::: "memory");
        } else {
            XB_SPIN(xb_ld(&bar[XB_XGEN(b.x)]) == gen, bar);
            __builtin_amdgcn_fence(__ATOMIC_ACQUIRE, "agent");
            asm volatile("s_waitcnt vmcnt(0)" ::: "memory");
        }
    }
    __syncthreads();
}


constexpr int GST = 72;
constexpr int GEMM_LDS = 2 * 2 * 128 * GST * 2;
template <class AF, class BF>
__device__ __forceinline__ void gemm_tile(int nk, AF afn, BF bfn, f4 (&acc)[4][2]) {
    half_t* As = (half_t*)smem; half_t* Bs = As + 2 * 128 * GST;
    const int tid = tid_(), lane = tid & 63, w = wid_of(tid), wm = w >> 2, wn = w & 3;
    const int pr0 = tid >> 3, pk = (tid & 7) * 8;
    uint4 ra[2], rb[2];
#pragma unroll
    for (int i = 0; i < 2; ++i) { ra[i] = afn(pr0 + 64 * i, pk); rb[i] = bfn(pr0 + 64 * i, pk); }
    __syncthreads();
#pragma unroll
    for (int i = 0; i < 2; ++i) { *(uint4*)(As + (pr0 + 64 * i) * GST + pk) = ra[i]; *(uint4*)(Bs + (pr0 + 64 * i) * GST + pk) = rb[i]; }
    __syncthreads();
    for (int kt = 0; kt < nk; ++kt) {
        const int cur = kt & 1;
        if (kt + 1 < nk) {
#pragma unroll
            for (int i = 0; i < 2; ++i) { ra[i] = afn(pr0 + 64 * i, (kt + 1) * 64 + pk); rb[i] = bfn(pr0 + 64 * i, (kt + 1) * 64 + pk); }
        }
        const half_t* Ac = As + cur * 128 * GST; const half_t* Bc = Bs + cur * 128 * GST;
#pragma unroll
        for (int ks = 0; ks < 2; ++ks) {
            h8 af[4], bf[2];
#pragma unroll
            for (int mi = 0; mi < 4; ++mi) af[mi] = *(const h8*)(Ac + (64 * wm + 16 * mi + (lane & 15)) * GST + 32 * ks + 8 * (lane >> 4));
#pragma unroll
            for (int ni = 0; ni < 2; ++ni) bf[ni] = *(const h8*)(Bc + (32 * wn + 16 * ni + (lane & 15)) * GST + 32 * ks + 8 * (lane >> 4));
#pragma unroll
            for (int mi = 0; mi < 4; ++mi)
#pragma unroll
                for (int ni = 0; ni < 2; ++ni) acc[mi][ni] = __builtin_amdgcn_mfma_f32_16x16x32_f16(bf[ni], af[mi], acc[mi][ni], 0, 0, 0);
        }
        if (kt + 1 < nk) {
            half_t* An = As + (cur ^ 1) * 128 * GST; half_t* Bn = Bs + (cur ^ 1) * 128 * GST;
#pragma unroll
            for (int i = 0; i < 2; ++i) { *(uint4*)(An + (pr0 + 64 * i) * GST + pk) = ra[i]; *(uint4*)(Bn + (pr0 + 64 * i) * GST + pk) = rb[i]; }
        }
        __syncthreads();
    }
}
__device__ __forceinline__ void acc_zero(f4 (&acc)[4][2]) {
#pragma unroll
    for (int mi = 0; mi < 4; ++mi)
#pragma unroll
        for (int ni = 0; ni < 2; ++ni) acc[mi][ni] = (f4){0.f, 0.f, 0.f, 0.f};
}
template <class FN> __device__ __forceinline__ void acc_foreach(const f4 (&acc)[4][2], FN fn) {
    const int lane = tid_() & 63, w = wid_of(tid_()), wm = w >> 2, wn = w & 3;
#pragma unroll
    for (int mi = 0; mi < 4; ++mi)
#pragma unroll
        for (int ni = 0; ni < 2; ++ni) fn(64 * wm + 16 * mi + (lane & 15), 32 * wn + 16 * ni + 4 * (lane >> 4), acc[mi][ni]);
}
template <class LD, class ST> __device__ __forceinline__ void acc_foreach2(const f4 (&acc)[4][2], LD ld, ST st) {
    const int lane = tid_() & 63, w = wid_of(tid_()), wm = w >> 2, wn = w & 3;
    decltype(ld(0, 0)) tmp[4][2];
#pragma unroll
    for (int mi = 0; mi < 4; ++mi)
#pragma unroll
        for (int ni = 0; ni < 2; ++ni) tmp[mi][ni] = ld(64 * wm + 16 * mi + (lane & 15), 32 * wn + 16 * ni + 4 * (lane >> 4));
#pragma unroll
    for (int mi = 0; mi < 4; ++mi)
#pragma unroll
        for (int ni = 0; ni < 2; ++ni) st(64 * wm + 16 * mi + (lane & 15), 32 * wn + 16 * ni + 4 * (lane >> 4), acc[mi][ni], tmp[mi][ni]);
}
__device__ __forceinline__ uint4 ld16(const half_t* p) { return *(const uint4*)p; }
__device__ __forceinline__ uint4 zero16() { return make_uint4(0u, 0u, 0u, 0u); }

namespace pg8 {
constexpr int BM = 256, BK = 64, HALF = 128, HTB = HALF * BK * 2, STAGE_BYTES = 8 * HTB, NXCD = 8, WGM = 8;
__host__ __device__ __forceinline__ int lds_byte(int r, int c) { const int st = (r >> 4) * 2 + (c >> 5), rr = r & 15, cc = c & 31, ob = rr * 64 + cc * 2; return st * 1024 + (ob ^ (((ob >> 9) & 1) << 5)); }
__host__ __device__ __forceinline__ void stage_rc(int b, int& R, int& C) { const int st = b / 1024, sb = b % 1024, swz = sb ^ (((sb >> 9) & 1) << 5); R = (st >> 1) * 16 + swz / 64; C = (st & 1) * 32 + (swz % 64) / 2; }
__host__ __device__ __forceinline__ int perm32(int rho) { const int n = rho >> 4, i = rho & 15; return 8 * (i >> 2) + 4 * n + (i & 3); }
struct Unit { const char* A; const char* B; int pm, pn; };
struct TileOrder {
    int nM, nN, nwg, G, c, lim;
    __device__ __forceinline__ void init(int nM_, int nN_, int G_, int c_, int lim_ = 1 << 30) { nM = nM_; nN = nN_; nwg = nM * nN; G = G_; c = c_; lim = lim_ < nwg ? lim_ : nwg; }
    __device__ __forceinline__ bool tile(int i, int& pm, int& pn) const {
        const long L = (long)i * G + c; if (L >= lim) return false;
        int wgid = (int)L; { const int q = nwg / NXCD, r = nwg % NXCD, xcd = wgid % NXCD, off = wgid / NXCD; wgid = (xcd < r ? xcd * (q + 1) : r * (q + 1) + (xcd - r) * q) + off; }
        const int nig = WGM * nN, gid = wgid / nig, fm = gid * WGM, gsz = (nM - fm) < WGM ? (nM - fm) : WGM;
        pm = fm + ((wgid % nig) % gsz); pn = (wgid % nig) / gsz; return true;
    }
};
typedef f4 Acc[2][2][4][2];
template <bool PERM = false, bool GATHER = false, class Sched, class Epi>
__device__ __forceinline__ void gemm_phase(const int K, const Sched& S, const Epi& E, const int* gidx = nullptr) {
    LAS unsigned char* lds = (LAS unsigned char*)smem;
    const int tid = tid_(), wid = __builtin_amdgcn_readfirstlane(tid >> 6), lane = tid & 63, wr = wid >> 2, wc = wid & 3, fr = lane & 15, fq = lane >> 4;
    const int nt = K / BK;
    unsigned voff[2], voffB[2];
#pragma unroll
    for (int i = 0; i < 2; ++i) { int R, C; stage_rc(tid * 16 + i * 8192, R, C); const int Rb = PERM ? ((R & ~31) + perm32(R & 31)) : R; voff[i] = (unsigned)(R * K + C) * 2u; voffB[i] = (unsigned)(Rb * K + C) * 2u; }
    const size_t kstep = (size_t)(BK * 2);
    const size_t hstep = (size_t)HALF * K * 2;
    const unsigned ldsw = (unsigned)wid * 1024u;
    const int aoff = lds_byte(wr * 64 + fr, fq * 8), boff = lds_byte(wc * 32 + fr, fq * 8);
#define PG8_SA(b, h) (((b) * 2 + (h)) * HTB)
#define PG8_SB(b, h) ((4 + (b) * 2 + (h)) * HTB)
#define PG8_STAGEV(bufoff, gbase, vo) do { _Pragma("unroll") for (int _i = 0; _i < 2; ++_i) \
        __builtin_amdgcn_global_load_lds((const unsigned*)((const char*)(gbase) + vo[_i]), (LAS unsigned*)(lds + (bufoff) + ldsw + _i * 8192), 16, 0, 0); } while (0)
#define PG8_STAGE(bufoff, gbase) PG8_STAGEV(bufoff, gbase, voff)
#define PG8_STAGEA(bufoff, gbase, h) do { if constexpr (GATHER) PG8_STAGEV(bufoff, gbase, go[h]); else PG8_STAGEV(bufoff, (gbase) + (h) * hstep, voff); } while (0)
#define PG8_GOFF(dst, pm_) do { if constexpr (GATHER) { _Pragma("unroll") for (int _h = 0; _h < 2; ++_h) _Pragma("unroll") for (int _i = 0; _i < 2; ++_i) { int R_, C_; stage_rc(tid * 16 + _i * 8192, R_, C_); \
        dst[_h][_i] = ((unsigned)gidx[(pm_) * 256 + _h * HALF + R_] * (unsigned)K + (unsigned)C_) * 2u; } } } while (0)
#define PG8_STAGEB(bufoff, gbase) PG8_STAGEV(bufoff, gbase, voffB)
#define PG8_LDA(dst, b, h) do { _Pragma("unroll") for (int m = 0; m < 4; ++m) _Pragma("unroll") for (int k = 0; k < 2; ++k) dst[m][k] = *(const LAS h8*)(lds + PG8_SA(b, h) + aoff + m * 2048 + k * 1024); } while (0)
#define PG8_LDB(dst, b, h) do { _Pragma("unroll") for (int n = 0; n < 2; ++n) _Pragma("unroll") for (int k = 0; k < 2; ++k) dst[n][k] = *(const LAS h8*)(lds + PG8_SB(b, h) + boff + n * 2048 + k * 1024); } while (0)
#define PG8_MMA(ai, bj, At, Bt) do { __builtin_amdgcn_s_setprio(1); _Pragma("unroll") for (int m = 0; m < 4; ++m) _Pragma("unroll") for (int n = 0; n < 2; ++n) _Pragma("unroll") for (int k = 0; k < 2; ++k) \
        acc[ai][bj][m][n] = __builtin_amdgcn_mfma_f32_16x16x32_f16(Bt[n][k], At[m][k], acc[ai][bj][m][n], 0, 0, 0); __builtin_amdgcn_s_setprio(0); } while (0)
#define PG8_WAIT_V(n) asm volatile("s_waitcnt vmcnt(" #n ")" ::: "memory")
#define PG8_WAIT_L(n) asm volatile("s_waitcnt lgkmcnt(" #n ")" ::: "memory")
#define PG8_BAR __builtin_amdgcn_s_barrier()
#define PG8_SCHED __builtin_amdgcn_sched_barrier(0)
    Unit cur, nxt; int ui = 0;
    if (!S.next(0, cur)) return;
    unsigned go[2][2], ngo[2][2];
    PG8_GOFF(go, cur.pm);
    Acc acc;
#pragma unroll
    for (int a = 0; a < 2; ++a)
#pragma unroll
        for (int b = 0; b < 2; ++b)
#pragma unroll
            for (int m = 0; m < 4; ++m)
#pragma unroll
                for (int n = 0; n < 2; ++n) acc[a][b][m][n] = (f4){0.f, 0.f, 0.f, 0.f};
    h8 At[4][2], B0[2][2], B1[2][2];
    const char* cA = cur.A; const char* cB = cur.B;
    PG8_STAGEB(PG8_SB(0, 0), cB); PG8_STAGEA(PG8_SA(0, 0), cA, 0); PG8_STAGEB(PG8_SB(0, 1), cB + hstep); PG8_STAGEA(PG8_SA(0, 1), cA, 1);
    if (wr == 1) PG8_BAR;
    PG8_WAIT_V(4); PG8_BAR;
    PG8_STAGEB(PG8_SB(1, 0), cB + kstep); PG8_STAGEA(PG8_SA(1, 0), cA + kstep, 0); PG8_STAGEB(PG8_SB(1, 1), cB + hstep + kstep);
    PG8_WAIT_V(6); PG8_BAR;
    for (;;) {
        const bool has_next = S.next(ui + 1, nxt);
        const char* nA = has_next ? nxt.A : cA; const char* nB = has_next ? nxt.B : cB;
        if constexpr (GATHER) { if (has_next) PG8_GOFF(ngo, nxt.pm); else {
#pragma unroll
            for (int _h = 0; _h < 2; ++_h) { ngo[_h][0] = go[_h][0]; ngo[_h][1] = go[_h][1]; } } }
        for (int t = 0; t < nt; t += 2) {
            const bool last = (t == nt - 2);
            const char* a1 = cA + (size_t)(t + 1) * kstep;
            const char* a2 = last ? nA : cA + (size_t)(t + 2) * kstep; const char* b2 = last ? nB : cB + (size_t)(t + 2) * kstep;
            const char* a3 = a2 + kstep; const char* b3 = b2 + kstep;
            PG8_LDB(B0, 0, 0); PG8_SCHED; PG8_LDA(At, 0, 0); PG8_STAGEA(PG8_SA(1, 1), a1, 1);
            if constexpr (GATHER) { if (last) { asm volatile("" ::: "memory");
#pragma unroll
                for (int _h = 0; _h < 2; ++_h) { go[_h][0] = ngo[_h][0]; go[_h][1] = ngo[_h][1]; } } }
            PG8_WAIT_L(8); PG8_BAR; PG8_WAIT_L(0); PG8_MMA(0, 0, At, B0); PG8_BAR; PG8_SCHED;
            PG8_LDB(B1, 0, 1); PG8_STAGEB(PG8_SB(0, 0), b2);
            PG8_BAR; PG8_WAIT_L(0); PG8_MMA(0, 1, At, B1); PG8_BAR;
            PG8_LDA(At, 0, 1); PG8_STAGEA(PG8_SA(0, 0), a2, 0);
            PG8_BAR; PG8_WAIT_L(0); PG8_MMA(1, 0, At, B0); PG8_BAR; PG8_SCHED;
            PG8_STAGEB(PG8_SB(0, 1), b2 + hstep);
            PG8_WAIT_V(6); PG8_BAR; PG8_MMA(1, 1, At, B1); PG8_BAR;
            PG8_LDB(B0, 1, 0); PG8_SCHED; PG8_LDA(At, 1, 0); PG8_STAGEA(PG8_SA(0, 1), a2, 1);
            PG8_WAIT_L(8); PG8_BAR; PG8_WAIT_L(0); PG8_MMA(0, 0, At, B0); PG8_BAR; PG8_SCHED;
            PG8_LDB(B1, 1, 1); PG8_STAGEB(PG8_SB(1, 0), b3);
            PG8_BAR; PG8_WAIT_L(0); PG8_MMA(0, 1, At, B1); PG8_BAR;
            PG8_LDA(At, 1, 1); PG8_STAGEA(PG8_SA(1, 0), a3, 0);
            PG8_BAR; PG8_WAIT_L(0); PG8_MMA(1, 0, At, B0); PG8_BAR; PG8_SCHED;
            PG8_STAGEB(PG8_SB(1, 1), b3 + hstep);
            PG8_WAIT_V(6); PG8_BAR; PG8_MMA(1, 1, At, B1); PG8_BAR;
        }
        E(acc, cur, wr, wc, fr, fq);
        if (!has_next) break;
#pragma unroll
        for (int a = 0; a < 2; ++a)
#pragma unroll
            for (int b = 0; b < 2; ++b)
#pragma unroll
                for (int m = 0; m < 4; ++m)
#pragma unroll
                    for (int n = 0; n < 2; ++n) acc[a][b][m][n] = (f4){0.f, 0.f, 0.f, 0.f};
        cur = nxt; cA = nA; cB = nB; ++ui;
    }
    PG8_WAIT_V(0);
    if (wr == 0) PG8_BAR;
    PG8_BAR;
#undef PG8_SA
#undef PG8_SB
#undef PG8_STAGE
#undef PG8_STAGEB
#undef PG8_STAGEA
#undef PG8_GOFF
#undef PG8_STAGEV
#undef PG8_LDA
#undef PG8_LDB
#undef PG8_MMA
#undef PG8_WAIT_V
#undef PG8_WAIT_L
#undef PG8_BAR
#undef PG8_SCHED
}
template <class FN> __device__ __forceinline__ void foreach_frag(const Acc& acc, int wr, int wc, int fr, int fq, FN fn) {
#pragma unroll
    for (int ai = 0; ai < 2; ++ai)
#pragma unroll
        for (int m = 0; m < 4; ++m)
        { int row = ai * HALF + wr * 64 + m * 16 + fr; asm volatile("" : "+v"(row));
#pragma unroll
            for (int bj = 0; bj < 2; ++bj)
#pragma unroll
                for (int n = 0; n < 2; ++n) fn(row, bj * HALF + wc * 32 + n * 16 + 4 * fq, acc[ai][bj][m][n]); }
}
template <class FN> __device__ __forceinline__ void foreach_frag8(const Acc& acc, int wr, int wc, int fr, int fq, FN fn) {
#pragma unroll
    for (int ai = 0; ai < 2; ++ai)
#pragma unroll
        for (int m = 0; m < 4; ++m)
        { int row = ai * HALF + wr * 64 + m * 16 + fr; asm volatile("" : "+v"(row));
#pragma unroll
            for (int bj = 0; bj < 2; ++bj) fn(row, bj * HALF + wc * 32 + 8 * fq, acc[ai][bj][m][0], acc[ai][bj][m][1]); }
}
template <class LD, class ST> __device__ __forceinline__ void foreach_frag2(const Acc& acc, int wr, int wc, int fr, int fq, LD ld, ST st) {
#pragma unroll
    for (int ai = 0; ai < 2; ++ai)
#pragma unroll
        for (int mp = 0; mp < 2; ++mp) {
            int row0 = ai * HALF + wr * 64 + mp * 32 + fr; asm volatile("" : "+v"(row0));
            decltype(ld(0, 0)) tmp[2][2][2];
#pragma unroll
            for (int mm = 0; mm < 2; ++mm)
#pragma unroll
                for (int bj = 0; bj < 2; ++bj)
#pragma unroll
                    for (int n = 0; n < 2; ++n) tmp[mm][bj][n] = ld(row0 + 16 * mm, bj * HALF + wc * 32 + n * 16 + 4 * fq);
#pragma unroll
            for (int mm = 0; mm < 2; ++mm)
#pragma unroll
                for (int bj = 0; bj < 2; ++bj)
#pragma unroll
                    for (int n = 0; n < 2; ++n) st(row0 + 16 * mm, bj * HALF + wc * 32 + n * 16 + 4 * fq, acc[ai][bj][2 * mp + mm][n], tmp[mm][bj][n]);
        }
}
template <class LD, class ST> __device__ __forceinline__ void foreach_frag2w(const Acc& acc, int wr, int wc, int fr, int fq, LD ld, ST st) {
#pragma unroll
    for (int ai = 0; ai < 2; ++ai) {
        int row0 = ai * HALF + wr * 64 + fr; asm volatile("" : "+v"(row0));
        decltype(ld(0, 0)) tmp[4][2][2];
#pragma unroll
        for (int m = 0; m < 4; ++m)
#pragma unroll
            for (int bj = 0; bj < 2; ++bj)
#pragma unroll
                for (int n = 0; n < 2; ++n) tmp[m][bj][n] = ld(row0 + 16 * m, bj * HALF + wc * 32 + n * 16 + 4 * fq);
#pragma unroll
        for (int m = 0; m < 4; ++m)
#pragma unroll
            for (int bj = 0; bj < 2; ++bj)
#pragma unroll
                for (int n = 0; n < 2; ++n) st(row0 + 16 * m, bj * HALF + wc * 32 + n * 16 + 4 * fq, acc[ai][bj][m][n], tmp[m][bj][n]);
    }
}
template <class FN> __device__ __forceinline__ void foreach_pair(const Acc& acc, int wr, int wc, int fr, int fq, FN fn) {
#pragma unroll
    for (int ai = 0; ai < 2; ++ai)
#pragma unroll
        for (int m = 0; m < 4; ++m)
        { int row = ai * HALF + wr * 64 + m * 16 + fr; asm volatile("" : "+v"(row));
#pragma unroll
            for (int bj = 0; bj < 2; ++bj) fn(row, bj * 64 + wc * 16 + 4 * fq, acc[ai][bj][m][0], acc[ai][bj][m][1]); }
}
}

__device__ __forceinline__ void ph_prologue(const Params& P) {
    const int tid = tid_(), G = gridDim.x, bid = bid_();
    float* cs = (float*)smem;
    float* red = cs + 5 * D;
    for (int i = tid; i < 5 * D; i += NTHREADS) { const int r = i / D, k = i % D; const float v = r < 4 ? pin(I_C)[r * D + k] : pin(I_CCTX)[k]; cs[i] = siluf_(v); }
    __syncthreads();
    const int lane = tid & 63, w = wid_of(tid);
    for (int t = bid; t < 2 * 96; t += G) {
        const int l = t / 96, n0 = (t % 96) * 128;
        const float* W = pin(I_MODW) + (size_t)l * D * (6 * D) + n0 + 2 * lane;
        float a[5][2];
#pragma unroll
        for (int r = 0; r < 5; ++r) { a[r][0] = 0.f; a[r][1] = 0.f; }
#pragma unroll 16
        for (int k = w * 256; k < w * 256 + 256; ++k) {
            const f2 wv = *(const f2*)(W + (size_t)k * (6 * D));
#pragma unroll
            for (int r = 0; r < 5; ++r) { const float c = cs[r * D + k]; a[r][0] += c * wv[0]; a[r][1] += c * wv[1]; }
        }
#pragma unroll
        for (int r = 0; r < 5; ++r) { red[(w * 5 + r) * 128 + 2 * lane] = a[r][0]; red[(w * 5 + r) * 128 + 2 * lane + 1] = a[r][1]; }
        __syncthreads();
        for (int i = tid; i < 5 * 128; i += NTHREADS) {
            const int r = i / 128, n = i % 128; float s = 0.f;
#pragma unroll
            for (int ww = 0; ww < 8; ++ww) s += red[(ww * 5 + r) * 128 + n];
            P.MOD()[((size_t)l * 5 + r) * (6 * D) + n0 + n] = s + pin(I_MODB)[(size_t)l * 6 * D + n0 + n];
        }
        __syncthreads();
    }
}

template <int KT = 1, class CF> __device__ __forceinline__ void convert_tile(half_t* dst, int K, int ld, int tn, int tk, CF colptr, int kmax = 1 << 30) {
    float* st = (float*)smem;
    const int tid = tid_(), n0 = tn * 64, k0 = tk * 64 * KT;
    {
        const int nl = tid & 63, kk = wid_of(tid); bool ok = true; const float* cp = colptr(n0 + nl, ok);
        float v[8 * KT];
#pragma unroll
        for (int i = 0; i < 8 * KT; ++i) { const int k = kk + 8 * i; const bool kin = (k0 + k) < kmax; v[i] = cp[(size_t)(kin ? k0 + k : 0) * ld]; v[i] = (ok && kin) ? v[i] : 0.f; }
#pragma unroll
        for (int i = 0; i < 8 * KT; ++i) st[(kk + 8 * i) * 65 + nl] = v[i];
    }
    __syncthreads();
    {
        const int nl = tid >> 3, kc = (tid & 7) * 8;
#pragma unroll
        for (int j = 0; j < KT; ++j) { h8 v;
#pragma unroll
            for (int i = 0; i < 8; ++i) v[i] = (half_t)st[(64 * j + kc + i) * 65 + nl];
            *(h8*)(dst + (size_t)(n0 + nl) * K + k0 + 64 * j + kc) = v; }
    }
    __syncthreads();
}
template <class CF> __device__ __forceinline__ void convert_wide(half_t* dst, int K, int ld, int tn, int tk, CF colptr4) {
    float* st = (float*)smem;
    const int tid = tid_(), n0 = tn * 256, k0 = tk * 64;
    {
        const int ng = (tid & 63) * 4, kk = wid_of(tid); bool ok = true; const float* cp = colptr4(n0 + ng, ok);
        f4 v[8];
#pragma unroll
        for (int i = 0; i < 8; ++i) { v[i] = *(const f4*)(cp + (size_t)(k0 + kk + 8 * i) * ld); if (!ok) v[i] = (f4){0.f, 0.f, 0.f, 0.f}; }
#pragma unroll
        for (int i = 0; i < 8; ++i) { const int k = kk + 8 * i; *(f4*)(st + k * 260 + (ng ^ (8 * ((k >> 3) & 3)))) = v[i]; }
    }
    __syncthreads();
#pragma unroll
    for (int j = 0; j < 4; ++j) { const int pidx = tid + NTHREADS * j, nl = pidx >> 3, kc = (pidx & 7) * 8, nsw = nl ^ (8 * ((kc >> 3) & 3)); h8 v;
#pragma unroll
        for (int i = 0; i < 8; ++i) v[i] = (half_t)st[(kc + i) * 260 + nsw];
        *(h8*)(dst + (size_t)(n0 + nl) * K + k0 + kc) = v; }
    __syncthreads();
}
namespace stp {
constexpr int T_WIN = (INPAD / 256) * (D / 64), T_PA = (D / 64) * (ADIM / 64), T_PB = T_PA, T_PC = (D / 64) * (CDIM / 64), T_WO = (D / 256) * (D / 64);
constexpr int T_LW = 2 * (ADIM / 64), T_LA = T_LW, T_LG = (ADIM / 64) * 2, T_LL = 2 * (BKEY / 64);
constexpr int T_GLU = (2 * CDIM / 64) * (CDIM / 64);
constexpr int T_ALL = T_WIN + T_PA + T_PB + T_PC + T_WO + T_GLU + T_LW + T_LA + T_LG + T_LL;
constexpr int QA = 1536, QB = 2304;
}
__device__ __forceinline__ void setup_task(const Params& P, int l_in, int t) {
    using namespace stp;
        int r = t, l = l_in; asm volatile("" : "+s"(l));
        if (r < T_WIN) { const float* src = pin(I_WIN) + (size_t)l * D * INSRC;
            convert_wide(P.WinT(), D, INSRC, r / (D / 64), r % (D / 64), [&](int n, bool& ok) -> const float* { ok = !(n >= 5536 && n < 5632); return src + (n < 5536 ? n : (n < 5632 ? 0 : n - 96)); }); return; } r -= T_WIN;
        if (r < T_PA) { const float* src = pin(I_PA) + (size_t)l * ADIM * D; convert_tile(P.PaT(), ADIM, D, r / (ADIM / 64), r % (ADIM / 64), [&](int n, bool&) -> const float* { return src + n; }); return; } r -= T_PA;
        if (r < T_PB) { const float* src = pin(I_PB) + (size_t)l * BDIM * D; convert_tile(P.PbT(), BDIM, D, r / (BDIM / 64), r % (BDIM / 64), [&](int n, bool&) -> const float* { return src + n; }); return; } r -= T_PB;
        if (r < T_PC) { const float* src = pin(I_PC) + (size_t)l * CDIM * D; convert_tile(P.PcT(), CDIM, D, r / (CDIM / 64), r % (CDIM / 64), [&](int n, bool&) -> const float* { return src + n; }); return; } r -= T_PC;
        if (r < T_LW) { const int d = r / (ADIM / 64); const float* src = pin(I_RKW2) + (size_t)(l * 2 + d) * 64 * ADIM; convert_tile(P.LW2T() + (size_t)d * ADIM * 64, 64, ADIM, r % (ADIM / 64), 0, [&](int n, bool&) -> const float* { return src + n; }); return; } r -= T_LW;
        if (r < T_LA) { const int d = r / (ADIM / 64); const float* src = pin(I_RKA2) + (size_t)(l * 2 + d) * 64 * ADIM; convert_tile(P.LA2T() + (size_t)d * ADIM * 64, 64, ADIM, r % (ADIM / 64), 0, [&](int n, bool&) -> const float* { return src + n; }); return; } r -= T_LA;
        if (r < T_LG) { const float* src = pin(I_RKG2) + (size_t)l * 128 * ADIM; convert_tile(P.LG2T(), 128, ADIM, r >> 1, r & 1, [&](int n, bool&) -> const float* { return src + n; }); return; } r -= T_LG;
        if (r < T_LL) { const int d = r / (BKEY / 64); const float* src = pin(I_GLAA2) + (size_t)(l * 2 + d) * 16 * BKEY; convert_tile(P.LGLT() + (size_t)d * BKEY * 64, 64, BKEY, r % (BKEY / 64), 0, [&](int n, bool&) -> const float* { return src + n; }, 16); return; } r -= T_LL;
        if (r < T_WO) { const float* src = pin(I_WOUT) + (size_t)l * D * D; convert_wide(P.WoT(), D, D, r / (D / 64), r % (D / 64), [&](int n, bool&) -> const float* { return src + n; }); return; } r -= T_WO;
        { const float* src = pin(I_S5GLU) + (size_t)l * CDIM * 2 * CDIM;
            convert_tile(P.GluT(), CDIM, 2 * CDIM, r / (CDIM / 64), r % (CDIM / 64),
                         [&](int n, bool&) -> const float* { const int j = n >> 5, wi = n & 31; return wi < 16 ? src + 16 * j + wi : src + CDIM + 16 * j + wi - 16; }); }
}
__device__ __forceinline__ void s5_matrix_task(const Params& P, int l, int g) {
    const int tid = tid_();
    float* apr = (float*)smem;
    float* api = apr + 2 * 17 * 64;
    float* bbr = api + 2 * 17 * 64;
    float* bbi = bbr + 2 * 64 * 16;
    float* cre = bbi + 2 * 64 * 16;
    float* cim = cre + 16 * 64;
    float* kern = cim + 16 * 64;
    {
        __syncthreads();
        for (int i = tid; i < 2 * 17 * 64; i += NTHREADS) {
            const int d = i / (17 * 64), tau = (i / 64) % 17, p = i % 64;
            const float lr = pin(I_S5LRE)[((l * 2 + d) * CGR + g) * CP + p], li = pin(I_S5LIM)[((l * 2 + d) * CGR + g) * CP + p];
            const float dt = expf(pin(I_S5LDT)[(l * 2 + d) * CGR + g]);
            const float mag = expf(lr * dt * (float)tau), ang = li * dt * (float)tau;
            apr[i] = mag * cosf(ang); api[i] = mag * sinf(ang);
        }
        for (int i = tid; i < 16 * 64; i += NTHREADS) { cre[i] = pin(I_S5CRE)[((size_t)l * CGR + g) * 16 * 64 + i]; cim[i] = pin(I_S5CIM)[((size_t)l * CGR + g) * 16 * 64 + i]; }
        __syncthreads();
        for (int i = tid; i < 2 * 64 * 16; i += NTHREADS) {
            const int d = i / (64 * 16), p = (i / 16) % 64, c = i % 16;
            const float lr = pin(I_S5LRE)[((l * 2 + d) * CGR + g) * CP + p], li = pin(I_S5LIM)[((l * 2 + d) * CGR + g) * CP + p];
            const float ar = apr[(d * 17 + 1) * 64 + p], ai = api[(d * 17 + 1) * 64 + p], den = lr * lr + li * li;
            const float fr = ((ar - 1.0f) * lr + ai * li) / den, fi = (ai * lr - (ar - 1.0f) * li) / den;
            const float br = pin(I_S5BRE)[(((size_t)l * CGR + g) * CP + p) * 16 + c], bi = pin(I_S5BIM)[(((size_t)l * CGR + g) * CP + p) * 16 + c];
            bbr[i] = fr * br - fi * bi; bbi[i] = fr * bi + fi * br;
        }
        __syncthreads();
        for (int i = tid; i < 2 * 16 * 16 * 16; i += NTHREADS) {
            const int d = i >> 12, tau = (i >> 8) & 15, c = (i >> 4) & 15, c2 = i & 15; float s = 0.f;
            for (int p = 0; p < 64; ++p) {
                const float ar = apr[(d * 17 + tau) * 64 + p], ai = api[(d * 17 + tau) * 64 + p], br = bbr[(d * 64 + p) * 16 + c2], bi = bbi[(d * 64 + p) * 16 + c2];
                const float er = ar * br - ai * bi, ei = ar * bi + ai * br;
                s += cre[c * 64 + p] * er - cim[c * 64 + p] * ei;
            }
            kern[i] = s;
        }
        __syncthreads();
        half_t* Mst = P.MstT() + (size_t)g * 256 * 256; half_t* Mcat = P.McatT() + (size_t)g * 256 * 512;
        for (int i = tid; i < 256 * 256; i += NTHREADS) {
            const int n = i >> 8, k = i & 255, d = n >> 7, q = n & 127, p = q & 63, tau = k >> 4, c2 = k & 15;
            const int pw = d ? tau : 15 - tau;
            const float ar = apr[(d * 17 + pw) * 64 + p], ai = api[(d * 17 + pw) * 64 + p], br = bbr[(d * 64 + p) * 16 + c2], bi = bbi[(d * 64 + p) * 16 + c2];
            Mst[i] = (half_t)(q < 64 ? ar * br - ai * bi : ar * bi + ai * br);
        }
        for (int i = tid; i < 256 * 512; i += NTHREADS) {
            const int n = i >> 9, k = i & 511, tau = n >> 4, c = n & 15; float v;
            if (k < 256) { const int t2 = k >> 4, c2 = k & 15; v = 0.f;
                if (t2 <= tau) v += kern[((0 * 16 + (tau - t2)) * 16 + c) * 16 + c2];
                if (t2 >= tau) v += kern[((1 * 16 + (t2 - tau)) * 16 + c) * 16 + c2];
            } else { const int kk = k - 256, d = kk >> 7, q = kk & 127, p = q & 63, pw = d ? 16 - tau : tau + 1;
                const float ar = apr[(d * 17 + pw) * 64 + p], ai = api[(d * 17 + pw) * 64 + p];
                v = q < 64 ? cre[c * 64 + p] * ar - cim[c * 64 + p] * ai : -(cre[c * 64 + p] * ai + cim[c * 64 + p] * ar);
            }
            Mcat[i] = (half_t)v;
        }
    }
    __syncthreads();
}
__device__ __forceinline__ void ph_setup(const Params& P, int l) {
    using namespace stp;
    const int G = gridDim.x, bid = bid_(), tid = tid_();
    const bool s5blk = (G == 256) && bid >= 224; const int sb = bid - 224;
    const int t_first = (G != 256) ? bid : (s5blk ? 224 + (sb % 24) + 248 * (sb / 24) : bid), t_step = (G != 256) ? G : 248;
    for (int tq = t_first, qi = sb; tq < T_ALL; ) {
        const int t = tq;
        if (s5blk) { qi += 32; tq = 248 * (qi / 24) + 224 + (qi % 24); } else tq += t_step;
        setup_task(P, l, t);
    }
    for (int g = (G == 256) ? sb : bid; g >= 0 && g < CGR; g += (G == 256) ? CGR : G) s5_matrix_task(P, l, g);
    if (bid == 0 && tid < 64) { P.cnt()[tid] = 0; }
}
__device__ __forceinline__ void ph_setup_queue(const Params& P, int l, int qn, int q_begin, int q_end) {
    int* head = P.cnt() + 32 + qn; int* slot = (int*)(smem + 131072 + 1024);
    for (;;) {
        __syncthreads();
        if (tid_() == 0) *slot = q_begin + atomicAdd(head, 4);
        __syncthreads();
        const int t0 = *slot;
        if (t0 >= q_end) break;
#pragma unroll 1
        for (int q = 0; q < 4; ++q) { const int r = t0 + q; if (r >= q_end) break; setup_task(P, l, r); }
    }
}
__device__ __forceinline__ void ph_setup_rest(const Params& P, int l) {
    ph_setup_queue(P, l, 5, stp::QB, stp::T_ALL);
    if (bid_() == 0 && (tid_() < 35 || tid_() == 38)) { P.cnt()[tid_()] = 0; }
}
__device__ __forceinline__ void ph_setup_s5_next(const Params& P, int l) {
    const int G = gridDim.x, bid = bid_();
    if (G >= 64) { const int g = bid - (G - CGR); if (g >= 0) s5_matrix_task(P, l, g); }
    else for (int g = bid; g < CGR; g += G) s5_matrix_task(P, l, g);
}
__device__ __forceinline__ void moe_convert_task(const Params& P, int l, int r) {
    constexpr int T_W13 = NE * (2 * DE / 256) * (D / 64);
    if (r < T_W13) { const int e = r / ((2 * DE / 256) * (D / 64)), rr = r % ((2 * DE / 256) * (D / 64));
        const float* s1 = pin(I_W1) + ((size_t)l * NE + e) * D * DE; const float* s3 = pin(I_W3) + ((size_t)l * NE + e) * D * DE;
        convert_wide(P.W13T() + (size_t)e * 2 * DE * D, D, DE, rr / (D / 64), rr % (D / 64),
                     [&](int n, bool&) -> const float* { const int j = n >> 5, wi = n & 31; return wi < 16 ? s1 + 16 * j + wi : s3 + 16 * j + wi - 16; }); }
    else { r -= T_W13; const int e = r / ((D / 256) * (DE / 64)), rr = r % ((D / 256) * (DE / 64)); const float* src = pin(I_W2) + ((size_t)l * NE + e) * DE * D;
        convert_wide(P.W2T() + (size_t)e * D * DE, DE, D, rr / (DE / 64), rr % (DE / 64), [&](int n, bool&) -> const float* { return src + n; }); }
}
__device__ __forceinline__ void ph_moe_convert(const Params& P, int l, int qn, int t_begin, int t_end) {
    int* head = P.cnt() + 32 + qn; int* slot = (int*)(smem + 131072 + 1024);
    const int lim = t_end;
    for (;;) {
        __syncthreads();
        if (tid_() == 0) *slot = t_begin + atomicAdd(head, 3);
        __syncthreads();
        const int t0 = *slot;
        if (t0 >= lim) break;
#pragma unroll 1
        for (int q = 0; q < 3; ++q) { const int r = t0 + q; if (r >= lim) break; moe_convert_task(P, l, r); }
    }
}
__device__ __forceinline__ void ph_moe_convert_static(const Params& P, int l, int t_begin, int t_end, int idx, int n) {
#pragma unroll 1
    for (int r = t_begin + idx; r < t_end; r += n) { __syncthreads(); moe_convert_task(P, l, r); }
}
template <int MODE> __device__ __forceinline__ void ph_rows(const Params& P, int l) {
    const int lane = tid_() & 63, gw = bid_() * 8 + wid_of(tid_()), NW = gridDim.x * 8;
    const int nrows = MODE == 2 ? RL : MT;
    const float* gvec = MODE == 2 ? pin(I_FG) : pin(I_N1G) + (size_t)l * D;
    for (int row = gw; row < nrows; row += NW) {
        float* xr = xrow_ptr(P, row); const float* xs = MODE == 0 ? xsrc_ptr(P, row, 0) : xr; const int mr = modrow_of(row);
        f4 v[8]; float ss = 0.f;
#pragma unroll
        for (int j = 0; j < 8; ++j) v[j] = *(const f4*)(xs + (j * 64 + lane) * 4);
        if (MODE >= 1) {
            const int lp = MODE == 2 ? 1 : l - 1;
            const float* ga2 = P.MOD() + ((size_t)lp * 5 + mr) * (6 * D) + 5 * D;
            const int p0 = P.pos()[row * 2], p1 = P.pos()[row * 2 + 1]; const float w0 = P.wsel()[row * 2], w1 = P.wsel()[row * 2 + 1];
            const half_t* y0 = P.Y() + (size_t)p0 * D; const half_t* y1 = P.Y() + (size_t)p1 * D;
#pragma unroll
            for (int j = 0; j < 8; ++j) {
                const int c = (j * 64 + lane) * 4; const h4 a = *(const h4*)(y0 + c), b = *(const h4*)(y1 + c); const f4 g = *(const f4*)(ga2 + c);
#pragma unroll
                for (int i = 0; i < 4; ++i) v[j][i] += g[i] * (w0 * (float)a[i] + w1 * (float)b[i]);
            }
            if (MODE == 1) {
#pragma unroll
                for (int j = 0; j < 8; ++j) *(f4*)(xr + (j * 64 + lane) * 4) = v[j];
            }
        }
#pragma unroll
        for (int j = 0; j < 8; ++j) ss += (v[j][0] * v[j][0] + v[j][1] * v[j][1]) + (v[j][2] * v[j][2] + v[j][3] * v[j][3]);
        ss = wave_sum(ss);
        const float rstd = rsqrtf(ss * (1.0f / D) + 1e-6f);
        if (MODE == 2) {
            const float* fg = gvec;
#pragma unroll
            for (int j = 0; j < 8; ++j) { const int c = (j * 64 + lane) * 4; const f4 g = *(const f4*)(fg + c); f4 o;
#pragma unroll
                for (int i = 0; i < 4; ++i) o[i] = v[j][i] * rstd * g[i];
                *(f4*)(xr + c) = o; }
        } else {
            const float* ng = gvec; const float* sh = P.MOD() + ((size_t)l * 5 + mr) * (6 * D); const float* sc = sh + D;
            half_t* hr = P.H() + (size_t)row * D;
#pragma unroll
            for (int j = 0; j < 8; ++j) { const int c = (j * 64 + lane) * 4; const f4 g = *(const f4*)(ng + c), s1 = *(const f4*)(sc + c), s0 = *(const f4*)(sh + c); f4 o;
#pragma unroll
                for (int i = 0; i < 4; ++i) o[i] = v[j][i] * rstd * g[i] * (1.0f + s1[i]) + s0[i];
                *(h4*)(hr + c) = to_h4(o); }
        }
    }
}

struct SchedDense {
    pg8::TileOrder T; const char* A; const char* B; size_t tstepA, tstepB;
    __device__ __forceinline__ bool next(int i, pg8::Unit& u) const { int pm, pn; if (!T.tile(i, pm, pn)) return false; u.pm = pm; u.pn = pn; u.A = A + (size_t)pm * tstepA; u.B = B + (size_t)pn * tstepB; return true; }
};
template <int PART> __device__ __forceinline__ void ph_inproj(const Params& P, int c, int G, int lim = 1 << 30, int mrows = MT) {
    constexpr int NT0 = (CONV + NLO) / 256, NT1 = NGT / 256, NTOFF = PART ? NT0 : 0;
    SchedDense S; S.T.init(mrows / 256, PART ? NT1 : NT0, G, c, lim); S.A = (const char*)P.H(); S.B = (const char*)(P.WinT() + (size_t)NTOFF * 256 * D); S.tstepA = (size_t)256 * D * 2; S.tstepB = (size_t)256 * D * 2;
    pg8::gemm_phase<true>(D, S, [&](const pg8::Acc& acc, const pg8::Unit& u, int wr, int wc, int fr, int fq) {
        const int m0 = u.pm * 256, n0 = (u.pn + NTOFF) * 256;
        auto st8 = [](half_t* p, f4 a, f4 b) { const h4 x = to_h4(a), y = to_h4(b); h8 o; for (int i = 0; i < 4; ++i) { o[i] = x[i]; o[4 + i] = y[i]; } *(h8*)p = o; };
        if (PART) pg8::foreach_frag8(acc, wr, wc, fr, fq, [&](int m, int n, f4 a, f4 b) { for (int i = 0; i < 4; ++i) { a[i] = sigmoidf_(a[i]); b[i] = sigmoidf_(b[i]); } st8(P.Pg() + (size_t)(m0 + m) * NGT + (n0 - CONV - NLO) + n, a, b); });
        else if (n0 < CONV) pg8::foreach_frag8(acc, wr, wc, fr, fq, [&](int m, int n, f4 a, f4 b) { st8(P.Pconv() + (size_t)(m0 + m) * CONV + n0 + n, a, b); });
        else pg8::foreach_frag8(acc, wr, wc, fr, fq, [&](int m, int n, f4 a, f4 b) { st8(P.Plo() + (size_t)(m0 + m) * NLO + (n0 - CONV) + n, a, b); });
    });
}

__device__ __forceinline__ void ph_convf(const Params& P, int l) {
    const int tid = tid_();
    const float* cw = pin(I_CONVW) + (size_t)l * 9 * CONV;
    for (int it = bid_(); it < MT / 16; it += gridDim.x) {
        const int row0 = it * 16;
        int rows, cols, gi, gj0, base;
        if (row0 < RL) { const int t = row0 & (SEQ - 1); rows = 64; cols = 64; gi = t >> 6; gj0 = t & 63; base = row0 - t; }
        else { const int t = (row0 - RL) & (CTXL - 1); rows = 1; cols = CTXL; gi = 0; gj0 = t; base = row0 - t; }
        __syncthreads();
#pragma unroll 1
        for (int rnd = 0; rnd < 2; ++rnd) {
            const int c0 = (tid + NTHREADS * rnd) * 4;
            if (c0 < CONV) {
                float wt[3][3][4];
#pragma unroll
                for (int u = 0; u < 3; ++u)
#pragma unroll
                    for (int v = 0; v < 3; ++v) { const f4 a = *(const f4*)(cw + (u * 3 + v) * CONV + c0);
#pragma unroll
                        for (int i = 0; i < 4; ++i) wt[u][v][i] = a[i]; }
                h4 win[3][3];
                const h4 hz = {0, 0, 0, 0};
                auto ldp = [&](int u, int j) -> h4 { const int gr = gi + u - 1; if (gr < 0 || gr >= rows || j < 0 || j >= cols) return hz; return *(const h4*)(P.Pconv() + (size_t)(base + gr * cols + j) * CONV + c0); };
#pragma unroll
                for (int u = 0; u < 3; ++u) { win[u][0] = ldp(u, gj0 - 1); win[u][1] = ldp(u, gj0); }
                const bool is_k = (c0 >= ADIM && c0 < 2 * ADIM);
                f4 kkw = (f4){0.f, 0.f, 0.f, 0.f};
                if (is_k) kkw = *(const f4*)(pin(I_RKKK) + l * ADIM + c0 - ADIM);
#pragma unroll 1
                for (int jb = 0; jb < 16; jb += 4) {
                    h4 nw[3][4];
#pragma unroll
                    for (int e = 0; e < 4; ++e)
#pragma unroll
                        for (int u = 0; u < 3; ++u) nw[u][e] = ldp(u, gj0 + jb + e + 1);
                    f4 ov[4], qv[4];
#pragma unroll
                    for (int e = 0; e < 4; ++e) {
#pragma unroll
                        for (int u = 0; u < 3; ++u) win[u][2] = nw[u][e];
                        f4 o = (f4){0.f, 0.f, 0.f, 0.f};
#pragma unroll
                        for (int u = 0; u < 3; ++u)
#pragma unroll
                            for (int v = 0; v < 3; ++v)
#pragma unroll
                                for (int i = 0; i < 4; ++i) o[i] += (float)win[u][v][i] * wt[u][v][i];
                        ov[e] = o;
                        {
                            f4 q; float sq = 0.f;
#pragma unroll
                            for (int i = 0; i < 4; ++i) { q[i] = o[i] * kkw[i]; sq += q[i] * q[i]; }
                            sq = red16(sq);
                            const float inv = rsqrtf(sq + 1e-12f);
#pragma unroll
                            for (int i = 0; i < 4; ++i) q[i] *= inv;
                            qv[e] = q;
                        }
#pragma unroll
                        for (int u = 0; u < 3; ++u) { win[u][0] = win[u][1]; win[u][1] = win[u][2]; }
                    }
#pragma unroll
                    for (int e = 0; e < 4; ++e) { *(h4*)(P.F() + (size_t)(row0 + jb + e) * CONV + c0) = to_h4(ov[e]);
                        if (is_k) *(h4*)(P.KK() + (size_t)(row0 + jb + e) * ADIM + c0 - ADIM) = to_h4(qv[e]); }
                }
            }
        }
    }
}

__device__ __forceinline__ uint4 tanh8(uint4 x) { h8 v = __builtin_bit_cast(h8, x);
#pragma unroll
    for (int i = 0; i < 8; ++i) v[i] = (half_t)tanhf((float)v[i]);
    return __builtin_bit_cast(uint4, v); }
__device__ __forceinline__ uint4 sigm8(uint4 x) { h8 v = __builtin_bit_cast(h8, x);
#pragma unroll
    for (int i = 0; i < 8; ++i) v[i] = (half_t)sigmoidf_((float)v[i]);
    return __builtin_bit_cast(uint4, v); }
__device__ __forceinline__ void ph_lora(const Params& P, int l, int first, int stride) {
    constexpr int NTM = MT / 128;
    half_t* As = (half_t*)smem; half_t* Bs = As + 128 * GST;
    const int tid = tid_(), lane = tid & 63, w = wid_of(tid), wm = w >> 2, wn = w & 3, pr0 = tid >> 3, pk = (tid & 7) * 8;
    for (int u = first; u < 6 * NTM; u += stride) {
        const int kind = u / NTM, tm = u - kind * NTM, m0 = tm * 128, d = kind & 1, cls = kind >> 1;
        const int ncol = cls == 2 ? BKEY : ADIM, nnt = ncol / 128;
        const half_t* A = P.Plo() + (size_t)m0 * NLO + (cls == 0 ? LO_DW + d * 64 : (cls == 1 ? LO_DA + d * 64 : LO_BG + d * 16));
        const half_t* B = (cls == 0 ? P.LW2T() : (cls == 1 ? P.LA2T() : P.LGLT())) + (size_t)d * ncol * 64;
        const float* bw = pin(I_RKW0); const float* ba = pin(I_RKA0); const float* bg = pin(I_GLAAB);
        const float* bias = (cls == 0 ? bw : (cls == 1 ? ba : bg)) + (l * 2 + d) * ncol;
        half_t* O = (cls == 0 ? P.SW() : (cls == 1 ? P.AA() : P.GG())) + ((size_t)d * MT + m0) * ncol;
        uint4 ra[2], rb[2];
#pragma unroll
        for (int i = 0; i < 2; ++i) { uint4 x = (cls == 2 && pk >= 16) ? zero16() : ld16(A + (size_t)(pr0 + 64 * i) * NLO + pk); if (cls == 0) x = tanh8(x); ra[i] = x; rb[i] = ld16(B + (size_t)(pr0 + 64 * i) * 64 + pk); }
        __syncthreads();
#pragma unroll
        for (int i = 0; i < 2; ++i) *(uint4*)(As + (pr0 + 64 * i) * GST + pk) = ra[i];
        for (int nt = 0; nt < nnt; ++nt) {
            half_t* Bc = Bs + (nt & 1) * 128 * GST;
#pragma unroll
            for (int i = 0; i < 2; ++i) *(uint4*)(Bc + (pr0 + 64 * i) * GST + pk) = rb[i];
            if (nt + 1 < nnt) {
#pragma unroll
                for (int i = 0; i < 2; ++i) rb[i] = ld16(B + (size_t)((nt + 1) * 128 + pr0 + 64 * i) * 64 + pk); }
            const f4 bb0 = *(const f4*)(bias + nt * 128 + 32 * wn + 4 * (lane >> 4)), bb1 = *(const f4*)(bias + nt * 128 + 32 * wn + 16 + 4 * (lane >> 4));
            __syncthreads();
            f4 acc[4][2]; acc_zero(acc);
#pragma unroll
            for (int ks = 0; ks < 2; ++ks) {
                h8 af[4], bf[2];
#pragma unroll
                for (int mi = 0; mi < 4; ++mi) af[mi] = *(const h8*)(As + (64 * wm + 16 * mi + (lane & 15)) * GST + 32 * ks + 8 * (lane >> 4));
#pragma unroll
                for (int ni = 0; ni < 2; ++ni) bf[ni] = *(const h8*)(Bc + (32 * wn + 16 * ni + (lane & 15)) * GST + 32 * ks + 8 * (lane >> 4));
#pragma unroll
                for (int mi = 0; mi < 4; ++mi)
#pragma unroll
                    for (int ni = 0; ni < 2; ++ni) acc[mi][ni] = __builtin_amdgcn_mfma_f32_16x16x32_f16(bf[ni], af[mi], acc[mi][ni], 0, 0, 0);
            }
#pragma unroll
            for (int mi = 0; mi < 4; ++mi)
#pragma unroll
                for (int ni = 0; ni < 2; ++ni) { const f4 bb = ni ? bb1 : bb0; const int m = 64 * wm + 16 * mi + (lane & 15), n = nt * 128 + 32 * wn + 16 * ni + 4 * (lane >> 4); f4 o;
#pragma unroll
                    for (int i = 0; i < 4; ++i) { const float x = acc[mi][ni][i] + bb[i]; o[i] = cls == 2 ? (fminf(x, 0.f) - log1pf(__expf(-fabsf(x)))) * (1.0f / 16.0f) : sigmoidf_(x); }
                    *(h4*)(O + (size_t)m * ncol + n) = to_h4(o); }
        }
    }
    __syncthreads();
}

__device__ __forceinline__ h8 ldfrag(const half_t* base, int stride, int row0, int red0, int lane) { return *(const h8*)(base + (row0 + (lane & 15)) * stride + red0 + 8 * (lane >> 4)); }
__device__ __forceinline__ half_t clamp_h(float x) { return (half_t)__builtin_amdgcn_fmed3f(x, -60000.f, 60000.f); }
__device__ __forceinline__ f4 mma16(h8 x, h8 y, f4 c) { return __builtin_amdgcn_mfma_f32_16x16x32_f16(x, y, c, 0, 0, 0); }
__device__ __forceinline__ void ph_rwkv(const Params& P, int l, int first_item, int stride) {
    constexpr int CH = 32, SK = 72, ST = 40;
    const int tid = tid_(), lane = tid & 63, w = wid_of(tid), q = lane >> 4, i16 = lane & 15;
    half_t* Kt = (half_t*)smem; half_t* Rt = Kt + CH * SK; half_t* Bt = Rt + CH * SK; half_t* Dt = Bt + CH * SK; half_t* Wm = Dt + CH * SK; half_t* HTs = Wm + CH * SK;
    half_t* KtT = HTs + 64 * SK; half_t* DhT = KtT + 64 * ST; half_t* BhTn = DhT + 64 * ST; half_t* VT = BhTn + 64 * ST; half_t* UT = VT + 64 * ST; half_t* G1T = UT + 64 * ST;
    half_t* Akd = G1T + 64 * ST; half_t* Ard = Akd + CH * ST; half_t* Arbn = Ard + CH * ST;
    half_t* Pn0 = Arbn + CH * ST; half_t* Pn1 = Pn0 + CH * ST; half_t* PT0 = Pn1 + CH * ST; half_t* PT1 = PT0 + CH * ST; half_t* Tn0 = PT1 + CH * ST; half_t* Tn1 = Tn0 + CH * ST;
    float* Lc = (float*)(Tn1 + CH * ST);
    float* segt = Lc + CH * 64;
    float* gC = segt + 8 * 64; float* gref = gC + 64; float* bonus = gref + 64; float* Yb = bonus + 128;
    for (int item = first_item; item < 2 * NBATCH * AH; item += stride) {
        const int d = item / (NBATCH * AH), b = (item / AH) % NBATCH, h = item % AH;
        const half_t* SWd = P.SW() + (size_t)d * MT * ADIM + h * 64; const half_t* AAd = P.AA() + (size_t)d * MT * ADIM + h * 64; half_t* Zd = P.Z() + (size_t)d * MT * ADIM + h * 64;
        const half_t* Fh = P.F() + h * 64; const half_t* KKh = P.KK() + h * 64;
        const float* kap = pin(I_RKKA) + l * ADIM + h * 64; const float* rkp = pin(I_RKRK) + l * ADIM + h * 64;
        const float* gnw = pin(I_RKGNW) + l * ADIM + h * 64; const float* gnb = pin(I_RKGNB) + l * ADIM + h * 64;
        const int ck = tid & 63, seg = w;
        const float ka_c = kap[ck], rk_c = rkp[ck];
        f4 accH[2];
        accH[0] = (f4){0.f, 0.f, 0.f, 0.f}; accH[1] = (f4){0.f, 0.f, 0.f, 0.f};
        unsigned pr[4], pk[4], pv[4], pkk[4], psw[4], pa[4];
        auto ldu = [](const half_t* p) -> unsigned { return (unsigned)*(const unsigned short*)p; };
        auto h2f = [](unsigned u) -> float { return (float)__builtin_bit_cast(half_t, (unsigned short)u); };
        auto prefetch = [&](int s0) {
#pragma unroll
            for (int i = 0; i < 4; ++i) { const int row = __builtin_amdgcn_readfirstlane(tokrow(d, b, s0 + 4 * seg + i)); const half_t* f = Fh + (size_t)row * CONV + ck;
                pr[i] = ldu(f); pk[i] = ldu(f + ADIM); pv[i] = ldu(f + 2 * ADIM); pkk[i] = ldu(KKh + (size_t)row * ADIM + ck); psw[i] = ldu(SWd + (size_t)row * ADIM + ck); pa[i] = ldu(AAd + (size_t)row * ADIM + ck); }
        };
        prefetch(0);
        for (int s0 = 0; s0 < TS; s0 += CH) {
            float rr[4], kdv[4], bb[4], kkv[4], vv[4], Lv[4];
            { float run = 0.f;
#pragma unroll
              for (int i = 0; i < 4; ++i) { const float a = h2f(pa[i]), kk = h2f(pkk[i]), k = h2f(pk[i]);
                  rr[i] = h2f(pr[i]); vv[i] = h2f(pv[i]); kkv[i] = kk; kdv[i] = k * (1.0f + (a - 1.0f) * ka_c); bb[i] = kk * a; run += -0.6065306597126334f * h2f(psw[i]); Lv[i] = run; } }
            lds_barrier();
            segt[seg * 64 + ck] = Lv[3];
            if (s0 + CH < TS) prefetch(s0 + CH);
            lds_barrier();
            { float off = 0.f;
#pragma unroll
              for (int sg = 0; sg < 7; ++sg) off += segt[sg * 64 + ck] * (sg < seg ? 1.0f : 0.0f);
#pragma unroll
              for (int i = 0; i < 4; ++i) { Lv[i] += off; Lc[(4 * seg + i) * 64 + ck] = Lv[i]; }
              { const float v0 = rr[0] * kdv[0] * rk_c, v1 = rr[1] * kdv[1] * rk_c, v2 = rr[2] * kdv[2] * rk_c, v3 = rr[3] * kdv[3] * rk_c;
                const bool o1 = lane & 1, o2 = lane & 2;
                const float s01 = (o1 ? v1 : v0) + dpp_f<0xB1>(o1 ? v0 : v1), s23 = (o1 ? v3 : v2) + dpp_f<0xB1>(o1 ? v2 : v3);
                float sv = (o2 ? s23 : s01) + dpp_f<0x4E>(o2 ? s01 : s23);
                sv += dpp_f<0x124>(sv); sv += dpp_f<0x128>(sv);
                if (i16 < 4) bonus[(4 * seg + i16) * 4 + q] = sv; }
            }
            lds_barrier();
            { const float Lref = Lc[15 * 64 + ck], L31 = Lc[31 * 64 + ck];
              if (seg == 0) { gC[ck] = __expf(L31); gref[ck] = __expf(Lref); }
              h4 ktp, dhp, bhp, vtp;
              const float c3 = __expf(L31 - Lref); float eprev = __expf(((seg == 0) ? 0.f : Lc[(4 * seg - 1) * 64 + ck]) - Lref);
#pragma unroll
              for (int i = 0; i < 4; ++i) { const int t = 4 * seg + i; const float Lt = Lv[i];
                  const float ep = eprev, et = __expf(Lt - Lref), er = __builtin_amdgcn_rcpf(et), e3 = c3 * er; eprev = et;
                  const half_t ktv = (half_t)(kkv[i] * ep);
                  Kt[t * SK + ck] = ktv; ktp[i] = ktv; Rt[t * SK + ck] = clamp_h(rr[i] * et); Bt[t * SK + ck] = (half_t)(bb[i] * er); Dt[t * SK + ck] = clamp_h(kdv[i] * er);
                  dhp[i] = (half_t)(kdv[i] * e3); bhp[i] = (half_t)(-bb[i] * e3); vtp[i] = (half_t)vv[i]; }
              *(h4*)(KtT + ck * ST + 4 * seg) = ktp; *(h4*)(DhT + ck * ST + 4 * seg) = dhp; *(h4*)(BhTn + ck * ST + 4 * seg) = bhp; *(h4*)(VT + ck * ST + 4 * seg) = vtp;
            }
            lds_barrier();
#pragma unroll
            for (int x = 0; x < 2; ++x) { const int id = 2 * w + x, kt = id >> 2, vt = id & 3, k0 = kt * 16 + 4 * q; h4 hv;
#pragma unroll
                for (int r = 0; r < 4; ++r) hv[r] = (half_t)(accH[x][r] * gref[k0 + r]);
                *(h4*)(HTs + (vt * 16 + i16) * SK + k0) = hv; }
            for (int rwrep = 0; rwrep < RWKV_REP; ++rwrep) {
            {   const int mat = w >> 1, tt = w & 1, incl = (mat >> 1) & 1;
                const half_t* X = (mat & 1) ? Dt : Bt; const half_t* Yp = (mat & 2) ? Rt : Kt; const float sgn = mat == 2 ? -1.0f : 1.0f;
                half_t* dst = mat == 0 ? Pn0 : (mat == 1 ? Akd : (mat == 2 ? Arbn : Ard));
                const h8 y0 = ldfrag(Yp, SK, tt * 16, 0, lane), y1 = ldfrag(Yp, SK, tt * 16, 32, lane);
                const int t = tt * 16 + i16;
#pragma unroll
                for (int ts = 0; ts < 2; ++ts) {
                    f4 acc = mma16(ldfrag(X, SK, ts * 16, 0, lane), y0, (f4){0.f, 0.f, 0.f, 0.f}); acc = mma16(ldfrag(X, SK, ts * 16, 32, lane), y1, acc);
                    const int sb = ts * 16 + 4 * q; h4 av;
#pragma unroll
                    for (int r = 0; r < 4; ++r) av[r] = (half_t)(sgn * __builtin_amdgcn_fmed3f((sb + r < t + incl) ? acc[r] : 0.f, -60000.f, 60000.f));
                    *(h4*)(dst + t * ST + sb) = av;
                    if (mat == 0) { h4 tv;
#pragma unroll
                        for (int r = 0; r < 4; ++r) { PT0[(sb + r) * ST + t] = av[r]; tv[r] = (half_t)(((sb + r == t) ? 1.0f : 0.f) - (float)av[r]); }
                        *(h4*)(Tn0 + t * ST + sb) = tv; }
                }
            }
            lds_barrier();
            {   half_t* Pc = Pn0; half_t* PTc = PT0; half_t* Pq = Pn1; half_t* PTq = PT1; half_t* Tc = Tn0; half_t* Tq = Tn1;
                const int tl = w & 3, t0 = (tl >> 1) * 16, c0 = (tl & 1) * 16;
#pragma unroll
                for (int lev = 0; lev < 5; ++lev) {
                    if (w >= 4) {
                        if (lev < 4) {
                            f4 acc = mma16(ldfrag(Pc, ST, t0, 0, lane), ldfrag(PTc, ST, c0, 0, lane), (f4){0.f, 0.f, 0.f, 0.f});
                            const int tb = t0 + 4 * q, sc = c0 + i16; h4 pv4;
#pragma unroll
                            for (int r = 0; r < 4; ++r) { pv4[r] = (half_t)acc[r]; Pq[(tb + r) * ST + sc] = pv4[r]; }
                            *(h4*)(PTq + sc * ST + tb) = pv4;
                        }
                    } else if (lev > 0) {
                        f4 acc = mma16(ldfrag(Tc, ST, t0, 0, lane), ldfrag(PTc, ST, c0, 0, lane), (f4){0.f, 0.f, 0.f, 0.f});
                        const int tb = t0 + 4 * q, sc = c0 + i16;
#pragma unroll
                        for (int r = 0; r < 4; ++r) Tq[(tb + r) * ST + sc] = (half_t)(acc[r] + (float)Tc[(tb + r) * ST + sc]);
                    }
                    lds_barrier();
                    if (lev < 4) { half_t* tp = Pc; Pc = Pq; Pq = tp; tp = PTc; PTc = PTq; PTq = tp; }
                    if (lev > 0) { half_t* tp = Tc; Tc = Tq; Tq = tp; }
                }
                {   const int kt = w >> 1, tt = w & 1;
                    f4 acc = mma16(ldfrag(KtT, ST, kt * 16, 0, lane), ldfrag(Tc, ST, tt * 16, 0, lane), (f4){0.f, 0.f, 0.f, 0.f});
                    h4 wv;
#pragma unroll
                    for (int r = 0; r < 4; ++r) wv[r] = (half_t)__builtin_amdgcn_fmed3f(acc[r], -60000.f, 60000.f);
                    *(h4*)(Wm + (tt * 16 + i16) * SK + kt * 16 + 4 * q) = wv;
                    const int t2 = w >> 2, vt = w & 3;
                    f4 acc2 = mma16(ldfrag(Akd, ST, t2 * 16, 0, lane), ldfrag(VT, ST, vt * 16, 0, lane), (f4){0.f, 0.f, 0.f, 0.f});
                    h4 gv;
#pragma unroll
                    for (int r = 0; r < 4; ++r) gv[r] = (half_t)__builtin_amdgcn_fmed3f(acc2[r], -60000.f, 60000.f);
                    *(h4*)(G1T + (vt * 16 + i16) * ST + t2 * 16 + 4 * q) = gv;
                }
                lds_barrier();
                {   const int t2 = w >> 2, vt = w & 3;
                    f4 acc = mma16(ldfrag(Tc, ST, t2 * 16, 0, lane), ldfrag(G1T, ST, vt * 16, 0, lane), (f4){0.f, 0.f, 0.f, 0.f});
#pragma unroll
                    for (int ks = 0; ks < 2; ++ks) acc = mma16(ldfrag(Wm, SK, t2 * 16, ks * 32, lane), ldfrag(HTs, SK, vt * 16, ks * 32, lane), acc);
                    h4 uv;
#pragma unroll
                    for (int r = 0; r < 4; ++r) uv[r] = (half_t)__builtin_amdgcn_fmed3f(acc[r], -60000.f, 60000.f);
                    *(h4*)(UT + (vt * 16 + i16) * ST + t2 * 16 + 4 * q) = uv;
                }
            }
            lds_barrier();
            }
            {   const int vt = w >> 1, tt = w & 1;
                f4 acc = (f4){0.f, 0.f, 0.f, 0.f};
#pragma unroll
                for (int ks = 0; ks < 2; ++ks) acc = mma16(ldfrag(HTs, SK, vt * 16, ks * 32, lane), ldfrag(Rt, SK, tt * 16, ks * 32, lane), acc);
                acc = mma16(ldfrag(VT, ST, vt * 16, 0, lane), ldfrag(Ard, ST, tt * 16, 0, lane), acc);
                acc = mma16(ldfrag(UT, ST, vt * 16, 0, lane), ldfrag(Arbn, ST, tt * 16, 0, lane), acc);
                *(f4*)(Yb + (tt * 16 + i16) * 68 + vt * 16 + 4 * q) = acc;
#pragma unroll
                for (int x = 0; x < 2; ++x) { const int id = 2 * w + x, kt = id >> 2, v2 = id & 3, k0 = kt * 16 + 4 * q;
#pragma unroll
                    for (int r = 0; r < 4; ++r) accH[x][r] *= gC[k0 + r];
                    accH[x] = mma16(ldfrag(DhT, ST, kt * 16, 0, lane), ldfrag(VT, ST, v2 * 16, 0, lane), accH[x]);
                    accH[x] = mma16(ldfrag(BhTn, ST, kt * 16, 0, lane), ldfrag(UT, ST, v2 * 16, 0, lane), accH[x]); }
            }
            lds_barrier();
            {   const int t = tid >> 4, c = 4 * (tid & 15), row = tokrow(d, b, s0 + t);
                const f4 y = *(const f4*)(Yb + t * 68 + c); const f4 gw = *(const f4*)(gnw + c), gb = *(const f4*)(gnb + c);
                float sm = (y[0] + y[1]) + (y[2] + y[3]); sm = red16(sm);
                const float mu = sm * (1.0f / 64.0f); float sq = 0.f;
#pragma unroll
                for (int i = 0; i < 4; ++i) { const float dd = y[i] - mu; sq += dd * dd; }
                sq = red16(sq);
                const f4 bp = *(const f4*)(bonus + 4 * t); const float rs = rsqrtf(sq * (1.0f / 64.0f) + 64e-5f), bo = (bp[0] + bp[1]) + (bp[2] + bp[3]); h4 o;
#pragma unroll
                for (int i = 0; i < 4; ++i) o[i] = (half_t)((y[i] - mu) * rs * gw[i] + gb[i] + bo * (float)VT[(c + i) * ST + t]);
                *(h4*)(Zd + (size_t)row * ADIM + c) = o;
            }
        }
        lds_barrier();
    }
}

__device__ __forceinline__ void ph_gla_a(const Params& P, int first, int stride) {
    constexpr int QS = 104, TSR = 72;
    half_t* Q2s = (half_t*)smem; half_t* K2s = Q2s + 64 * QS; half_t* K3T = K2s + 64 * QS; half_t* VT = K3T + 96 * TSR; half_t* Ps = VT + 192 * TSR;
    float* cgf = (float*)(Ps + 64 * TSR); float* segt = cgf + 64 * 96;
    const int tid = tid_(), lane = tid & 63, w = wid_of(tid);
    for (int task = first; task < GLT; task += stride) {
        const int n = task % 68, c = task / 68, h = c & 3, b = (c >> 2) & 3, d = c >> 4, s0 = n * 64;
        const half_t* GGd = P.GG() + (size_t)d * MT * BKEY + h * BHK; half_t* Od = P.O() + (size_t)d * MT * BDIM + h * BHV;
        const half_t* Fq = P.F() + 2304 + h * BHK; const half_t* Fv = P.F() + 3072 + h * BHV;
        lds_barrier();
        h8 qv[2], kv[2];
#pragma unroll
        for (int j = 0; j < 2; ++j) { const int p = tid + NTHREADS * j;
            if (p < 768) { const int i = p / 12, kc = (p % 12) * 8, row = tokrow(d, b, s0 + i);
                qv[j] = *(const h8*)(Fq + (size_t)row * CONV + kc); kv[j] = *(const h8*)(Fq + (size_t)row * CONV + BKEY + kc);
                const h8 g = *(const h8*)(GGd + (size_t)row * BKEY + kc);
#pragma unroll
                for (int e = 0; e < 8; ++e) cgf[i * 96 + kc + e] = (float)g[e]; } }
#pragma unroll
        for (int j = 0; j < 3; ++j) { const int p = tid + NTHREADS * j, i = p / 24, vc = (p % 24) * 8, row = tokrow(d, b, s0 + i);
            const h8 v = *(const h8*)(Fv + (size_t)row * CONV + vc);
#pragma unroll
            for (int e = 0; e < 8; ++e) VT[(vc + e) * TSR + i] = v[e]; }
        lds_barrier();
        { float loc[16]; const int ck = tid % 96, cseg = tid / 96;
          if (tid < 384) { float run = 0.f;
#pragma unroll
              for (int i = 0; i < 16; ++i) { run += cgf[(cseg * 16 + i) * 96 + ck]; loc[i] = run; }
              segt[cseg * 96 + ck] = run; }
          lds_barrier();
          if (tid < 384) { float off = 0.f;
#pragma unroll
              for (int sg = 0; sg < 4; ++sg) off += (sg < cseg) ? segt[sg * 96 + ck] : 0.f;
#pragma unroll
              for (int i = 0; i < 16; ++i) cgf[(cseg * 16 + i) * 96 + ck] = loc[i] + off; }
        }
        lds_barrier();
#pragma unroll
        for (int j = 0; j < 2; ++j) { const int p = tid + NTHREADS * j;
            if (p < 768) { const int i = p / 12, kc = (p % 12) * 8; h8 q1, q2, k2;
#pragma unroll
                for (int e = 0; e < 8; ++e) { const float cg = cgf[i * 96 + kc + e], rf = cgf[31 * 96 + kc + e], tt = cgf[63 * 96 + kc + e];
                    const float qf = (float)qv[j][e] * 0.10206207261596575f, kf = (float)kv[j][e];
                    q1[e] = clamp_h(qf * __expf(cg)); q2[e] = clamp_h(qf * __expf(cg - rf)); k2[e] = clamp_h(kf * __expf(rf - cg)); K3T[(kc + e) * TSR + i] = clamp_h(kf * __expf(tt - cg)); }
                *(h8*)(P.GQ() + ((size_t)task * 64 + i) * BHK + kc) = q1; *(h8*)(Q2s + i * QS + kc) = q2; *(h8*)(K2s + i * QS + kc) = k2; } }
        if (tid < 96) P.GE()[(size_t)task * BHK + tid] = __expf(cgf[63 * 96 + tid]);
        lds_barrier();
#pragma unroll
        for (int x = 0; x < 2; ++x) {
            const int id = w * 2 + x, it = id >> 2, jt = id & 3; f4 a = (f4){0.f, 0.f, 0.f, 0.f};
            if (jt <= it) {
#pragma unroll
                for (int ks = 0; ks < 3; ++ks) a = mma16(ldfrag(K2s, QS, jt * 16, ks * 32, lane), ldfrag(Q2s, QS, it * 16, ks * 32, lane), a);
            }
            const int i = it * 16 + (lane & 15), j = jt * 16 + 4 * (lane >> 4); h4 pv;
#pragma unroll
            for (int r = 0; r < 4; ++r) pv[r] = (j + r <= i) ? clamp_h(a[r]) : (half_t)0.f;
            *(h4*)(Ps + i * TSR + j) = pv;
        }
        lds_barrier();
        {   const int it = w & 3, i = it * 16 + (lane & 15), row = tokrow(d, b, s0 + i);
            const h8 p0 = ldfrag(Ps, TSR, it * 16, 0, lane), p1 = ldfrag(Ps, TSR, it * 16, 32, lane);
#pragma unroll
            for (int x = 0; x < 6; ++x) { const int vt = (w >> 2) * 6 + x;
                f4 a = mma16(ldfrag(VT, TSR, vt * 16, 0, lane), p0, (f4){0.f, 0.f, 0.f, 0.f}); a = mma16(ldfrag(VT, TSR, vt * 16, 32, lane), p1, a);
                *(h4*)(Od + (size_t)row * BDIM + vt * 16 + 4 * (lane >> 4)) = to_h4(a); }
        }
        {   half_t* gs = P.GS() + (size_t)task * BHV * BHK;
#pragma unroll
            for (int x = 0; x < 9; ++x) { const int id = w * 9 + x, kt = id / 12, vt = id - kt * 12;
                f4 a = mma16(ldfrag(K3T, TSR, kt * 16, 0, lane), ldfrag(VT, TSR, vt * 16, 0, lane), (f4){0.f, 0.f, 0.f, 0.f});
                a = mma16(ldfrag(K3T, TSR, kt * 16, 32, lane), ldfrag(VT, TSR, vt * 16, 32, lane), a);
                *(h4*)(gs + (size_t)(vt * 16 + (lane & 15)) * BHK + kt * 16 + 4 * (lane >> 4)) = to_h4(a); }
        }
    }
    __syncthreads();
}
__device__ __forceinline__ void ph_gla_b(const Params& P, int first, int stride) {
    constexpr int NBLK = 32 * (BHV * BHK / 8) / NTHREADS;
    for (int blk = first; blk < NBLK; blk += stride) {
        const int gid = blk * NTHREADS + tid_(), c = gid / (BHV * BHK / 8), e = gid - c * (BHV * BHK / 8), v = e / 12, kc = (e - v * 12) * 8;
        half_t* base = P.GS() + ((size_t)c * 68 * BHV + v) * BHK + kc; const float* eb = P.GE() + (size_t)c * 68 * BHK + kc;
        float S[8];
#pragma unroll
        for (int j = 0; j < 8; ++j) S[j] = 0.f;
        for (int n0 = 0; n0 < 68; n0 += 4) {
            h8 U[4]; f4 e0[4], e1[4];
#pragma unroll
            for (int u = 0; u < 4; ++u) { U[u] = *(const h8*)(base + (size_t)(n0 + u) * BHV * BHK); e0[u] = *(const f4*)(eb + (n0 + u) * BHK); e1[u] = *(const f4*)(eb + (n0 + u) * BHK + 4); }
#pragma unroll
            for (int u = 0; u < 4; ++u) { h8 o;
#pragma unroll
                for (int j = 0; j < 8; ++j) o[j] = clamp_h(S[j]);
                *(h8*)(base + (size_t)(n0 + u) * BHV * BHK) = o;
#pragma unroll
                for (int j = 0; j < 4; ++j) { S[j] = e0[u][j] * S[j] + (float)U[u][j]; S[4 + j] = e1[u][j] * S[4 + j] + (float)U[u][4 + j]; } }
        }
    }
}
__device__ __forceinline__ void ph_gla_c(const Params& P, int l, int first, int stride, bool latent_only) {
    const int tid = tid_(), lane = tid & 63, w = wid_of(tid), q = lane >> 4, i16 = lane & 15;
    const float* ng = pin(I_GLANG) + l * BHV;
    for (int u = first; u < NBATCH * BH * 68 / 2; u += stride) {
        const int t = 2 * u + (w >> 2), m = t % 68, h = (t / 68) & 3, b = t / (68 * 4), it = w & 3, j = it * 16 + i16;
        if (latent_only && m < 4) continue;
        const int row = (m < 4) ? RL + b * CTXL + 64 * m + j : b * SEQ + 64 * (m - 4) + j;
        const int task0 = ((0 * 4 + b) * 4 + h) * 68 + m, task1 = ((1 * 4 + b) * 4 + h) * 68 + (m < 4 ? 3 - m : 71 - m);
        h8 y0[3], y1[3];
        { const half_t* q0 = P.GQ() + ((size_t)task0 * 64 + j) * BHK + 8 * q; const half_t* q1 = P.GQ() + ((size_t)task1 * 64 + (63 - j)) * BHK + 8 * q;
#pragma unroll
          for (int ks = 0; ks < 3; ++ks) { y0[ks] = *(const h8*)(q0 + 32 * ks); y1[ks] = *(const h8*)(q1 + 32 * ks); } }
        const half_t* s0p = P.GS() + ((size_t)task0 * BHV + i16) * BHK + 8 * q; const half_t* s1p = P.GS() + ((size_t)task1 * BHV + i16) * BHK + 8 * q;
        const half_t* o0 = P.O() + (size_t)row * BDIM + h * BHV + 4 * q; const half_t* o1 = o0 + (size_t)MT * BDIM;
        f4 o[12]; float ss = 0.f;
#pragma unroll
        for (int vt = 0; vt < 12; ++vt) {
            f4 a = (f4){0.f, 0.f, 0.f, 0.f};
#pragma unroll
            for (int ks = 0; ks < 3; ++ks) { a = mma16(*(const h8*)(s0p + (size_t)vt * 16 * BHK + 32 * ks), y0[ks], a); a = mma16(*(const h8*)(s1p + (size_t)vt * 16 * BHK + 32 * ks), y1[ks], a); }
            const h4 i0 = *(const h4*)(o0 + vt * 16), i1 = *(const h4*)(o1 + vt * 16);
#pragma unroll
            for (int r = 0; r < 4; ++r) { a[r] += (float)i0[r] + (float)i1[r]; ss += a[r] * a[r]; }
            o[vt] = a;
        }
        ss += __shfl_xor(ss, 16); ss += __shfl_xor(ss, 32);
        const float rs = rsqrtf(ss * (1.0f / BHV) + 1e-6f);
        const half_t* ogp = P.Plo() + (size_t)row * NLO + LO_OG + h * BHV + 4 * q; half_t* yb = P.YB() + (size_t)row * YCP + h * BHV + 4 * q;
#pragma unroll
        for (int vt = 0; vt < 12; ++vt) { const h4 og = *(const h4*)(ogp + vt * 16); const f4 g = *(const f4*)(ng + vt * 16 + 4 * q); f4 r4;
#pragma unroll
            for (int r = 0; r < 4; ++r) r4[r] = o[vt][r] * rs * g[r] * siluf_((float)og[r]);
            *(h4*)(yb + vt * 16) = to_h4(r4); }
    }
}

template <class FN> __device__ __forceinline__ void acc_foreach_pair(const f4 (&acc)[4][2], FN fn) {
    const int lane = tid_() & 63, w = wid_of(tid_()), wm = w >> 2, wn = w & 3;
#pragma unroll
    for (int mi = 0; mi < 4; ++mi) fn(64 * wm + 16 * mi + (lane & 15), 16 * wn + 4 * (lane >> 4), acc[mi][0], acc[mi][1]);
}
__device__ __forceinline__ float gelu_tanh(float x) { const float u = 0.7978845608028654f * (x + 0.044715f * x * x * x); return 0.5f * x * (1.0f + tanhf(u)); }

__device__ __forceinline__ uint4 s5_u_piece(const Params& P, int g, int m, int k) {
    if (m >= S5ROWS) return zero16();
    const int b = m / 272, n = m - b * 272, row0 = s5_block_row0(b, n);
    return ld16(P.Plo() + (size_t)(row0 + (k >> 4)) * NLO + LO_U + g * 16 + (k & 15));
}
__device__ __forceinline__ void ph_s5g2(const Params& P, int first, int stride) {
    for (int u = first; u < CGR * 9 * 2; u += stride) {
        const int g = u / 18, tm = (u % 18) >> 1, tn = u & 1;
        const half_t* B = P.MstT() + (size_t)g * 256 * 256 + (size_t)tn * 128 * 256;
        f4 acc[4][2]; acc_zero(acc);
        gemm_tile(4, [&](int r, int k) { return s5_u_piece(P, g, tm * 128 + r, k); }, [&](int r, int k) { return ld16(B + r * 256 + k); }, acc);
        acc_foreach(acc, [&](int m, int n, f4 v) { const int mm = tm * 128 + m; if (mm < S5ROWS) *(f4*)(P.Sloc() + ((size_t)g * S5ROWS + mm) * 256 + tn * 128 + n) = v; });
    }
}
__device__ __forceinline__ void ph_s5scan(const Params& P, int l, int first, int stride) {
    for (int blk = first; blk < 32; blk += stride) {
        const int gid = blk * NTHREADS + tid_(), p = gid & 63, d = (gid >> 6) & 1, b = (gid >> 7) & 3, g = gid >> 9;
        const float lr = pin(I_S5LRE)[((l * 2 + d) * CGR + g) * CP + p], li = pin(I_S5LIM)[((l * 2 + d) * CGR + g) * CP + p];
        const float dt = expf(pin(I_S5LDT)[(l * 2 + d) * CGR + g]);
        const float mag = expf(lr * dt * 16.0f), ang = li * dt * 16.0f, ar = mag * cosf(ang), ai = mag * sinf(ang);
        float xr = 0.f, xi = 0.f;
        for (int n0 = 0; n0 < 272; n0 += 16) {
            float sr[16], si[16]; size_t oo[16];
#pragma unroll
            for (int u = 0; u < 16; ++u) { const int ns = n0 + u, nb = d == 0 ? ns : (ns < 16 ? 15 - ns : 287 - ns);
                oo[u] = ((size_t)g * S5ROWS + b * 272 + nb) * 256 + d * 128 + p; sr[u] = P.Sloc()[oo[u]]; si[u] = P.Sloc()[oo[u] + 64]; }
#pragma unroll
            for (int u = 0; u < 16; ++u) { P.XinH()[oo[u]] = (half_t)xr; P.XinH()[oo[u] + 64] = (half_t)xi;
                const float nr = ar * xr - ai * xi + sr[u], ni = ar * xi + ai * xr + si[u]; xr = nr; xi = ni; }
        }
    }
}
__device__ __forceinline__ void ph_s5g1(const Params& P, int l, int first, int stride) {
    const float* s5d = pin(I_S5D) + l * CDIM;
    for (int u = first; u < CGR * 9 * 2; u += stride) {
        const int g = u / 18, tm = (u % 18) >> 1, tn = u & 1;
        const half_t* B = P.McatT() + (size_t)g * 256 * 512 + (size_t)tn * 128 * 512;
        f4 acc[4][2]; acc_zero(acc);
        gemm_tile(8, [&](int r, int k) -> uint4 { const int m = tm * 128 + r; if (k < 256) return s5_u_piece(P, g, m, k); if (m >= S5ROWS) return zero16();
                         return ld16(P.XinH() + ((size_t)g * S5ROWS + m) * 256 + (k - 256)); },
                  [&](int r, int k) { return ld16(B + r * 512 + k); }, acc);
        struct UD { h4 u; f4 d; };
        acc_foreach2(acc, [&](int m, int n) { UD r; const int mm = tm * 128 + m < S5ROWS ? tm * 128 + m : S5ROWS - 1;
            const int nn = tn * 128 + n, tau = nn >> 4, c = nn & 15, b = mm / 272, nb = mm - b * 272, row = s5_block_row0(b, nb) + tau, ch = g * 16 + c;
            r.u = *(const h4*)(P.Plo() + (size_t)row * NLO + LO_U + ch); r.d = *(const f4*)(s5d + ch); return r; },
          [&](int m, int n, f4 v, UD r) { const int mm = tm * 128 + m; if (mm >= S5ROWS) return;
            const int nn = tn * 128 + n, tau = nn >> 4, c = nn & 15, b = mm / 272, nb = mm - b * 272, row = s5_block_row0(b, nb) + tau, ch = g * 16 + c; f4 o;
#pragma unroll
            for (int i = 0; i < 4; ++i) o[i] = gelu_tanh(v[i] + r.d[i] * (float)r.u[i]);
            *(h4*)(P.TC() + (size_t)row * CDIM + ch) = to_h4(o); });
    }
}
__device__ __forceinline__ void ph_glu(const Params& P, int mrows) {
    SchedDense S; S.T.init(mrows / 256, (2 * CDIM) / 256, gridDim.x, bid_()); S.A = (const char*)P.TC(); S.B = (const char*)P.GluT(); S.tstepA = (size_t)256 * CDIM * 2; S.tstepB = (size_t)256 * CDIM * 2;
    pg8::gemm_phase(CDIM, S, [&](const pg8::Acc& acc, const pg8::Unit& u, int wr, int wc, int fr, int fq) {
        pg8::foreach_pair(acc, wr, wc, fr, fq, [&](int m, int hc, f4 a, f4 g) { f4 o;
#pragma unroll
            for (int i = 0; i < 4; ++i) o[i] = a[i] * sigmoidf_(g[i]);
            *(h4*)(P.YC() + (size_t)(u.pm * 256 + m) * CDIM + u.pn * 128 + hc) = to_h4(o); });
    });
}

__device__ __forceinline__ void ph_comb(const Params& P, int l, int mrows) {
    const int tid = tid_();
    for (int u = bid_(); u < (mrows / 128) * 6; u += gridDim.x) {
        const int tm = u / 6, tn = u % 6, m0 = tm * 128, n0 = tn * 128;
        const half_t* A = P.Plo() + (size_t)m0 * NLO + LO_DG; const half_t* B = P.LG2T() + (size_t)n0 * 128;
        f4 acc[4][2]; acc_zero(acc);
        gemm_tile(2, [&](int rr, int k) { return sigm8(ld16(A + (size_t)rr * NLO + k)); }, [&](int rr, int k) { return ld16(B + rr * 128 + k); }, acc);
        struct ZZ { h4 a, b; };
        acc_foreach2(acc, [&](int m, int n) { ZZ z; const size_t o = (size_t)(m0 + m) * ADIM + n0 + n; z.a = *(const h4*)(P.Z() + o); z.b = *(const h4*)(P.Z() + (size_t)MT * ADIM + o); return z; },
          [&](int m, int n, f4 v, ZZ z) { const size_t o = (size_t)(m0 + m) * ADIM + n0 + n; f4 r;
#pragma unroll
            for (int i = 0; i < 4; ++i) r[i] = ((float)z.a[i] + (float)z.b[i]) * v[i];
            *(h4*)(P.YA() + o) = to_h4(r); });
    }
}

struct SchedMerge1 {
    pg8::TileOrder T; const char *a, *b; int nb, br0, K;
    __device__ __forceinline__ bool next(int i, pg8::Unit& u) const { const int t = i / nb, br = i - nb * t; int pm, pn; if (!T.tile(t, pm, pn)) return false; u.pm = pm; u.pn = pn * 4 + br0 + br;
        u.A = a + ((size_t)br * MT + (size_t)pm * 256) * K * 2; u.B = b + ((size_t)br * D + (size_t)pn * 256) * K * 2; return true; }
};
template <class S_> __device__ __forceinline__ void merge1_call(const Params& P, const S_& S, int K) {
    pg8::gemm_phase(K, S, [&](const pg8::Acc& acc, const pg8::Unit& u, int wr, int wc, int fr, int fq) {
        const int br = u.pn & 3, m0 = u.pm * 256, n0 = (u.pn >> 2) * 256;
        struct GO { h4 g, o; };
        pg8::foreach_frag2w(acc, wr, wc, fr, fq,
            [&](int m, int n) { GO r; r.g = *(const h4*)(P.Pg() + (size_t)(m0 + m) * NGT + br * D + n0 + n); r.o = (h4){0, 0, 0, 0}; if (br != 0) r.o = *(const h4*)(P.U() + (size_t)(m0 + m) * D + n0 + n); return r; },
            [&](int m, int n, f4 v, GO r) { f4 x;
#pragma unroll
                for (int i = 0; i < 4; ++i) x[i] = (float)r.o[i] + (float)r.g[i] * v[i];
                *(h4*)(P.U() + (size_t)(m0 + m) * D + n0 + n) = to_h4(x); });
    });
}
__device__ __forceinline__ void ph_merge1(const Params& P, int mrows_all) {
    const int mrows = RL;
    if (mrows_all > RL) {
        for (int u = bid_(); u < (RC / 128) * (D / 128); u += gridDim.x) {
            const int tm = u >> 4, tn = u & 15, m0 = RL + tm * 128, n0 = tn * 128;
            f4 tot[4][2]; acc_zero(tot);
#pragma unroll 1
            for (int br = 0; br < 3; ++br) {
                const int K = br == 2 ? CDIM : YCP;
                const half_t* A = (br == 0 ? P.YA() : (br == 1 ? P.YB() : P.YC())) + (size_t)m0 * K;
                const half_t* B = (br == 0 ? P.PaT() : (br == 1 ? P.PbT() : P.PcT())) + (size_t)n0 * K;
                f4 acc[4][2]; acc_zero(acc);
                gemm_tile(K / 64, [&](int r, int k) { return ld16(A + (size_t)r * K + k); }, [&](int r, int k) { return ld16(B + (size_t)r * K + k); }, acc);
                const int lane = tid_() & 63, w = wid_of(tid_()), wm = w >> 2, wn = w & 3;
                h4 gt[4][2];
#pragma unroll
                for (int mi = 0; mi < 4; ++mi)
#pragma unroll
                    for (int ni = 0; ni < 2; ++ni) gt[mi][ni] = *(const h4*)(P.Pg() + (size_t)(m0 + 64 * wm + 16 * mi + (lane & 15)) * NGT + br * D + n0 + 32 * wn + 16 * ni + 4 * (lane >> 4));
#pragma unroll
                for (int mi = 0; mi < 4; ++mi)
#pragma unroll
                    for (int ni = 0; ni < 2; ++ni)
#pragma unroll
                        for (int i = 0; i < 4; ++i) tot[mi][ni][i] += (float)gt[mi][ni][i] * acc[mi][ni][i];
            }
            acc_foreach(tot, [&](int m, int n, f4 v) { *(h4*)(P.U() + (size_t)(m0 + m) * D + n0 + n) = to_h4(v); });
        }
        __syncthreads();
    }
    SchedMerge1 S; S.T.init(mrows / 256, D / 256, gridDim.x, bid_()); S.a = (const char*)P.YA(); S.b = (const char*)P.PaT(); S.nb = 2; S.br0 = 0; S.K = YCP;
    merge1_call(P, S, YCP);
    SchedMerge1 S2; S2.T.init(mrows / 256, D / 256, gridDim.x, bid_()); S2.a = (const char*)P.YC(); S2.b = (const char*)P.PcT(); S2.nb = 1; S2.br0 = 2; S2.K = CDIM;
    merge1_call(P, S2, CDIM);
}
__device__ __forceinline__ void ph_merge2(const Params& P, int l, int mrows_all) {
    const int mrows = RL;
    if (mrows_all > RL) {
        for (int u = bid_(); u < (RC / 128) * (D / 128); u += gridDim.x) {
            const int tm = u >> 4, tn = u & 15, m0 = RL + tm * 128, n0 = tn * 128;
            const half_t* A = P.U() + (size_t)m0 * D; const half_t* B = P.WoT() + (size_t)n0 * D;
            f4 acc[4][2]; acc_zero(acc);
            gemm_tile(D / 64, [&](int r, int k) { return ld16(A + (size_t)r * D + k); }, [&](int r, int k) { return ld16(B + (size_t)r * D + k); }, acc);
            const float* gap = P.MOD() + ((size_t)l * 5 + 4) * (6 * D) + 2 * D + n0;
            struct XG { f4 x, g; };
            acc_foreach2(acc, [&](int m, int n) { XG r; r.x = *(const f4*)(xsrc_ptr(P, m0 + m, l) + n0 + n); r.g = *(const f4*)(gap + n); return r; },
                [&](int m, int n, f4 v, XG r) {
#pragma unroll
                    for (int i = 0; i < 4; ++i) r.x[i] += r.g[i] * v[i];
                    *(f4*)(xrow_ptr(P, m0 + m) + n0 + n) = r.x; });
        }
        __syncthreads();
    }
    SchedDense S; S.T.init(mrows / 256, D / 256, gridDim.x, bid_()); S.A = (const char*)P.U(); S.B = (const char*)P.WoT(); S.tstepA = (size_t)256 * D * 2; S.tstepB = (size_t)256 * D * 2;
    pg8::gemm_phase(D, S, [&](const pg8::Acc& acc, const pg8::Unit& u, int wr, int wc, int fr, int fq) {
        const int m0 = u.pm * 256, n0 = u.pn * 256;
        const float* gap = P.MOD() + ((size_t)l * 5 + modrow_of(m0)) * (6 * D) + 2 * D + n0;
        f4 gv[2][2];
#pragma unroll
        for (int bj = 0; bj < 2; ++bj)
#pragma unroll
            for (int n = 0; n < 2; ++n) gv[bj][n] = *(const f4*)(gap + bj * pg8::HALF + wc * 32 + n * 16 + 4 * fq);
        pg8::foreach_frag2w(acc, wr, wc, fr, fq,
            [&](int m, int n) { return *(const f4*)(xsrc_ptr(P, m0 + m, l) + n0 + n); },
            [&](int m, int n, f4 v, f4 x) { const int cg = (n - wc * 32 - 4 * fq) >> 4;
                const f4 g = (cg & 8) ? ((cg & 1) ? gv[1][1] : gv[1][0]) : ((cg & 1) ? gv[0][1] : gv[0][0]);
#pragma unroll
                for (int i = 0; i < 4; ++i) x[i] += g[i] * v[i];
                *(f4*)(xrow_ptr(P, m0 + m) + n0 + n) = x; });
    });
}

__device__ __forceinline__ void ph_route(const Params& P, int l, int mrows) {
    const int tid = tid_(), lane = tid & 63, gw = bid_() * 8 + wid_of(tid), NW = gridDim.x * 8;
    constexpr int RWS = D + 4;
    float* rwT = (float*)smem;
    { const float* rwp = pin(I_RW); for (int i = tid; i < D * NE; i += NTHREADS) rwT[(i & 15) * RWS + (i >> 4)] = rwp[i]; }
    const float* rbias = pin(I_RB); const float* n2g = pin(I_N2G) + (size_t)l * D;
    for (int i = bid_() * NTHREADS + tid; i < SLOTS; i += gridDim.x * NTHREADS) P.sidx()[i] = 0;
    int* lcnt = (int*)(smem + 131072 + 512);
    if (tid < NE) lcnt[tid] = 0;
    __syncthreads();
    for (int row = gw; row < mrows; row += NW) {
        const float* xr = xrow_ptr(P, row); const int mr = modrow_of(row);
        const float* ng = n2g; const float* sh = P.MOD() + ((size_t)l * 5 + mr) * (6 * D) + 3 * D; const float* sc = sh + D;
        f4 v[8]; float ss = 0.f;
#pragma unroll
        for (int j = 0; j < 8; ++j) { v[j] = *(const f4*)(xr + (j * 64 + lane) * 4); ss += (v[j][0] * v[j][0] + v[j][1] * v[j][1]) + (v[j][2] * v[j][2] + v[j][3] * v[j][3]); }
        ss = wave_sum(ss);
        const float rstd = rsqrtf(ss * (1.0f / D) + 1e-6f);
        float lg[NE];
#pragma unroll
        for (int e = 0; e < NE; ++e) lg[e] = 0.f;
        half_t* hr = P.H() + (size_t)row * D;
#pragma unroll
        for (int j = 0; j < 8; ++j) { const int c = (j * 64 + lane) * 4; const f4 g = *(const f4*)(ng + c), s1 = *(const f4*)(sc + c), s0 = *(const f4*)(sh + c); f4 o;
#pragma unroll
            for (int i = 0; i < 4; ++i) o[i] = v[j][i] * rstd * g[i] * (1.0f + s1[i]) + s0[i];
#pragma unroll
            for (int e = 0; e < NE; ++e) { const f4 wv = *(const f4*)(rwT + e * RWS + c); lg[e] += (o[0] * wv[0] + o[1] * wv[1]) + (o[2] * wv[2] + o[3] * wv[3]); }
            *(h4*)(hr + c) = to_h4(o); asm volatile("" ::: "memory"); }
#pragma unroll
        for (int e = 0; e < NE; ++e) lg[e] = wave_sum(lg[e]);
        float sc16[NE], bi[NE];
#pragma unroll
        for (int e = 0; e < NE; ++e) { sc16[e] = sigmoidf_(lg[e]); bi[e] = sc16[e] + rbias[e]; }
        int gsel = 0; float gbest = -1e30f;
#pragma unroll
        for (int g = 0; g < 4; ++g) { float m1 = -1e30f, m2 = -1e30f;
#pragma unroll
            for (int i = 0; i < 4; ++i) { const float x = bi[4 * g + i]; if (x > m1) { m2 = m1; m1 = x; } else if (x > m2) m2 = x; }
            const float s = m1 + m2; if (s > gbest) { gbest = s; gsel = g; } }
        int i0 = 0, i1 = 0; float b0 = -1e30f, b1 = -1e30f, s0v = 0.f, s1v = 0.f;
#pragma unroll
        for (int e = 0; e < NE; ++e) { const bool in = (e >> 2) == gsel; const float x = bi[e];
            if (in && x > b0) { b1 = b0; i1 = i0; s1v = s0v; b0 = x; i0 = e; s0v = sc16[e]; } else if (in && x > b1) { b1 = x; i1 = e; s1v = sc16[e]; } }
        if (lane == 0) { const float inv = 1.0f / (s0v + s1v);
            P.wsel()[row * 2] = s0v * inv; P.wsel()[row * 2 + 1] = s1v * inv; P.pos()[row * 2] = i0; P.pos()[row * 2 + 1] = i1;
            atomicAdd(&lcnt[i0], 1); atomicAdd(&lcnt[i1], 1); }
    }
    __syncthreads();
    if (tid < NE) P.blkcnt()[bid_() * NE + tid] = lcnt[tid];
}
__device__ __forceinline__ void seg_starts(const Params& P, int (&st)[NE + 1]) {
    int a = 0;
#pragma unroll
    for (int e = 0; e < NE; ++e) { st[e] = a; a += (P.cnt()[e] + 255) & ~255; }
    st[NE] = a;
}
__device__ __forceinline__ void ph_slot(const Params& P, int mrows) {
    const int tid = tid_(), lane = tid & 63, bid = bid_(), gw = bid * 8 + wid_of(tid), NW = gridDim.x * 8, G = gridDim.x;
    int* ls = (int*)smem;
    if (tid < 48) ls[tid] = 0;
    __syncthreads();
    { const int e = tid & 15; int t = 0, p = 0;
        for (int b = tid >> 4; b < G; b += NTHREADS / 16) { const int c = P.blkcnt()[b * NE + e]; t += c; p += (b < bid) ? c : 0; }
        atomicAdd(&ls[e], t); atomicAdd(&ls[16 + e], p); }
    __syncthreads();
    if (tid < NE) { int a = 0;
        for (int q = 0; q < tid; ++q) a += (ls[q] + 255) & ~255;
        ls[32 + tid] = a + ls[16 + tid];
        if (bid == 0) P.cnt()[tid] = ls[tid]; }
    __syncthreads();
    { const int row = gw + lane * NW;
        if (row < mrows) { const int e0 = P.pos()[row * 2], e1 = P.pos()[row * 2 + 1];
            const int s0 = atomicAdd(&ls[32 + e0], 1), s1 = atomicAdd(&ls[32 + e1], 1);
            P.pos()[row * 2] = s0; P.pos()[row * 2 + 1] = s1; P.sidx()[s0] = row; P.sidx()[s1] = row; } }
}
struct SchedMoe {
    pg8::TileOrder T; const char* A; const char* B; size_t tstepA, tstepB, estepB; int st[NE + 1];
    __device__ __forceinline__ bool next(int i, pg8::Unit& u) const { int pm, pn; if (!T.tile(i, pm, pn)) return false; u.pm = pm; u.pn = pn; const int s0 = pm * 256; int e = 0;
#pragma unroll
        for (int q = 1; q < NE; ++q) e = (s0 >= st[q]) ? q : e;
        u.A = A + (size_t)pm * tstepA; u.B = B + (size_t)e * estepB + (size_t)pn * tstepB; return true; }
};
__device__ __forceinline__ void ph_up(const Params& P) {
    SchedMoe S; seg_starts(P, S.st); S.T.init(S.st[NE] >> 8, (2 * DE) / 256, gridDim.x, bid_());
    S.A = (const char*)P.H(); S.B = (const char*)P.W13T(); S.tstepA = 0; S.tstepB = (size_t)256 * D * 2; S.estepB = (size_t)2 * DE * D * 2;
    pg8::gemm_phase<false, true>(D, S, [&](const pg8::Acc& acc, const pg8::Unit& u, int wr, int wc, int fr, int fq) {
        pg8::foreach_pair(acc, wr, wc, fr, fq, [&](int m, int hc, f4 a, f4 g) { f4 o;
#pragma unroll
            for (int i = 0; i < 4; ++i) o[i] = siluf_(a[i]) * g[i];
            *(h4*)(P.Hg() + (size_t)(u.pm * 256 + m) * DE + u.pn * 128 + hc) = to_h4(o); });
    }, P.sidx());
}
__device__ __forceinline__ void ph_down(const Params& P) {
    SchedMoe S; seg_starts(P, S.st); S.T.init(S.st[NE] >> 8, D / 256, gridDim.x, bid_());
    S.A = (const char*)P.Hg(); S.B = (const char*)P.W2T(); S.tstepA = (size_t)256 * DE * 2; S.tstepB = (size_t)256 * DE * 2; S.estepB = (size_t)D * DE * 2;
    pg8::gemm_phase<true>(DE, S, [&](const pg8::Acc& acc, const pg8::Unit& u, int wr, int wc, int fr, int fq) {
        pg8::foreach_frag8(acc, wr, wc, fr, fq, [&](int m, int n, f4 a, f4 b) { const h4 x = to_h4(a), y = to_h4(b); h8 o;
#pragma unroll
            for (int i = 0; i < 4; ++i) { o[i] = x[i]; o[4 + i] = y[i]; }
            *(h8*)(P.Y() + (size_t)(u.pm * 256 + m) * D + u.pn * 256 + n) = o; });
    });
}

#ifndef PROBE_BAR
#define PROBE_BAR 1
#endif
#define XBAR(b) REP(PROBE_BAR, xcd_barrier(b);)
#ifndef TPROBE
#define TPROBE 0
#endif
#define TPMUL 8
template <int ID, int END> __device__ __forceinline__ void tp_mark(const Params& P) {
    if (((TPROBE >> ID) & 1) && blockIdx.x == 0 && threadIdx.x == 0) {
        GAS unsigned char* w = (GAS unsigned char*)P.ws; asm volatile("" : "+s"(w));
        GAS unsigned long long* s = (GAS unsigned long long*)(w + WS_TOTAL);
        const unsigned long long t = __builtin_amdgcn_s_memrealtime();
        if (END) s[0] += t - s[1]; else s[1] = t; }
}
#define TPB(id) tp_mark<id, 0>(P);
#define TPE(id) tp_mark<id, 1>(P);
template <int l> __device__ __forceinline__ void layer_body(const Params& P, const XcdBarrier& bar, const int bid, const int G) {
    constexpr int MR = (l == DEPTH - 1) ? RL : MT;

    TPB(1)
    if (l == 0) { ph_prologue(P); REP(PROBE_SETUP, ph_setup(P, 0); XBAR(bar);) ph_rows<0>(P, 0); }
    else { ph_setup_rest(P, l); ph_rows<1>(P, l); }
    XBAR(bar);
    TPE(1) TPB(2)
    REP(PROBE_INPROJ, ph_inproj<0>(P, bid, G); ph_moe_convert(P, l, 6, 6144 - MOE_I, 6144); XBAR(bar);)
    TPE(2) TPB(3)
    REP(PROBE_CONVF, REP(PROBE_CONV1, ph_convf(P, l);) ph_lora(P, l, bid, G); REP(PROBE_S5G2, ph_s5g2(P, bid, G);) XBAR(bar);)
    TPE(3) TPB(4)
    REP(PROBE_SCANS,
    if (G >= 224) { if (bid < 96) { REP(PROBE_RWKV, ph_rwkv(P, l, bid, 1 << 30);) ph_inproj<1>(P, bid, 96, 96 * GATE_KU, MR); }
                    else if (bid >= G - NCONV) { ph_moe_convert_static(P, l, 0, MOE_A, bid - (G - NCONV), NCONV); ph_inproj<1>(P, 96 * GATE_KU + bid - (G - NCONV), NCONV, 96 * GATE_KU + NCONV * CONV_GU, MR); }
                    else { ph_s5scan(P, l, bid - 96, G - 96 - NCONV); ph_gla_a(P, bid - 96, G - 96 - NCONV); ph_inproj<1>(P, 96 * GATE_KU + NCONV * CONV_GU + bid - 96, G - 96 - NCONV, 1 << 30, MR); } }
    else { ph_rwkv(P, l, bid, G); ph_s5scan(P, l, bid, G); ph_gla_a(P, bid, G); ph_inproj<1>(P, bid, G, 1 << 30, MR); ph_moe_convert(P, l, 2, 0, MOE_A); }
    XBAR(bar);)
    TPE(4) TPB(5)
    ph_gla_b(P, bid, G); ph_s5g1(P, l, bid, G); ph_comb(P, l, MR); ph_moe_convert(P, l, 0, MOE_A, MOE_A + (6144 - MOE_I - MOE_A) / 2);
    XBAR(bar);
    TPE(5) TPB(6)
    REP(PROBE_P6, ph_gla_c(P, l, bid, G, l == DEPTH - 1); ph_glu(P, MR);) ph_moe_convert(P, l, 1, MOE_A + (6144 - MOE_I - MOE_A) / 2, 6144 - MOE_I); XBAR(bar);
    TPE(6) TPB(7)
    REP(PROBE_MERGE1, ph_merge1(P, MR); XBAR(bar);)
    TPE(7) TPB(8)
    ph_merge2(P, l, MR);
    XBAR(bar);
    TPE(8) TPB(9)
    ph_route(P, l, MR);
    XBAR(bar);
    TPE(9) TPB(10)
    ph_slot(P, MR);
    XBAR(bar);
    TPE(10) TPB(11)
    ph_up(P); if (l + 1 < DEPTH) { ph_setup_s5_next(P, l + 1); ph_setup_queue(P, l + 1, 3, 0, stp::QA); } XBAR(bar);
    TPE(11) TPB(12)
    ph_down(P); if (l + 1 < DEPTH) ph_setup_queue(P, l + 1, 4, stp::QA, stp::QB); XBAR(bar);
    TPE(12)
    }
__global__ void __launch_bounds__(NTHREADS, 2) k_fused(Params P) {
    const int bid = blockIdx.x, G = gridDim.x;
    volatile LAS unsigned* xbw = (volatile LAS unsigned*)(LAS unsigned char*)(smem + LDS_BYTES - 16);
    if (threadIdx.x == 0) { xbw[0] = 0u; xbw[1] = 0u; xbw[2] = 0u; xbw[3] = 0u; }
    __syncthreads();
    const XcdBarrier bar = xcd_barrier_post(P.bar(), xbw);
    if (TPROBE && blockIdx.x == 0 && threadIdx.x == 0) { GAS unsigned long long* s = (GAS unsigned long long*)((GAS unsigned char*)P.ws + WS_TOTAL); s[0] = 0ull; }
    layer_body<0>(P, bar, bid, G);
    layer_body<1>(P, bar, bid, G);
    TPB(13)
    ph_rows<2>(P, 1);
    TPE(13)
    if (TPROBE && blockIdx.x == 0 && threadIdx.x == 0) { GAS unsigned long long* s = (GAS unsigned long long*)((GAS unsigned char*)P.ws + WS_TOTAL);
        const unsigned long long T = s[0] * TPMUL, t0 = __builtin_amdgcn_s_memrealtime();
        while (__builtin_amdgcn_s_memrealtime() - t0 < T) __builtin_amdgcn_s_sleep(32); }
}

extern "C" void kernel_launch(void* const* d_in, const int* in_sizes, int n_in, void* d_out, int out_size, void* d_ws, size_t ws_size, hipStream_t stream) {
    static int grid = 0;
    if (grid == 0) { int dev = 0, cus = 0; (void)hipGetDevice(&dev); (void)hipDeviceGetAttribute(&cus, hipDeviceAttributeMultiprocessorCount, dev); grid = cus > 0 ? cus : 256;
        (void)hipFuncSetAttribute((const void*)k_fused, hipFuncAttributeMaxDynamicSharedMemorySize, LDS_BYTES); }
    Params P{};
    for (int i = 0; i < 42; ++i) P.in[i] = (const float*)d_in[i];
    P.out = (float*)d_out;
    P.ws = (unsigned char*)d_ws;
    if (WS_TOTAL + 256 > ws_size || n_in != 42 || out_size != RL * D) { fprintf(stderr, "kernel_launch: workspace %zu < %zu or bad shapes\n", ws_size, (size_t)WS_TOTAL); return; }
    (void)hipMemsetAsync(P.ws + OFF_bar, 0, XCD_BAR_WORDS * sizeof(unsigned), stream);
    hipLaunchKernelGGL(k_fused, dim3(grid), dim3(NTHREADS), LDS_BYTES, stream, P);
}
```
